# Optimizing an MI355X kernel written in HIP

```python
import jax, jax.numpy as jnp
from jax import lax
import numpy as np

D_MODEL = 1024
BATCH = 8
SEQ = 2048
DEPTH = 1

MIX_WIDTH = D_MODEL
HEAD_DIM = 64
ATTN_WIDTH = MIX_WIDTH // 2
N_Q_HEADS = ATTN_WIDTH // HEAD_DIM
N_KV_HEADS = 2
KV_GROUP = N_Q_HEADS // N_KV_HEADS
KV_WIDTH = N_KV_HEADS * HEAD_DIM
WINDOW = 128
ATTN_BLOCK = 128
LRU_WIDTH = MIX_WIDTH - ATTN_WIDTH
LRU_BLOCKS = 8
LRU_BLOCK_W = LRU_WIDTH // LRU_BLOCKS
CONV_WIDTH = 4
LRU_C = 8.0
IN_SPLITS = [ATTN_WIDTH, ATTN_WIDTH + KV_WIDTH, ATTN_WIDTH + 2 * KV_WIDTH, ATTN_WIDTH + 2 * KV_WIDTH + LRU_WIDTH]
IN_COLS = ATTN_WIDTH + 2 * KV_WIDTH + 2 * LRU_WIDTH
N_EXPERTS = 32
TOP_K = 4
D_EXPERT = D_MODEL
SWIGLU_LIMIT = 7.0
SWIGLU_ALPHA = 1.702
MOE_BLOCK = 256
EPS = 1e-6

kernel_name = "hymba_griffin_swa_sink_moe_adaln"


def rms_norm(x, g):
    xf = x.astype(jnp.float32)
    y = xf * lax.rsqrt(jnp.mean(xf * xf, axis=-1, keepdims=True) + EPS)
    return (y * g.astype(jnp.float32)).astype(x.dtype)


def causal_depthwise_conv(x, w, b):
    y = lax.conv_general_dilated(
        x, w[:, None, :].astype(x.dtype), window_strides=(1,),
        padding=[(CONV_WIDTH - 1, 0)], dimension_numbers=("NWC", "WIO", "NWC"),
        feature_group_count=x.shape[-1])
    return y + b


def rg_lru(x, w_a, b_a, w_x, b_x, lam):
    B, S, C = x.shape
    xf = x.astype(jnp.float32)
    xh = xf.reshape(B, S, LRU_BLOCKS, LRU_BLOCK_W)
    r = jax.nn.sigmoid(jnp.einsum("bshi,hij->bshj", xh, w_a.astype(jnp.float32)) + b_a).reshape(B, S, C)
    i = jax.nn.sigmoid(jnp.einsum("bshi,hij->bshj", xh, w_x.astype(jnp.float32)) + b_x).reshape(B, S, C)
    log_a = LRU_C * r * jax.nn.log_sigmoid(lam.astype(jnp.float32))
    a = jnp.exp(log_a)
    mult = jnp.sqrt(jnp.maximum(-jnp.expm1(2.0 * log_a), 0.0))
    u = mult * (i * xf)

    def combine(left, right):
        a1, b1 = left
        a2, b2 = right
        return a1 * a2, a2 * b1 + b2

    _, h = lax.associative_scan(combine, (a, u), axis=1)
    return h.astype(x.dtype)


def sliding_window_sink_attention(q, k, v, sinks):
    B, S = q.shape[0], q.shape[1]
    nblk = S // ATTN_BLOCK
    qb = q.reshape(B, nblk, ATTN_BLOCK, N_KV_HEADS, KV_GROUP, HEAD_DIM)

    def band(t):
        tp = jnp.pad(t, ((0, 0), (ATTN_BLOCK, 0), (0, 0), (0, 0)))
        prev = tp[:, :S].reshape(B, nblk, ATTN_BLOCK, N_KV_HEADS, HEAD_DIM)
        cur = t.reshape(B, nblk, ATTN_BLOCK, N_KV_HEADS, HEAD_DIM)
        return jnp.concatenate([prev, cur], axis=2)

    kw, vw = band(k), band(v)
    scores = jnp.einsum("bnqkgd,bnskd->bnkgqs", qb, kw).astype(jnp.float32) * (HEAD_DIM ** -0.5)
    qi = jnp.arange(ATTN_BLOCK)[:, None]
    sj = jnp.arange(2 * ATTN_BLOCK)[None, :]
    rel = qi + ATTN_BLOCK - sj
    key_pos = jnp.arange(nblk)[:, None, None] * ATTN_BLOCK - ATTN_BLOCK + sj[None]
    mask = ((rel >= 0) & (rel < WINDOW))[None] & (key_pos >= 0)
    scores = jnp.where(mask[None, :, None, None], scores, jnp.finfo(jnp.float32).min)
    sink = jnp.broadcast_to(sinks.astype(jnp.float32).reshape(1, 1, N_KV_HEADS, KV_GROUP, 1, 1),
                            scores.shape[:-1] + (1,))
    probs = jax.nn.softmax(jnp.concatenate([scores, sink], axis=-1), axis=-1)[..., :-1]
    out = jnp.einsum("bnkgqs,bnskd->bnqkgd", probs.astype(v.dtype), vw)
    return out.reshape(B, S, N_Q_HEADS * HEAD_DIM)


def parallel_mixer(h, w_in, conv_w, conv_b, w_rg_a, b_rg_a, w_rg_x, b_rg_x, lru_lambda,
                   sinks, g_attn_out, g_lru_out, w_out):
    B, S, _ = h.shape
    p = h @ w_in
    q, k, v, xr, xg = jnp.split(p, IN_SPLITS, axis=-1)
    attn = sliding_window_sink_attention(
        q.reshape(B, S, N_Q_HEADS, HEAD_DIM), k.reshape(B, S, N_KV_HEADS, HEAD_DIM),
        v.reshape(B, S, N_KV_HEADS, HEAD_DIM), sinks)
    xc = causal_depthwise_conv(xr, conv_w, conv_b)
    lru = rg_lru(xc, w_rg_a, b_rg_a, w_rg_x, b_rg_x, lru_lambda) * jax.nn.gelu(xg)
    merged = jnp.concatenate([rms_norm(attn, g_attn_out), rms_norm(lru, g_lru_out)], axis=-1)
    return merged @ w_out


def moe_ffn(h, w_router, b_router, w_gu, b_gu, w_down, b_down):
    B, S, D = h.shape
    T = B * S
    A = T * TOP_K
    R = ((A + N_EXPERTS * (MOE_BLOCK - 1) + MOE_BLOCK - 1) // MOE_BLOCK) * MOE_BLOCK
    nb = R // MOE_BLOCK
    hf = h.reshape(T, D)
    logits = (hf @ w_router + b_router).astype(jnp.float32)
    top_vals, top_idx = lax.top_k(logits, TOP_K)
    gates = jax.nn.softmax(top_vals, axis=-1)
    flat_e = top_idx.reshape(A).astype(jnp.int32)
    flat_tok = jnp.repeat(jnp.arange(T, dtype=jnp.int32), TOP_K)
    flat_w = gates.reshape(A)
    order = jnp.argsort(flat_e)
    se = flat_e[order]
    sizes = jnp.bincount(flat_e, length=N_EXPERTS)
    padded = ((sizes + MOE_BLOCK - 1) // MOE_BLOCK) * MOE_BLOCK
    pad_end = jnp.cumsum(padded)
    pad_start = pad_end - padded
    start = jnp.cumsum(sizes) - sizes
    dest = pad_start[se] + (jnp.arange(A, dtype=jnp.int32) - start[se])
    row_tok = jnp.zeros((R,), jnp.int32).at[dest].set(flat_tok[order])
    row_w = jnp.zeros((R,), jnp.float32).at[dest].set(flat_w[order])
    blk_e = jnp.minimum(jnp.searchsorted(pad_end, jnp.arange(nb) * MOE_BLOCK, side="right"),
                        N_EXPERTS - 1).astype(jnp.int32)
    xs = hf[row_tok].reshape(nb, MOE_BLOCK, D)

    def expert_block(args):
        xb, e = args
        gu = xb @ w_gu[e] + b_gu[e]
        gate = jnp.minimum(gu[:, :D_EXPERT], SWIGLU_LIMIT)
        up = jnp.clip(gu[:, D_EXPERT:], -SWIGLU_LIMIT, SWIGLU_LIMIT)
        glu = gate * jax.nn.sigmoid(SWIGLU_ALPHA * gate)
        return ((up + 1.0) * glu) @ w_down[e] + b_down[e]

    ys = lax.map(expert_block, (xs, blk_e)).reshape(R, D)
    ys = ys.astype(jnp.float32) * row_w[:, None]
    out = jax.ops.segment_sum(ys, row_tok, num_segments=T)
    return out.reshape(B, S, D).astype(h.dtype)


def setup_inputs(seed: int = 0) -> dict:
    key = jax.random.key(seed)
    ks = jax.random.split(key, 26)
    L, D, E, F = DEPTH, D_MODEL, N_EXPERTS, D_EXPERT
    nrm = lambda k, shape, s: jax.random.normal(k, shape, jnp.float32) * s
    a0 = jax.random.uniform(ks[13], (L, LRU_WIDTH), jnp.float32, minval=0.9, maxval=0.999)
    root = a0 ** (1.0 / LRU_C)
    return {
        "x": nrm(ks[0], (BATCH, SEQ, D), 1.0),
        "c": nrm(ks[1], (BATCH, D), 1.0),
        "w_ada": nrm(ks[2], (L, D, 6 * D), 0.5 * D ** -0.5),
        "b_ada": nrm(ks[3], (L, 6 * D), 0.02),
        "g_mix": 1.0 + nrm(ks[4], (L, D), 0.05),
        "w_in": nrm(ks[5], (L, D, IN_COLS), D ** -0.5),
        "conv_w": nrm(ks[6], (L, CONV_WIDTH, LRU_WIDTH), CONV_WIDTH ** -0.5),
        "conv_b": nrm(ks[7], (L, LRU_WIDTH), 0.02),
        "w_rg_a": nrm(ks[8], (L, LRU_BLOCKS, LRU_BLOCK_W, LRU_BLOCK_W), LRU_BLOCK_W ** -0.5),
        "b_rg_a": nrm(ks[9], (L, LRU_BLOCKS, LRU_BLOCK_W), 0.02),
        "w_rg_x": nrm(ks[10], (L, LRU_BLOCKS, LRU_BLOCK_W, LRU_BLOCK_W), LRU_BLOCK_W ** -0.5),
        "b_rg_x": nrm(ks[11], (L, LRU_BLOCKS, LRU_BLOCK_W), 0.02),
        "lru_lambda": jnp.log(root) - jnp.log1p(-root),
        "sinks": nrm(ks[12], (L, N_Q_HEADS), 0.5),
        "g_attn_out": 1.0 + nrm(ks[14], (L, ATTN_WIDTH), 0.05),
        "g_lru_out": 1.0 + nrm(ks[15], (L, LRU_WIDTH), 0.05),
        "w_out": nrm(ks[16], (L, MIX_WIDTH, D), MIX_WIDTH ** -0.5),
        "g_ffn": 1.0 + nrm(ks[17], (L, D), 0.05),
        "w_router": nrm(ks[18], (L, D, E), D ** -0.5),
        "b_router": nrm(ks[19], (L, E), 0.01),
        "w_gu": nrm(ks[20], (L, E, D, 2 * F), D ** -0.5),
        "b_gu": nrm(ks[21], (L, E, 2 * F), 0.02),
        "w_down": nrm(ks[22], (L, E, F, D), F ** -0.5),
        "b_down": nrm(ks[23], (L, E, D), 0.02),
        "g_final": 1.0 + nrm(ks[24], (D,), 0.05),
    }


def reference(x, c, w_ada, b_ada, g_mix, w_in, conv_w, conv_b, w_rg_a, b_rg_a, w_rg_x, b_rg_x,
              lru_lambda, sinks, g_attn_out, g_lru_out, w_out, g_ffn, w_router, b_router,
              w_gu, b_gu, w_down, b_down, g_final):
    for l in range(DEPTH):
        mod = (c @ w_ada[l] + b_ada[l])[:, None, :]
        sh1, sc1, gt1, sh2, sc2, gt2 = jnp.split(mod, 6, axis=-1)
        h = rms_norm(x, g_mix[l]) * (1.0 + sc1) + sh1
        x = x + gt1 * parallel_mixer(h, w_in[l], conv_w[l], conv_b[l], w_rg_a[l], b_rg_a[l],
                                     w_rg_x[l], b_rg_x[l], lru_lambda[l], sinks[l],
                                     g_attn_out[l], g_lru_out[l], w_out[l])
        h = rms_norm(x, g_ffn[l]) * (1.0 + sc2) + sh2
        x = x + gt2 * moe_ffn(h, w_router[l], b_router[l], w_gu[l], b_gu[l], w_down[l], b_down[l])
    return rms_norm(x, g_final)
```

```cpp
#include <hip/hip_runtime.h>
#include <stdint.h>
#include <stdio.h>
namespace nv {
constexpr int B_ = 8, S_ = 2048, D_ = 1024, T_ = B_ * S_;
constexpr int NCOL = 1792, NE = 32, F_ = 1024;
constexpr int QOFF = 0, KOFF = 512, VOFF = 640, XROFF = 768, XGOFF = 1280;
constexpr int LISTCAP = 16384;

__device__ __forceinline__ float wave_sum(float v) {
#pragma unroll
    for (int o = 1; o < 64; o <<= 1) v += __shfl_xor(v, o);
    return v;
}
__device__ __forceinline__ float block_sum256(float v, float* red) {
    v = wave_sum(v);
    __syncthreads();
    if ((threadIdx.x & 63) == 0) red[threadIdx.x >> 6] = v;
    __syncthreads();
    return (red[0] + red[1]) + (red[2] + red[3]);
}

__global__ void __launch_bounds__(256) k_mod(const float* c, const float* w_ada, const float* b_ada, float* mod) {
    const int j = blockIdx.x * 256 + threadIdx.x, b = blockIdx.y;
    float acc = b_ada[j];
    for (int k = 0; k < D_; ++k) acc += c[b * D_ + k] * w_ada[(size_t)k * 6144 + j];
    mod[b * 6144 + j] = acc;
}

__global__ void __launch_bounds__(256) k_normmod(const float* x, const float* g, const float* mod, int sh_off, int sc_off, float* h) {
    __shared__ float red[4];
    const int t = blockIdx.x, b = t / S_;
    const float4 v = ((const float4*)(x + (size_t)t * D_))[threadIdx.x];
    float ss = v.x * v.x + v.y * v.y + v.z * v.z + v.w * v.w;
    ss = block_sum256(ss, red);
    const float rs = rsqrtf(ss * (1.0f / D_) + 1e-6f);
    const int d = threadIdx.x * 4;
    const float* m = mod + b * 6144;
    float4 o;
    o.x = v.x * rs * g[d + 0] * (1.f + m[sc_off + d + 0]) + m[sh_off + d + 0];
    o.y = v.y * rs * g[d + 1] * (1.f + m[sc_off + d + 1]) + m[sh_off + d + 1];
    o.z = v.z * rs * g[d + 2] * (1.f + m[sc_off + d + 2]) + m[sh_off + d + 2];
    o.w = v.w * rs * g[d + 3] * (1.f + m[sc_off + d + 3]) + m[sh_off + d + 3];
    ((float4*)(h + (size_t)t * D_))[threadIdx.x] = o;
}

template <int MODE>
__global__ void __launch_bounds__(256) k_sgemm(const float* A, int lda, const float* Bm, int ldb, float* C, int ldc, int K,
                                               const int* counts, const int* list, const float* bias) {
    __shared__ float As[16][64 + 4];
    __shared__ float Bs[16][64 + 4];
    __shared__ float Bs2[MODE == 1 ? 16 : 1][64 + 4];
    __shared__ int rowsrc[64];
    __shared__ int rowdst[64];
    const int tx = threadIdx.x;
    const int n0 = blockIdx.x * 64;
    int row0 = blockIdx.y * 64;
    int e = 0;
    if (MODE != 0) {
        e = blockIdx.z;
        const int cnt = counts[e];
        if (row0 >= cnt) return;
        if (tx < 64) {
            const int r = row0 + tx;
            const int slot = (r < cnt) ? list[e * LISTCAP + r] : -1;
            rowdst[tx] = slot;
            rowsrc[tx] = (slot < 0) ? 0 : (MODE == 1 ? (slot >> 2) : slot);
        }
        Bm += (size_t)e * K * ldb;
    } else {
        if (tx < 64) { rowsrc[tx] = row0 + tx; rowdst[tx] = row0 + tx; }
    }
    __syncthreads();
    float acc[4][4], acc2[4][4];
#pragma unroll
    for (int i = 0; i < 4; ++i)
#pragma unroll
        for (int j = 0; j < 4; ++j) { acc[i][j] = 0.f; acc2[i][j] = 0.f; }
    const int ty4 = (tx >> 4) * 4, tx4 = (tx & 15) * 4;
    const int ar = tx >> 2, ak = (tx & 3) * 4;
    const float* arow = A + (size_t)rowsrc[ar] * lda;
    const int bk = tx >> 4, bn = (tx & 15) * 4;
    for (int k0 = 0; k0 < K; k0 += 16) {
        const float4 av = *(const float4*)(arow + k0 + ak);
        const float4 bv = *(const float4*)(Bm + (size_t)(k0 + bk) * ldb + n0 + bn);
        float4 bv2 = bv;
        if (MODE == 1) bv2 = *(const float4*)(Bm + (size_t)(k0 + bk) * ldb + 1024 + n0 + bn);
        __syncthreads();
        As[ak + 0][ar] = av.x; As[ak + 1][ar] = av.y; As[ak + 2][ar] = av.z; As[ak + 3][ar] = av.w;
        *(float4*)&Bs[bk][bn] = bv;
        if (MODE == 1) *(float4*)&Bs2[bk][bn] = bv2;
        __syncthreads();
#pragma unroll
        for (int kk = 0; kk < 16; ++kk) {
            const float4 a4 = *(const float4*)&As[kk][ty4];
            const float4 b4 = *(const float4*)&Bs[kk][tx4];
            const float a_[4] = {a4.x, a4.y, a4.z, a4.w};
            const float b_[4] = {b4.x, b4.y, b4.z, b4.w};
#pragma unroll
            for (int i = 0; i < 4; ++i)
#pragma unroll
                for (int j = 0; j < 4; ++j) acc[i][j] += a_[i] * b_[j];
            if (MODE == 1) {
                const float4 c4 = *(const float4*)&Bs2[kk][tx4];
                const float c_[4] = {c4.x, c4.y, c4.z, c4.w};
#pragma unroll
                for (int i = 0; i < 4; ++i)
#pragma unroll
                    for (int j = 0; j < 4; ++j) acc2[i][j] += a_[i] * c_[j];
            }
        }
    }
#pragma unroll
    for (int i = 0; i < 4; ++i) {
        const int dst = rowdst[ty4 + i];
        if (dst < 0) continue;
        float4 o;
        float r_[4];
#pragma unroll
        for (int j = 0; j < 4; ++j) {
            const int n = n0 + tx4 + j;
            if (MODE == 0) r_[j] = acc[i][j];
            else if (MODE == 1) {
                float gate = acc[i][j] + bias[e * 2048 + n];
                float up = acc2[i][j] + bias[e * 2048 + 1024 + n];
                gate = fminf(gate, 7.0f);
                up = fminf(fmaxf(up, -7.0f), 7.0f);
                const float glu = gate * (1.0f / (1.0f + __expf(-1.702f * gate)));
                r_[j] = (up + 1.0f) * glu;
            } else r_[j] = acc[i][j] + bias[e * 1024 + n];
        }
        o.x = r_[0]; o.y = r_[1]; o.z = r_[2]; o.w = r_[3];
        *(float4*)(C + (size_t)dst * ldc + n0 + tx4) = o;
    }
}

__global__ void __launch_bounds__(256) k_attn(const float* P, const float* sinks, float* mixraw) {
    const int w = blockIdx.x * 4 + (threadIdx.x >> 6), lane = threadIdx.x & 63;
    const int t = w >> 3, h = w & 7, kvh = h >> 2;
    const int b = t / S_, sp = t % S_;
    const float q = P[(size_t)t * NCOL + QOFF + h * 64 + lane];
    float m = -3.0e38f, l = 0.f, o = 0.f;
    const int s0 = sp - 127 < 0 ? 0 : sp - 127;
    for (int s = s0; s <= sp; ++s) {
        const size_t row = (size_t)(b * S_ + s) * NCOL;
        const float kx = P[row + KOFF + kvh * 64 + lane];
        const float vx = P[row + VOFF + kvh * 64 + lane];
        const float sc = wave_sum(q * kx) * 0.125f;
        const float mn = fmaxf(m, sc);
        const float f = __expf(m - mn), p = __expf(sc - mn);
        l = l * f + p; o = o * f + p * vx; m = mn;
    }
    const float sk = sinks[h];
    const float mf = fmaxf(m, sk);
    const float f = __expf(m - mf);
    l = l * f + __expf(sk - mf);
    mixraw[(size_t)t * D_ + h * 64 + lane] = o * f / l;
}

__device__ __forceinline__ float sigmoidf_(float x) { return 1.0f / (1.0f + expf(-x)); }
__device__ __forceinline__ float gelu_tanh(float x) { return 0.5f * x * (1.0f + tanhf(0.7978845608028654f * (x + 0.044715f * x * x * x))); }

__global__ void __launch_bounds__(256) k_lru_gates(const float* P, const float* conv_w, const float* conv_b, const float* w_a, const float* b_a,
                                                   const float* w_x, const float* b_x, const float* lam, float* Abuf, float* Ubuf) {
    __shared__ float xcs[4][64];
    const int tl = threadIdx.x >> 6, jc = threadIdx.x & 63, hb = blockIdx.y;
    const int t = blockIdx.x * 4 + tl, sp = t % S_;
    const int c = hb * 64 + jc;
    float xc = conv_b[c];
#pragma unroll
    for (int k = 0; k < 4; ++k) {
        const int s = sp - 3 + k;
        if (s >= 0) xc += conv_w[k * 512 + c] * P[(size_t)(t - 3 + k) * NCOL + XROFF + c];
    }
    xcs[tl][jc] = xc;
    __syncthreads();
    float ra = b_a[c], ri = b_x[c];
    for (int i = 0; i < 64; ++i) {
        const float xi = xcs[tl][i];
        ra += xi * w_a[(hb * 64 + i) * 64 + jc];
        ri += xi * w_x[(hb * 64 + i) * 64 + jc];
    }
    const float r = sigmoidf_(ra), ig = sigmoidf_(ri);
    const float lg = -log1pf(expf(-lam[c]));
    const float log_a = 8.0f * r * lg;
    const float a = expf(log_a);
    const float mult = sqrtf(fmaxf(-expm1f(2.0f * log_a), 0.0f));
    Abuf[(size_t)t * 512 + c] = a;
    Ubuf[(size_t)t * 512 + c] = mult * (ig * xc);
}

__global__ void __launch_bounds__(256) k_scan(const float* P, const float* Abuf, const float* Ubuf, float* mixraw) {
    const int id = blockIdx.x * 256 + threadIdx.x;
    const int b = id >> 9, c = id & 511;
    float h = 0.f;
    for (int s = 0; s < S_; ++s) {
        const size_t t = (size_t)b * S_ + s;
        h = Abuf[t * 512 + c] * h + Ubuf[t * 512 + c];
        mixraw[t * D_ + 512 + c] = h * gelu_tanh(P[t * NCOL + XGOFF + c]);
    }
}

__global__ void __launch_bounds__(256) k_norm_merge(const float* mixraw, const float* g_attn, const float* g_lru, float* mix) {
    __shared__ float red[4];
    const int t = blockIdx.x, tx = threadIdx.x;
    const float a0 = mixraw[(size_t)t * D_ + tx], a1 = mixraw[(size_t)t * D_ + 256 + tx];
    const float l0 = mixraw[(size_t)t * D_ + 512 + tx], l1 = mixraw[(size_t)t * D_ + 768 + tx];
    const float sa = block_sum256(a0 * a0 + a1 * a1, red);
    const float sl = block_sum256(l0 * l0 + l1 * l1, red);
    const float ra = rsqrtf(sa * (1.0f / 512) + 1e-6f), rl = rsqrtf(sl * (1.0f / 512) + 1e-6f);
    mix[(size_t)t * D_ + tx] = a0 * ra * g_attn[tx];
    mix[(size_t)t * D_ + 256 + tx] = a1 * ra * g_attn[256 + tx];
    mix[(size_t)t * D_ + 512 + tx] = l0 * rl * g_lru[tx];
    mix[(size_t)t * D_ + 768 + tx] = l1 * rl * g_lru[256 + tx];
}

__global__ void __launch_bounds__(256) k_resid(const float* x, const float* mixo, const float* mod, int gt_off, float* x1) {
    const int t = blockIdx.x, b = t / S_, d = threadIdx.x * 4;
    const float4 xv = ((const float4*)(x + (size_t)t * D_))[threadIdx.x];
    const float4 mv = ((const float4*)(mixo + (size_t)t * D_))[threadIdx.x];
    const float* g = mod + b * 6144 + gt_off + d;
    float4 o; o.x = xv.x + g[0] * mv.x; o.y = xv.y + g[1] * mv.y; o.z = xv.z + g[2] * mv.z; o.w = xv.w + g[3] * mv.w;
    ((float4*)(x1 + (size_t)t * D_))[threadIdx.x] = o;
}

__global__ void __launch_bounds__(256) k_router(const float* h2, const float* w_r, const float* b_r, int* topi, float* topg, int* counts, int* list) {
    __shared__ float hs[1024];
    __shared__ float lg[32];
    const int t = blockIdx.x, tx = threadIdx.x;
    ((float4*)hs)[tx] = ((const float4*)(h2 + (size_t)t * D_))[tx];
    __syncthreads();
    const int e = tx >> 3, part = tx & 7;
    float acc = 0.f;
    for (int k = part; k < 1024; k += 8) acc += hs[k] * w_r[k * 32 + e];
    acc += __shfl_xor(acc, 1); acc += __shfl_xor(acc, 2); acc += __shfl_xor(acc, 4);
    if (part == 0) lg[e] = acc + b_r[e];
    __syncthreads();
    if (tx == 0) {
        int idx[4]; float val[4];
        unsigned used = 0u;
#pragma unroll
        for (int k = 0; k < 4; ++k) {
            float best = -3.0e38f; int bi = 0;
            for (int j = 0; j < 32; ++j) { const float v = lg[j]; if (!((used >> j) & 1u) && v > best) { best = v; bi = j; } }
            used |= 1u << bi; idx[k] = bi; val[k] = best;
        }
        float den = 0.f, ex[4];
#pragma unroll
        for (int k = 0; k < 4; ++k) { ex[k] = __expf(val[k] - val[0]); den += ex[k]; }
#pragma unroll
        for (int k = 0; k < 4; ++k) {
            topi[t * 4 + k] = idx[k]; topg[t * 4 + k] = ex[k] / den;
            const int pos = atomicAdd(&counts[idx[k]], 1);
            list[idx[k] * LISTCAP + pos] = t * 4 + k;
        }
    }
}

__global__ void __launch_bounds__(256) k_final(const float* x1, const float* Y, const float* topg, const float* mod, const float* g_final, float* out) {
    __shared__ float red[4];
    const int t = blockIdx.x, b = t / S_, tx = threadIdx.x, d = tx * 4;
    float4 v = ((const float4*)(x1 + (size_t)t * D_))[tx];
    float4 s = make_float4(0.f, 0.f, 0.f, 0.f);
#pragma unroll
    for (int k = 0; k < 4; ++k) {
        const float gk = topg[t * 4 + k];
        const float4 y = ((const float4*)(Y + (size_t)(t * 4 + k) * D_))[tx];
        s.x += gk * y.x; s.y += gk * y.y; s.z += gk * y.z; s.w += gk * y.w;
    }
    const float* g2 = mod + b * 6144 + 5120 + d;
    v.x += g2[0] * s.x; v.y += g2[1] * s.y; v.z += g2[2] * s.z; v.w += g2[3] * s.w;
    const float ss = block_sum256(v.x * v.x + v.y * v.y + v.z * v.z + v.w * v.w, red);
    const float rs = rsqrtf(ss * (1.0f / D_) + 1e-6f);
    float4 o; o.x = v.x * rs * g_final[d]; o.y = v.y * rs * g_final[d + 1]; o.z = v.z * rs * g_final[d + 2]; o.w = v.w * rs * g_final[d + 3];
    ((float4*)(out + (size_t)t * D_))[tx] = o;
}
}
extern "C" void kernel_launch(void* const* d_in, const int* in_sizes, int n_in, void* d_out, int out_size, void* d_ws, size_t ws_size,
                              hipStream_t stream) {
    using namespace nv;
    const float* x = (const float*)d_in[0];       const float* c = (const float*)d_in[1];
    const float* w_ada = (const float*)d_in[2];   const float* b_ada = (const float*)d_in[3];
    const float* g_mix = (const float*)d_in[4];   const float* w_in = (const float*)d_in[5];
    const float* conv_w = (const float*)d_in[6];  const float* conv_b = (const float*)d_in[7];
    const float* w_rg_a = (const float*)d_in[8];  const float* b_rg_a = (const float*)d_in[9];
    const float* w_rg_x = (const float*)d_in[10]; const float* b_rg_x = (const float*)d_in[11];
    const float* lam = (const float*)d_in[12];    const float* sinks = (const float*)d_in[13];
    const float* g_attn = (const float*)d_in[14]; const float* g_lru = (const float*)d_in[15];
    const float* w_out = (const float*)d_in[16];  const float* g_ffn = (const float*)d_in[17];
    const float* w_router = (const float*)d_in[18]; const float* b_router = (const float*)d_in[19];
    const float* w_gu = (const float*)d_in[20];   const float* b_gu = (const float*)d_in[21];
    const float* w_down = (const float*)d_in[22]; const float* b_down = (const float*)d_in[23];
    const float* g_final = (const float*)d_in[24];
    float* out = (float*)d_out;
    char* ws = (char*)d_ws;
    const size_t MiB = 1u << 20;
    int* counts = (int*)(ws);
    float* MOD = (float*)(ws + 1 * MiB);
    int* TOPI = (int*)(ws + 2 * MiB);
    float* TOPG = (float*)(ws + 3 * MiB);
    int* LIST = (int*)(ws + 4 * MiB);
    float* H1 = (float*)(ws + 16 * MiB);
    float* AB = (float*)(ws + 16 * MiB);
    float* UB = (float*)(ws + 48 * MiB);
    float* MIXO = (float*)(ws + 16 * MiB);
    float* P = (float*)(ws + 80 * MiB);
    float* MIXRAW = (float*)(ws + 192 * MiB);
    float* MIX = (float*)(ws + 256 * MiB);
    float* H2 = (float*)(ws + 256 * MiB);
    float* X1 = (float*)(ws + 320 * MiB);
    float* ACT = (float*)(ws + 384 * MiB);
    float* Y = (float*)(ws + 640 * MiB);
    hipMemsetAsync(counts, 0, 4096, stream);
    k_mod<<<dim3(24, 8), 256, 0, stream>>>(c, w_ada, b_ada, MOD);
    k_normmod<<<T_, 256, 0, stream>>>(x, g_mix, MOD, 0, 1024, H1);
    k_sgemm<0><<<dim3(28, 256), 256, 0, stream>>>(H1, 1024, w_in, 1792, P, 1792, 1024, nullptr, nullptr, nullptr);
    k_attn<<<T_ * 8 / 4, 256, 0, stream>>>(P, sinks, MIXRAW);
    k_lru_gates<<<dim3(T_ / 4, 8), 256, 0, stream>>>(P, conv_w, conv_b, w_rg_a, b_rg_a, w_rg_x, b_rg_x, lam, AB, UB);
    k_scan<<<16, 256, 0, stream>>>(P, AB, UB, MIXRAW);
    k_norm_merge<<<T_, 256, 0, stream>>>(MIXRAW, g_attn, g_lru, MIX);
    k_sgemm<0><<<dim3(16, 256), 256, 0, stream>>>(MIX, 1024, w_out, 1024, MIXO, 1024, 1024, nullptr, nullptr, nullptr);
    k_resid<<<T_, 256, 0, stream>>>(x, MIXO, MOD, 2048, X1);
    k_normmod<<<T_, 256, 0, stream>>>(X1, g_ffn, MOD, 3072, 4096, H2);
    k_router<<<T_, 256, 0, stream>>>(H2, w_router, b_router, TOPI, TOPG, counts, LIST);
    k_sgemm<1><<<dim3(16, 256, 32), 256, 0, stream>>>(H2, 1024, w_gu, 2048, ACT, 1024, 1024, counts, LIST, b_gu);
    k_sgemm<2><<<dim3(16, 256, 32), 256, 0, stream>>>(ACT, 1024, w_down, 1024, Y, 1024, 1024, counts, LIST, b_down);
    k_final<<<T_, 256, 0, stream>>>(X1, Y, TOPG, MOD, g_final, out);
}
```

```cpp
#include <hip/hip_runtime.h>
#include <stdint.h>
#include <stdio.h>
namespace mk {
#define LAS __attribute__((address_space(3)))
#define GAS __attribute__((address_space(1)))
typedef unsigned short bf16_t;
typedef short bf16x8 __attribute__((ext_vector_type(8)));
typedef short s16x4 __attribute__((ext_vector_type(4)));
typedef float f32x2 __attribute__((ext_vector_type(2)));
typedef float f32x4 __attribute__((ext_vector_type(4)));
typedef float f32x16 __attribute__((ext_vector_type(16)));
typedef unsigned u32x2 __attribute__((ext_vector_type(2)));
typedef unsigned u32x4 __attribute__((ext_vector_type(4)));

constexpr int NWAVES = 8, NTHR = 512;
constexpr int NB = 8, SEQ = 2048, D = 1024, T = NB * SEQ, NCOL = 1792, NE = 32;
constexpr int QOFF = 0, KOFF = 512, VOFF = 640, XROFF = 768, XGOFF = 1280;
constexpr int LISTCAP = 16384, DUMP = 65536, MAXTILES = 288;
constexpr float EPS = 1e-6f;

constexpr size_t MiB = 1u << 20;
constexpr size_t WS_CTL = 0, CTL_ZERO_BYTES = 64 * 1024;
constexpr int CW_CNT = 64;
constexpr int CW_BAR = 4096;
constexpr size_t WS_MOD = 1 * MiB;
constexpr size_t WS_TOPG = 2 * MiB;
constexpr size_t WS_LIST = 4 * MiB;
constexpr size_t WS_SSQA = 6 * MiB;
constexpr size_t WS_SSQL = 7 * MiB;
constexpr size_t WS_SSQ1 = 9 * MiB;
constexpr size_t WS_WIN = 10 * MiB;
constexpr size_t WS_WOUT = 14 * MiB;
constexpr size_t WS_WGU = 16 * MiB;
constexpr size_t WS_WDN = 144 * MiB;
constexpr size_t WS_H = 208 * MiB;
constexpr size_t WS_P = 242 * MiB;
constexpr size_t WS_MIX = 298 * MiB;
constexpr size_t WS_X1 = 330 * MiB;
constexpr size_t WS_ACT = 394 * MiB;
constexpr size_t WS_YB = 538 * MiB;
constexpr size_t WS_END = 668 * MiB;

constexpr int RING_BYTES = 131072;
constexpr int LDSCTL_OFF = RING_BYTES;
constexpr int TAB_OFF = RING_BYTES + 512;
constexpr int LDS_BYTES = 147456;

#define RLX_AGENT __ATOMIC_RELAXED, __HIP_MEMORY_SCOPE_AGENT
#define LDS_WAIT() asm volatile("s_waitcnt lgkmcnt(0)" ::: "memory")
#define VM_WAIT() asm volatile("s_waitcnt vmcnt(0)" ::: "memory")
__device__ __forceinline__ unsigned f2bf(float f) { unsigned u = __builtin_bit_cast(unsigned, f); return (u + 0x7fffu + ((u >> 16) & 1u)) >> 16; }
__device__ __forceinline__ unsigned pk2(float lo, float hi) { return f2bf(lo) | (f2bf(hi) << 16); }
__device__ __forceinline__ float bf2f(unsigned short h) { return __builtin_bit_cast(float, (unsigned)h << 16); }
__device__ __forceinline__ float bflo(unsigned w) { return __builtin_bit_cast(float, w << 16); }
__device__ __forceinline__ float bfhi(unsigned w) { return __builtin_bit_cast(float, w & 0xffff0000u); }
__device__ __forceinline__ unsigned cvt_pk_bf16(float lo, float hi) { unsigned r; asm volatile("v_cvt_pk_bf16_f32 %0, %1, %2" : "=v"(r) : "v"(lo), "v"(hi)); return r; }
__device__ __forceinline__ float wave_sum(float v) {
#pragma unroll
    for (int o = 1; o < 64; o <<= 1) v += __shfl_xor(v, o);
    return v;
}

#define XB_TMO      128
#define XB_XCNT(j)  (256  + 64 * (j))
#define XB_XSUB(j)  (1280 + 64 * (j))
#define XB_XGEN(j)  (2304 + 64 * (j))
#define XB_TOP      3328
#define XB_TOPGEN   3392
#define XCD_BAR_WORDS 3456
#define XB_SPIN_CAP (1u << 20)
__device__ __forceinline__ unsigned xb_ld(unsigned* p)              { return __hip_atomic_load(p, __ATOMIC_RELAXED, __HIP_MEMORY_SCOPE_AGENT); }
__device__ __forceinline__ unsigned xb_add(unsigned* p, unsigned v) { return __hip_atomic_fetch_add(p, v, __ATOMIC_RELAXED, __HIP_MEMORY_SCOPE_AGENT); }
__device__ __forceinline__ unsigned xb_xcc_id() { return (unsigned)__builtin_amdgcn_s_getreg((3 << 11) | 20) & 0xFu; }
#define XB_SPIN(cond, bar) do { unsigned _sp = 0; while (cond) { __builtin_amdgcn_s_sleep(1); \
    if ((++_sp & 255u) == 0u) { if (xb_ld(&(bar)[XB_TMO])) break; if (_sp > XB_SPIN_CAP) { atomicAdd(&(bar)[XB_TMO], 1u); break; } } } } while (0)
struct XcdBarrier { unsigned* bar; unsigned x; volatile LAS unsigned* st; };
__device__ __forceinline__ XcdBarrier xcd_barrier_post(unsigned* bar, volatile LAS unsigned* st) {
    XcdBarrier b; b.bar = bar; b.x = xb_xcc_id(); b.st = st;
    if (threadIdx.x == 0) (void)xb_add(&bar[XB_XCNT(b.x)], 1u);
    return b;
}
__device__ __forceinline__ void xcd_barrier_complete(unsigned* bar, unsigned x, unsigned& nloc, unsigned& nx) {
    const unsigned G = gridDim.x * gridDim.y * gridDim.z;
    unsigned sum, cnt, mine, sp = 0u;
    for (;;) {
        sum = 0u; cnt = 0u; mine = 0u;
#pragma unroll
        for (unsigned j = 0; j < 16; ++j) { const unsigned c = xb_ld(&bar[XB_XCNT(j)]); sum += c; cnt += (c > 0u) ? 1u : 0u; mine = (j == x) ? c : mine; }
        if (sum == G) break;
        __builtin_amdgcn_s_sleep(1);
        if ((++sp & 255u) == 0u) { if (xb_ld(&bar[XB_TMO])) break; if (sp > XB_SPIN_CAP) { atomicAdd(&bar[XB_TMO], 1u); break; } }
    }
    nloc = mine > 0u ? mine : 1u; nx = cnt > 0u ? cnt : 1u;
}
__device__ __forceinline__ void xcd_barrier(const XcdBarrier& b) {
    asm volatile("s_waitcnt vmcnt(0)" ::: "memory");
    __syncthreads();
    if (threadIdx.x == 0) {
        unsigned* bar = b.bar;
        __builtin_amdgcn_s_waitcnt(0);
        unsigned nloc = b.st[0], nx = b.st[1];
        if (nloc == 0u) { xcd_barrier_complete(bar, b.x, nloc, nx); b.st[0] = nloc; b.st[1] = nx; }
        const unsigned old = xb_add(&bar[XB_XSUB(b.x)], 1u);
        const unsigned gen = old / nloc;
        if (old + 1u == (gen + 1u) * nloc) {
            __builtin_amdgcn_fence(__ATOMIC_RELEASE, "agent");
            asm volatile("s_waitcnt vmcnt(0)" ::: "memory");
            const unsigned og = xb_add(&bar[XB_TOP], 1u);
            const unsigned tg = og / nx;
            if (og + 1u == (tg + 1u) * nx) xb_add(&bar[XB_TOPGEN], 1u);
            else XB_SPIN(xb_ld(&bar[XB_TOPGEN]) == tg, bar);
            __builtin_amdgcn_fence(__ATOMIC_ACQUIRE, "agent");
            xb_add(&bar[XB_XGEN(b.x)], 1u);
            asm volatile("s_waitcnt vmcnt(0)" ::: "memory");
        } else {
            XB_SPIN(xb_ld(&bar[XB_XGEN(b.x)]) == gen, bar);
            __builtin_amdgcn_fence(__ATOMIC_ACQUIRE, "agent");
            asm volatile("s_waitcnt vmcnt(0)" ::: "memory");
        }
    }
    __syncthreads();
}

namespace pg8 {
constexpr int BM = 256, BK = 64, HALF = 128, HTB = HALF * BK * 2, STAGE_BYTES = 8 * HTB, NXCD = 8;
__device__ __forceinline__ int lds_byte(int r, int c) { const int st = (r >> 4) * 2 + (c >> 5), rr = r & 15, cc = c & 31, ob = rr * 64 + cc * 2; return st * 1024 + (ob ^ (((ob >> 9) & 1) << 5)); }
__device__ __forceinline__ void stage_rc(int b, int& R, int& C) { const int st = b / 1024, sb = b % 1024, swz = sb ^ (((sb >> 9) & 1) << 5); R = (st >> 1) * 16 + swz / 64; C = (st & 1) * 32 + (swz % 64) / 2; }
__device__ __forceinline__ int perm32(int rho) { const int n = rho >> 4, i = rho & 15; return 8 * (i >> 2) + 4 * n + (i & 3); }

struct Unit { int pm, pn, e, li; const char* bptr; };

template <class Epi, class Sched, bool ALIGN_EPI>
__device__ __forceinline__ void gemm_phase(LAS unsigned char* lds, const char* Abase, const int K, const Sched& S, const Epi& E) {
    const int tid = threadIdx.x, wid = __builtin_amdgcn_readfirstlane(tid >> 6), lane = tid & 63, wr = wid >> 2, wc = wid & 3, fr = lane & 15, fq = lane >> 4;
    const int nt = K / BK;
    int R_[2], C2_[2]; unsigned voffB[2];
#pragma unroll
    for (int i = 0; i < 2; ++i) { int R, C; stage_rc(tid * 16 + i * 8192, R, C); const int Rb = Epi::PERM ? ((R & ~31) + perm32(R & 31)) : R;
        R_[i] = R; C2_[i] = C * 2; voffB[i] = (unsigned)(Rb * K + C) * 2u; }
    const size_t kstep = (size_t)(BK * 2);
    const size_t hstepB = (size_t)HALF * K * 2;
    const unsigned ldsw = (unsigned)wid * 1024u;
    const int aoff = lds_byte(wr * 64 + fr, fq * 8), boff = lds_byte(wc * 32 + fr, fq * 8);
#define PG8_SA(b, h) (((b) * 2 + (h)) * HTB)
#define PG8_SB(b, h) ((4 + (b) * 2 + (h)) * HTB)
#define PG8_STAGE_B(bufoff, gbase) do { _Pragma("unroll") for (int _i = 0; _i < 2; ++_i) \
        __builtin_amdgcn_global_load_lds((const unsigned*)((const char*)(gbase) + voffB[_i]), (LAS unsigned*)(lds + (bufoff) + ldsw + _i * 8192), 16, 0, 0); } while (0)
#define PG8_STAGE_A(bufoff, OFF, h, kb) do { _Pragma("unroll") for (int _i = 0; _i < 2; ++_i) \
        __builtin_amdgcn_global_load_lds((const unsigned*)(Abase + (size_t)(OFF)[h][_i] + (size_t)(kb)), (LAS unsigned*)(lds + (bufoff) + ldsw + _i * 8192), 16, 0, 0); } while (0)
#define PG8_LDA(dst, b, h) do { _Pragma("unroll") for (int m = 0; m < 4; ++m) _Pragma("unroll") for (int k = 0; k < 2; ++k) dst[m][k] = *(const LAS bf16x8*)(lds + PG8_SA(b, h) + aoff + m * 2048 + k * 1024); } while (0)
#define PG8_LDB(dst, b, h) do { _Pragma("unroll") for (int n = 0; n < 2; ++n) _Pragma("unroll") for (int k = 0; k < 2; ++k) dst[n][k] = *(const LAS bf16x8*)(lds + PG8_SB(b, h) + boff + n * 2048 + k * 1024); } while (0)
#define PG8_MMA(ai, bj, At, Bt) do { __builtin_amdgcn_s_setprio(1); _Pragma("unroll") for (int m = 0; m < 4; ++m) _Pragma("unroll") for (int n = 0; n < 2; ++n) _Pragma("unroll") for (int k = 0; k < 2; ++k) \
        acc[ai][bj][m][n] = __builtin_amdgcn_mfma_f32_16x16x32_bf16(Bt[n][k], At[m][k], acc[ai][bj][m][n], 0, 0, 0); __builtin_amdgcn_s_setprio(0); } while (0)
#define PG8_WAIT_V(n) asm volatile("s_waitcnt vmcnt(" #n ")" ::: "memory")
#define PG8_WAIT_L(n) asm volatile("s_waitcnt lgkmcnt(" #n ")" ::: "memory")
#define PG8_BAR __builtin_amdgcn_s_barrier()
#define PG8_SCHED __builtin_amdgcn_sched_barrier(0)
    Unit cur, nxt; int ui = 0;
    if (!S.next(0, cur)) return;
    f32x4 acc[2][2][4][2];
#pragma unroll
    for (int a = 0; a < 2; ++a)
#pragma unroll
        for (int b = 0; b < 2; ++b)
#pragma unroll
            for (int m = 0; m < 4; ++m)
#pragma unroll
                for (int n = 0; n < 2; ++n) acc[a][b][m][n] = (f32x4){0.f, 0.f, 0.f, 0.f};
    bf16x8 At[4][2], B0[2][2], B1[2][2];
    unsigned aC[2][2], aN[2][2];
#pragma unroll
    for (int h = 0; h < 2; ++h)
#pragma unroll
        for (int i = 0; i < 2; ++i) aC[h][i] = S.a_off(cur, h * HALF + R_[i]) + (unsigned)C2_[i];
    const char* cB = cur.bptr;
    PG8_STAGE_B(PG8_SB(0, 0), cB); PG8_STAGE_B(PG8_SB(0, 1), cB + hstepB); PG8_STAGE_A(PG8_SA(0, 0), aC, 0, 0); PG8_STAGE_A(PG8_SA(0, 1), aC, 1, 0);
    if (wr == 1) PG8_BAR;
    PG8_WAIT_V(2); PG8_BAR;
    PG8_STAGE_B(PG8_SB(1, 0), cB + kstep); PG8_STAGE_A(PG8_SA(1, 0), aC, 0, kstep); PG8_STAGE_B(PG8_SB(1, 1), cB + hstepB + kstep);
    PG8_WAIT_V(6); PG8_BAR;
    for (;;) {
        const bool has_next = S.next(ui + 1, nxt);
        const char* nB = has_next ? nxt.bptr : cB;
#pragma unroll
        for (int h = 0; h < 2; ++h)
#pragma unroll
            for (int i = 0; i < 2; ++i) aN[h][i] = has_next ? (S.a_off(nxt, h * HALF + R_[i]) + (unsigned)C2_[i]) : aC[h][i];
        for (int t = 0; t < nt; t += 2) {
            const bool last = (t == nt - 2);
            const size_t k1 = (size_t)(t + 1) * kstep;
            const size_t k2 = last ? 0 : (size_t)(t + 2) * kstep, k3 = k2 + kstep;
            const char* b2 = last ? nB : cB + (size_t)(t + 2) * kstep; const char* b3 = b2 + kstep;
            unsigned a2[2][2];
#pragma unroll
            for (int h = 0; h < 2; ++h)
#pragma unroll
                for (int i = 0; i < 2; ++i) a2[h][i] = last ? aN[h][i] : aC[h][i];
            if constexpr (Epi::MIDK) { if (t == nt / 2) E.mid(acc, cur, wr, wc, fr, fq); }
            PG8_LDB(B0, 0, 0); PG8_LDB(B1, 0, 1); PG8_SCHED; PG8_LDA(At, 0, 0); PG8_STAGE_A(PG8_SA(1, 1), aC, 1, k1);
            PG8_WAIT_V(8); PG8_WAIT_L(0); PG8_BAR; PG8_MMA(0, 0, At, B0); PG8_MMA(0, 1, At, B1); PG8_BAR; PG8_SCHED;
            PG8_LDA(At, 0, 1); PG8_STAGE_B(PG8_SB(0, 0), b2); PG8_STAGE_B(PG8_SB(0, 1), b2 + hstepB); PG8_STAGE_A(PG8_SA(0, 0), a2, 0, k2);
            PG8_WAIT_V(8); PG8_WAIT_L(0); PG8_BAR; PG8_MMA(1, 0, At, B0); PG8_MMA(1, 1, At, B1); PG8_BAR; PG8_SCHED;
            PG8_LDB(B0, 1, 0); PG8_LDB(B1, 1, 1); PG8_SCHED; PG8_LDA(At, 1, 0); PG8_STAGE_A(PG8_SA(0, 1), a2, 1, k2);
            PG8_WAIT_V(8); PG8_WAIT_L(0); PG8_BAR; PG8_MMA(0, 0, At, B0); PG8_MMA(0, 1, At, B1); PG8_BAR; PG8_SCHED;
            PG8_LDA(At, 1, 1); PG8_STAGE_B(PG8_SB(1, 0), b3); PG8_STAGE_B(PG8_SB(1, 1), b3 + hstepB); PG8_STAGE_A(PG8_SA(1, 0), a2, 0, k3);
            PG8_WAIT_V(8); PG8_WAIT_L(0); PG8_BAR; PG8_MMA(1, 0, At, B0); PG8_MMA(1, 1, At, B1); PG8_BAR; PG8_SCHED;
        }
        if constexpr (ALIGN_EPI) { if (wr == 0) PG8_BAR; }
        E(acc, cur, wr, wc, fr, fq);
        if (!has_next) break;
#pragma unroll
        for (int a = 0; a < 2; ++a)
#pragma unroll
            for (int b = 0; b < 2; ++b)
#pragma unroll
                for (int m = 0; m < 4; ++m)
#pragma unroll
                    for (int n = 0; n < 2; ++n) acc[a][b][m][n] = (f32x4){0.f, 0.f, 0.f, 0.f};
        cur = nxt; cB = nB; ++ui;
#pragma unroll
        for (int h = 0; h < 2; ++h)
#pragma unroll
            for (int i = 0; i < 2; ++i) aC[h][i] = aN[h][i];
        if constexpr (ALIGN_EPI) { if (wr == 1) PG8_BAR; }
    }
    PG8_WAIT_V(0);
    if constexpr (!ALIGN_EPI) { if (wr == 0) PG8_BAR; }
    PG8_BAR;
#undef PG8_SA
#undef PG8_SB
#undef PG8_STAGE_A
#undef PG8_STAGE_B
#undef PG8_LDA
#undef PG8_LDB
#undef PG8_MMA
#undef PG8_WAIT_V
#undef PG8_WAIT_L
#undef PG8_BAR
#undef PG8_SCHED
}

struct DenseOrder {
    int nM, nN, nwg, G, c, K; const char* Bt;
    __device__ void init(int M, int N, int K_, const void* Bt_, int G_, int c_) { nM = M / BM; nN = N / BM; nwg = nM * nN; G = G_; c = c_; K = K_; Bt = (const char*)Bt_; }
    __device__ __forceinline__ bool next(int i, Unit& u) const {
        const long L = (long)i * G + c; if (L >= nwg) return false;
        int wgid = (int)L; { const int q = nwg / NXCD, r = nwg % NXCD, xcd = wgid % NXCD, off = wgid / NXCD; wgid = (xcd < r ? xcd * (q + 1) : r * (q + 1) + (xcd - r) * q) + off; }
        const int WGM = 8;
        const int nig = WGM * nN, gid = wgid / nig, fm = gid * WGM, gsz = (nM - fm) < WGM ? (nM - fm) : WGM;
        u.pm = fm + ((wgid % nig) % gsz); u.pn = (wgid % nig) / gsz; u.e = 0; u.li = i;
        u.bptr = Bt + (size_t)u.pn * BM * K * 2;
        return true;
    }
    __device__ __forceinline__ unsigned a_off(const Unit& u, int r) const { return (unsigned)((u.pm * BM + r) * K * 2); }
};
}
struct Args { const float* in[25]; float* out; unsigned char* ws; int ph_lo, ph_hi; };
enum { I_X = 0, I_C, I_WADA, I_BADA, I_GMIX, I_WIN, I_CONVW, I_CONVB, I_WRGA, I_BRGA, I_WRGX, I_BRGX, I_LAM, I_SINKS, I_GATT, I_GLRU, I_WOUT, I_GFFN,
       I_WR, I_BR, I_WGU, I_BGU, I_WDN, I_BDN, I_GFIN };

struct Frame {
    LAS unsigned char* lds;
    int tid, lane, wave, G, bx;
    unsigned char* ws;
};

__device__ __forceinline__ void p0_transpose_item(const float* W, int K, int N, bf16_t* WT, int k0, int n0, int drow0, const float* kscale, LAS float* scr, int lane) {
#pragma unroll 8
    for (int i = 0; i < 32; ++i) { const int kk = 2 * i + (lane >> 5); float v = W[(size_t)(k0 + kk) * N + n0 + (lane & 31)]; if (kscale) v *= kscale[k0 + kk]; scr[kk * 33 + (lane & 31)] = v; }
    LDS_WAIT(); asm volatile("" ::: "memory");
    const int c = lane & 7;
#pragma unroll
    for (int j = 0; j < 4; ++j) { const int n = (lane >> 3) + 8 * j; const LAS float* s = scr + (8 * c) * 33 + n;
        u32x4 o; o.x = pk2(s[0 * 33], s[1 * 33]); o.y = pk2(s[2 * 33], s[3 * 33]); o.z = pk2(s[4 * 33], s[5 * 33]); o.w = pk2(s[6 * 33], s[7 * 33]);
        *(GAS u32x4*)(WT + (size_t)(drow0 + n) * K + k0 + 8 * c) = o; }
    LDS_WAIT(); asm volatile("" ::: "memory");
}

__device__ __forceinline__ void p0_phase(Frame& F, const Args& a) {
    unsigned char* ws = F.ws;
    if (F.bx < 192) {
        LAS float* cs = (LAS float*)F.lds;
        LAS float* red = (LAS float*)(F.lds + 32768);
        const float* c = a.in[I_C];
        for (int i = F.tid; i < 8 * 1024; i += NTHR) cs[i] = c[i];
        __syncthreads();
        const int col = F.tid & 31, kg = F.tid >> 5, j0 = F.bx * 32;
        const float* w = a.in[I_WADA] + j0 + col;
        float acc[8];
#pragma unroll
        for (int b = 0; b < 8; ++b) acc[b] = 0.f;
#pragma unroll 8
        for (int i = 0; i < 64; ++i) { const int k = kg + 16 * i; const float wv = w[(size_t)k * 6144];
#pragma unroll
            for (int b = 0; b < 8; ++b) acc[b] += cs[b * 1024 + k] * wv; }
#pragma unroll
        for (int b = 0; b < 8; ++b) red[(kg * 8 + b) * 32 + col] = acc[b];
        __syncthreads();
        if (F.tid < 256) { const int b = F.tid >> 5; float s = a.in[I_BADA][j0 + col];
#pragma unroll
            for (int g = 0; g < 16; ++g) s += red[(g * 8 + b) * 32 + col];
            ((float*)(ws + WS_MOD))[b * 6144 + j0 + col] = s; }
        __syncthreads();
    }
    { u32x4* L = (u32x4*)(ws + WS_LIST); const int n4 = NE * LISTCAP / 4; const unsigned dv = (unsigned)DUMP;
      for (int i = F.bx * NTHR + F.tid; i < n4; i += F.G * NTHR) L[i] = (u32x4){dv, dv, dv, dv};
      if (F.bx == 0 && F.tid < 128) ((u32x4*)(ws + WS_H + (size_t)T * D * 2))[F.tid] = (u32x4){0u, 0u, 0u, 0u}; }
    LAS float* scr = (LAS float*)(F.lds + F.wave * 16384);
    const int gw = F.bx * NWAVES + F.wave, NGW = F.G * NWAVES;
    constexpr int I_IN = 16 * 56, I_OUT = 16 * 32, I_GU = 32 * 16 * 64, I_DN = 32 * 16 * 32;
    constexpr int NITEMS = I_IN + I_OUT + I_GU + I_DN;
    for (int it = gw; it < NITEMS; it += NGW) {
        int r = it;
        if (r < I_IN) { const int kb = r / 56, nb = r % 56; p0_transpose_item(a.in[I_WIN], 1024, 1792, (bf16_t*)(ws + WS_WIN), kb * 64, nb * 32, nb * 32, nullptr, scr, F.lane); continue; } r -= I_IN;
        if (r < I_OUT) { const int kb = r / 32, nb = r % 32; const float* ks = (kb < 8) ? a.in[I_GATT] : (a.in[I_GLRU] - 512);
            p0_transpose_item(a.in[I_WOUT], 1024, 1024, (bf16_t*)(ws + WS_WOUT), kb * 64, nb * 32, nb * 32, ks, scr, F.lane); continue; } r -= I_OUT;
        if (r < I_GU) { const int e = r / 1024, q = r % 1024, kb = q / 64, nb = q % 64; const int n0 = nb * 32;
            const int drow = ((n0 & 1023) >> 7) * 256 + (n0 >> 10) * 128 + (n0 & 127);
            p0_transpose_item(a.in[I_WGU] + (size_t)e * 1024 * 2048, 1024, 2048, (bf16_t*)(ws + WS_WGU) + (size_t)e * 2048 * 1024, kb * 64, n0, drow, nullptr, scr, F.lane); continue; } r -= I_GU;
        { const int e = r / 512, q = r % 512, kb = q / 32, nb = q % 32;
            p0_transpose_item(a.in[I_WDN] + (size_t)e * 1024 * 1024, 1024, 1024, (bf16_t*)(ws + WS_WDN) + (size_t)e * 1024 * 1024, kb * 64, nb * 32, nb * 32, nullptr, scr, F.lane); }
    }
}

__device__ __forceinline__ void p1_phase(Frame& F, const Args& a) {
    const int gw = F.bx * NWAVES + F.wave, NGW = F.G * NWAVES;
    const float* mod = (const float*)(F.ws + WS_MOD);
    const GAS f32x4* g4 = (const GAS f32x4*)a.in[I_GMIX] + F.lane;
    for (int m = gw; m < T; m += NGW) {
        const int b = m / SEQ;
        const GAS f32x4* xr = (const GAS f32x4*)(a.in[I_X] + (size_t)m * D) + F.lane;
        f32x4 v[4]; float s = 0.f;
#pragma unroll
        for (int j = 0; j < 4; ++j) { v[j] = xr[64 * j]; s += (v[j].x * v[j].x + v[j].y * v[j].y) + (v[j].z * v[j].z + v[j].w * v[j].w); }
        const float rs = rsqrtf(wave_sum(s) * (1.f / D) + EPS);
        const GAS f32x4* sh = (const GAS f32x4*)(mod + b * 6144) + F.lane;
        const GAS f32x4* sc = (const GAS f32x4*)(mod + b * 6144 + 1024) + F.lane;
        GAS u32x2* o8 = (GAS u32x2*)((bf16_t*)(F.ws + WS_H) + (size_t)m * D) + F.lane;
#pragma unroll
        for (int j = 0; j < 4; ++j) { const f32x4 g = g4[64 * j], h = sh[64 * j], c = sc[64 * j];
            const f32x4 y = v[j] * rs * g * (c + 1.0f) + h;
            u32x2 w; w.x = pk2(y.x, y.y); w.y = pk2(y.z, y.w); o8[64 * j] = w; }
    }
}

struct EpiBf16 {
    static constexpr bool PERM = true, MIDK = false;
    bf16_t* O; int ldc;
    __device__ __forceinline__ void operator()(const f32x4 (&acc)[2][2][4][2], const pg8::Unit& u, int wr, int wc, int fr, int fq) const {
        const int row0 = u.pm * 256 + wr * 64 + fr, col0 = u.pn * 256 + wc * 32 + 8 * fq;
#pragma unroll
        for (int ai = 0; ai < 2; ++ai)
#pragma unroll
            for (int m = 0; m < 4; ++m) { bf16_t* rowp = O + (size_t)(row0 + ai * 128 + m * 16) * ldc + col0;
#pragma unroll
                for (int bj = 0; bj < 2; ++bj) { const f32x4 v0 = acc[ai][bj][m][0], v1 = acc[ai][bj][m][1];
                    u32x4 w; w.x = cvt_pk_bf16(v0[0], v0[1]); w.y = cvt_pk_bf16(v0[2], v0[3]); w.z = cvt_pk_bf16(v1[0], v1[1]); w.w = cvt_pk_bf16(v1[2], v1[3]);
                    *(u32x4*)(rowp + bj * 128) = w; } }
    }
    __device__ __forceinline__ void mid(f32x4 (&acc)[2][2][4][2], const pg8::Unit& u, int wr, int wc, int fr, int fq) const {}
};
__device__ __forceinline__ int crow(int r, int hi) { return (r & 3) + 8 * (r >> 2) + 4 * hi; }
__device__ __forceinline__ s16x4 vtr(const LAS unsigned char* p) {
    typedef short v4i16_t __attribute__((ext_vector_type(4)));
    return __builtin_bit_cast(s16x4, __builtin_amdgcn_ds_read_tr16_b64_v4i16((LAS v4i16_t*)p));
}

__device__ __forceinline__ void attn_item(Frame& F, const Args& a, int item) {
    const int b = item >> 5, n = (item >> 1) & 15, j = item & 1;
    const bf16_t* P = (const bf16_t*)(F.ws + WS_P);
    LAS unsigned char* Kl = F.lds;
    LAS unsigned char* Vl = F.lds + 32768;
    LAS unsigned char* ost = F.lds + 65536 + F.wave * 4608;
    LAS float* wsf = (LAS float*)(ost + 4096);
    const int lane = F.lane, ql = lane & 31, hi = lane >> 5;
    {
        const int row = F.tid >> 1, half = F.tid & 1;
        int tb = 128 * (n - 1) + row; if (tb < 0) tb += 128;
        const bf16_t* src = P + (size_t)(b * SEQ + tb) * NCOL + 64 * j;
#pragma unroll
        for (int i = 0; i < 4; ++i) { const int c = half * 4 + i;
            const u32x4 kv = *(const GAS u32x4*)(src + KOFF + 8 * c);
            const u32x4 vv = *(const GAS u32x4*)(src + VOFF + 8 * c);
            *(LAS u32x4*)(Kl + row * 128 + ((c ^ (row & 7)) * 16)) = kv;
            *(LAS u32x4*)(Vl + row * 128 + c * 16) = vv; }
    }
    __syncthreads();
    const int g = F.wave >> 1, qh = F.wave & 1, h = 4 * j + g;
    const float sink = a.in[I_SINKS][h];
    constexpr float L2E = 1.4426950408889634f, C1 = 0.125f * 1.4426950408889634f;
    for (int qb = 0; qb < 2; ++qb) {
        const int o = 64 * qh + 32 * qb;
        const int tq0 = b * SEQ + 128 * n + o;
        bf16x8 qr[4];
#pragma unroll
        for (int d0 = 0; d0 < 4; ++d0) qr[d0] = *(const GAS bf16x8*)(P + (size_t)(tq0 + ql) * NCOL + QOFF + 64 * h + 16 * d0 + 8 * hi);
        f32x16 S[5];
#pragma unroll
        for (int kt = 0; kt < 5; ++kt) {
            const int key = o + 32 * kt + ql;
            f32x16 acc = {};
#pragma unroll
            for (int d0 = 0; d0 < 4; ++d0) { const int c = 2 * d0 + hi;
                const bf16x8 kf = *(const LAS bf16x8*)(Kl + key * 128 + ((c ^ (key & 7)) * 16));
                acc = __builtin_amdgcn_mfma_f32_32x32x16_bf16(kf, qr[d0], acc, 0, 0, 0); }
            S[kt] = acc;
        }
        constexpr float NEG = -1.0e30f;
#pragma unroll
        for (int r = 0; r < 16; ++r) { const int cr = crow(r, hi);
            if (!(cr > ql)) S[0][r] = NEG;
            if (!(cr <= ql)) S[4][r] = NEG; }
        if (n == 0) {
#pragma unroll
            for (int kt = 0; kt < 4; ++kt)
#pragma unroll
                for (int r = 0; r < 16; ++r) if (o + 32 * kt + crow(r, hi) < 128) S[kt][r] = NEG;
        }
        float mx = NEG;
#pragma unroll
        for (int kt = 0; kt < 5; ++kt)
#pragma unroll
            for (int r = 0; r < 16; ++r) mx = fmaxf(mx, S[kt][r]);
        mx = fmaxf(mx, __shfl_xor(mx, 32));
        const float m = fmaxf(mx * 0.125f, sink);
        const float mb = m * L2E;
        float l = 0.f;
#pragma unroll
        for (int kt = 0; kt < 5; ++kt)
#pragma unroll
            for (int r = 0; r < 16; ++r) { const float p = __builtin_amdgcn_exp2f(S[kt][r] * C1 - mb); S[kt][r] = p; l += p; }
        l += __shfl_xor(l, 32);
        l += __builtin_amdgcn_exp2f((sink - m) * L2E);
        if (hi == 0) wsf[ql] = 1.0f / l;
        f32x16 O0 = {}, O1 = {};
        const int gi = (lane >> 4) & 1, li = lane & 15;
        const LAS unsigned char* vb = Vl + (o + 4 * hi + (li >> 2)) * 128 + (16 * gi + 4 * (li & 3)) * 2;
#pragma unroll
        for (int kt = 0; kt < 5; ++kt)
#pragma unroll
            for (int s = 0; s < 2; ++s) {
                bf16x8 pa;
                { const f32x16& X = S[kt];
                  const unsigned w0 = cvt_pk_bf16(X[8 * s + 0], X[8 * s + 1]), w1 = cvt_pk_bf16(X[8 * s + 2], X[8 * s + 3]);
                  const unsigned w2 = cvt_pk_bf16(X[8 * s + 4], X[8 * s + 5]), w3 = cvt_pk_bf16(X[8 * s + 6], X[8 * s + 7]);
                  pa = __builtin_bit_cast(bf16x8, (u32x4){w0, w1, w2, w3}); }
                const LAS unsigned char* vp = vb + (32 * kt + 16 * s) * 128;
                const s16x4 lo0 = vtr(vp), hi0 = vtr(vp + 8 * 128);
                const s16x4 lo1 = vtr(vp + 64), hi1 = vtr(vp + 8 * 128 + 64);
                const bf16x8 v0 = (bf16x8){lo0[0], lo0[1], lo0[2], lo0[3], hi0[0], hi0[1], hi0[2], hi0[3]};
                const bf16x8 v1 = (bf16x8){lo1[0], lo1[1], lo1[2], lo1[3], hi1[0], hi1[1], hi1[2], hi1[3]};
                O0 = __builtin_amdgcn_mfma_f32_32x32x16_bf16(pa, v0, O0, 0, 0, 0);
                O1 = __builtin_amdgcn_mfma_f32_32x32x16_bf16(pa, v1, O1, 0, 0, 0);
            }
        LDS_WAIT(); asm volatile("" ::: "memory");
#pragma unroll
        for (int r = 0; r < 16; ++r) { const int q = crow(r, hi); const float il = wsf[q];
            *(LAS unsigned short*)(ost + q * 128 + ql * 2) = (unsigned short)f2bf(O0[r] * il);
            *(LAS unsigned short*)(ost + q * 128 + (32 + ql) * 2) = (unsigned short)f2bf(O1[r] * il); }
        LDS_WAIT(); asm volatile("" ::: "memory");
        bf16_t* MIXp = (bf16_t*)(F.ws + WS_MIX);
        float* SSQA = (float*)(F.ws + WS_SSQA);
#pragma unroll
        for (int i = 0; i < 4; ++i) { const int id = lane + 64 * i, row = id >> 3, ch = id & 7;
            const u32x4 w = *(const LAS u32x4*)(ost + row * 128 + ch * 16);
            *(GAS u32x4*)(MIXp + (size_t)(tq0 + row) * D + 64 * h + 8 * ch) = w;
            float ss = bflo(w.x) * bflo(w.x) + bfhi(w.x) * bfhi(w.x) + bflo(w.y) * bflo(w.y) + bfhi(w.y) * bfhi(w.y)
                     + bflo(w.z) * bflo(w.z) + bfhi(w.z) * bfhi(w.z) + bflo(w.w) * bflo(w.w) + bfhi(w.w) * bfhi(w.w);
            ss += __shfl_xor(ss, 1); ss += __shfl_xor(ss, 2); ss += __shfl_xor(ss, 4);
            if (ch == 0) SSQA[(size_t)(tq0 + row) * 8 + h] = ss; }
        LDS_WAIT(); asm volatile("" ::: "memory");
    }
    __syncthreads();
}

__device__ __forceinline__ void lru_item(Frame& F, const Args& a, int item) {
    const int b = item >> 5, hb = (item >> 2) & 7, qt = item & 3;
    const int c0 = hb * 64 + qt * 16;
    const bf16_t* P = (const bf16_t*)(F.ws + WS_P);
    constexpr int PITCH = 260;
    LAS unsigned char* XC = F.lds;
    LAS float* XCF = (LAS float*)(F.lds + 32768);
    LAS float* AA = XCF + 16 * PITCH;
    LAS float* UU = AA + 16 * PITCH;
    LAS float* XG = UU + 16 * PITCH;
    LAS float* OUT = XG + 16 * PITCH;
    const int tid = F.tid, lane = F.lane, w = F.wave;
    const int cg = tid & 7, tg = tid >> 3;
    float cw[4][8], cb[8];
#pragma unroll
    for (int e = 0; e < 8; ++e) { cb[e] = a.in[I_CONVB][hb * 64 + 8 * cg + e];
#pragma unroll
        for (int k = 0; k < 4; ++k) cw[k][e] = a.in[I_CONVW][k * 512 + hb * 64 + 8 * cg + e]; }
    bf16x8 wb[2][2];
    { const int nn = lane & 15, kq = lane >> 4;
#pragma unroll
      for (int nt = 0; nt < 2; ++nt) { const float* Wg = (nt == 0 ? a.in[I_WRGA] : a.in[I_WRGX]) + (size_t)hb * 64 * 64 + qt * 16 + nn;
#pragma unroll
        for (int ks = 0; ks < 2; ++ks) { unsigned pw[4];
#pragma unroll
            for (int jj = 0; jj < 4; ++jj) { const int k = 32 * ks + 8 * kq + 2 * jj; pw[jj] = pk2(Wg[(size_t)k * 64], Wg[(size_t)(k + 1) * 64]); }
            wb[nt][ks] = __builtin_bit_cast(bf16x8, (u32x4){pw[0], pw[1], pw[2], pw[3]}); } } }
    const int chn = c0 + (lane & 15);
    const float ba = a.in[I_BRGA][chn], bx = a.in[I_BRGX][chn];
    const float lg8 = -8.0f * log1pf(expf(-a.in[I_LAM][chn]));
    float hcarry = 0.f;
    bf16_t* MIXp = (bf16_t*)(F.ws + WS_MIX);
    float* SSQL = (float*)(F.ws + WS_SSQL);
    for (int tile = 0; tile < 8; ++tile) {
        const int t0 = tile * 256;
        const size_t tokbase = (size_t)b * SEQ + t0;
        {
            f32x4 xin[7][2];
#pragma unroll
            for (int rr = 0; rr < 7; ++rr) { const int s = t0 + 4 * tg - 3 + rr;
                u32x4 v = (u32x4){0u, 0u, 0u, 0u};
                if (s >= 0) v = *(const GAS u32x4*)(P + ((size_t)b * SEQ + s) * NCOL + XROFF + hb * 64 + 8 * cg);
                xin[rr][0] = (f32x4){bflo(v.x), bfhi(v.x), bflo(v.y), bfhi(v.y)};
                xin[rr][1] = (f32x4){bflo(v.z), bfhi(v.z), bflo(v.w), bfhi(v.w)}; }
            float xo[4][8];
#pragma unroll
            for (int tt = 0; tt < 4; ++tt)
#pragma unroll
                for (int e = 0; e < 8; ++e) { float acc = cb[e];
#pragma unroll
                    for (int k = 0; k < 4; ++k) acc += cw[k][e] * xin[tt + k][e >> 2][e & 3];
                    xo[tt][e] = acc; }
#pragma unroll
            for (int tt = 0; tt < 4; ++tt) { const int tl = 4 * tg + tt;
                u32x4 pkv; pkv.x = pk2(xo[tt][0], xo[tt][1]); pkv.y = pk2(xo[tt][2], xo[tt][3]); pkv.z = pk2(xo[tt][4], xo[tt][5]); pkv.w = pk2(xo[tt][6], xo[tt][7]);
                *(LAS u32x4*)(XC + tl * 128 + ((cg ^ (tl & 7)) * 16)) = pkv; }
            if ((cg >> 1) == qt) {
#pragma unroll
                for (int e = 0; e < 8; ++e) *(LAS f32x4*)(XCF + ((cg & 1) * 8 + e) * PITCH + 4 * tg) = (f32x4){xo[0][e], xo[1][e], xo[2][e], xo[3][e]};
            }
            { const int tk = tid >> 1, hf = tid & 1;
              const u32x4 v = *(const GAS u32x4*)(P + (tokbase + tk) * NCOL + XGOFF + c0 + 8 * hf);
              const float xv[8] = {bflo(v.x), bfhi(v.x), bflo(v.y), bfhi(v.y), bflo(v.z), bfhi(v.z), bflo(v.w), bfhi(v.w)};
#pragma unroll
              for (int e = 0; e < 8; ++e) XG[(hf * 8 + e) * PITCH + tk] = xv[e]; }
        }
        __syncthreads();
        {
            const int kq = lane >> 4, rl = lane & 15;
#pragma unroll
            for (int mt = 0; mt < 2; ++mt) {
                const int row = 32 * w + 16 * mt + rl;
                f32x4 accR = {0.f, 0.f, 0.f, 0.f}, accI = {0.f, 0.f, 0.f, 0.f};
#pragma unroll
                for (int ks = 0; ks < 2; ++ks) { const int c = 4 * ks + kq;
                    const bf16x8 af = *(const LAS bf16x8*)(XC + row * 128 + ((c ^ (row & 7)) * 16));
                    accR = __builtin_amdgcn_mfma_f32_16x16x32_bf16(af, wb[0][ks], accR, 0, 0, 0);
                    accI = __builtin_amdgcn_mfma_f32_16x16x32_bf16(af, wb[1][ks], accI, 0, 0, 0); }
                const int tl0 = 32 * w + 16 * mt + 4 * kq;
                const f32x4 xcf = *(const LAS f32x4*)(XCF + rl * PITCH + tl0);
                f32x4 av, uv;
#pragma unroll
                for (int r = 0; r < 4; ++r) {
                    const float rg = 1.0f / (1.0f + __expf(-(accR[r] + ba)));
                    const float ig = 1.0f / (1.0f + __expf(-(accI[r] + bx)));
                    const float log_a = rg * lg8;
                    av[r] = __expf(log_a);
                    uv[r] = sqrtf(fmaxf(-expm1f(2.0f * log_a), 0.0f)) * (ig * xcf[r]);
                }
                *(LAS f32x4*)(AA + rl * PITCH + tl0) = av;
                *(LAS f32x4*)(UU + rl * PITCH + tl0) = uv;
            }
        }
        __syncthreads();
        {
            const int ch = 2 * w + (lane >> 5), chunk = lane & 31;
            const f32x4 a0 = *(const LAS f32x4*)(AA + ch * PITCH + 8 * chunk), a1 = *(const LAS f32x4*)(AA + ch * PITCH + 8 * chunk + 4);
            const f32x4 u0 = *(const LAS f32x4*)(UU + ch * PITCH + 8 * chunk), u1 = *(const LAS f32x4*)(UU + ch * PITCH + 8 * chunk + 4);
            const float av[8] = {a0[0], a0[1], a0[2], a0[3], a1[0], a1[1], a1[2], a1[3]};
            const float uv[8] = {u0[0], u0[1], u0[2], u0[3], u1[0], u1[1], u1[2], u1[3]};
            float Ac = 1.f, Hc = 0.f;
#pragma unroll
            for (int s = 0; s < 8; ++s) { Hc = av[s] * Hc + uv[s]; Ac *= av[s]; }
#pragma unroll
            for (int off = 1; off < 32; off <<= 1) {
                const float Ap = __shfl_up(Ac, off, 32), Hp = __shfl_up(Hc, off, 32);
                if (chunk >= off) { Hc = Ac * Hp + Hc; Ac = Ac * Ap; }
            }
            float Ae = __shfl_up(Ac, 1, 32), He = __shfl_up(Hc, 1, 32);
            if (chunk == 0) { Ae = 1.f; He = 0.f; }
            float hh = He + Ae * hcarry;
            const float Hl = __shfl(Hc, 31, 32), Al = __shfl(Ac, 31, 32);
            hcarry = Hl + Al * hcarry;
            const f32x4 g0 = *(const LAS f32x4*)(XG + ch * PITCH + 8 * chunk), g1 = *(const LAS f32x4*)(XG + ch * PITCH + 8 * chunk + 4);
            const float gv[8] = {g0[0], g0[1], g0[2], g0[3], g1[0], g1[1], g1[2], g1[3]};
            float yo[8];
#pragma unroll
            for (int s = 0; s < 8; ++s) { hh = av[s] * hh + uv[s];
                const float x = gv[s];
                const float z2 = 1.5957691216057308f * (x + 0.044715f * x * x * x);
                yo[s] = hh * (x / (1.0f + __expf(-z2))); }
            *(LAS f32x4*)(OUT + ch * PITCH + 8 * chunk) = (f32x4){yo[0], yo[1], yo[2], yo[3]};
            *(LAS f32x4*)(OUT + ch * PITCH + 8 * chunk + 4) = (f32x4){yo[4], yo[5], yo[6], yo[7]};
        }
        __syncthreads();
        {
            const int tk = tid >> 1, hf = tid & 1;
            float yv[8];
#pragma unroll
            for (int e = 0; e < 8; ++e) yv[e] = OUT[(hf * 8 + e) * PITCH + tk];
            u32x4 o; o.x = pk2(yv[0], yv[1]); o.y = pk2(yv[2], yv[3]); o.z = pk2(yv[4], yv[5]); o.w = pk2(yv[6], yv[7]);
            *(GAS u32x4*)(MIXp + (tokbase + tk) * D + 512 + c0 + 8 * hf) = o;
            float ss = bflo(o.x) * bflo(o.x) + bfhi(o.x) * bfhi(o.x) + bflo(o.y) * bflo(o.y) + bfhi(o.y) * bfhi(o.y)
                     + bflo(o.z) * bflo(o.z) + bfhi(o.z) * bfhi(o.z) + bflo(o.w) * bflo(o.w) + bfhi(o.w) * bfhi(o.w);
            ss += __shfl_xor(ss, 1);
            if (hf == 0) SSQL[(tokbase + tk) * 32 + hb * 4 + qt] = ss;
        }
    }
    __syncthreads();
}

struct EpiX1 {
    static constexpr bool PERM = false, MIDK = true;
    const float* x; const float* mod; float* X1; float* SSQ1; const LAS f32x2* RS;
    __device__ __forceinline__ void mid(f32x4 (&acc)[2][2][4][2], const pg8::Unit& u, int wr, int wc, int fr, int fq) const {
#pragma unroll
        for (int ai = 0; ai < 2; ++ai)
#pragma unroll
            for (int m = 0; m < 4; ++m) { const float f = RS[ai * 128 + wr * 64 + m * 16 + fr].x;
#pragma unroll
                for (int bj = 0; bj < 2; ++bj)
#pragma unroll
                    for (int n = 0; n < 2; ++n) acc[ai][bj][m][n] = acc[ai][bj][m][n] * f; }
    }
    __device__ __forceinline__ void operator()(const f32x4 (&acc)[2][2][4][2], const pg8::Unit& u, int wr, int wc, int fr, int fq) const {
        const int col0 = u.pn * 256 + wc * 32 + 4 * fq;
        const int b = (u.pm * 256) / SEQ;
        f32x4 gt[2][2];
#pragma unroll
        for (int bj = 0; bj < 2; ++bj)
#pragma unroll
            for (int n = 0; n < 2; ++n) gt[bj][n] = *(const f32x4*)(mod + b * 6144 + 2048 + col0 + bj * 128 + n * 16);
#pragma unroll
        for (int ai = 0; ai < 2; ++ai)
#pragma unroll
            for (int m = 0; m < 4; ++m) { const int r = ai * 128 + wr * 64 + m * 16 + fr; const float f = RS[r].y;
                const size_t off = (size_t)(u.pm * 256 + r) * D + col0; float ss = 0.f;
#pragma unroll
                for (int bj = 0; bj < 2; ++bj)
#pragma unroll
                    for (int n = 0; n < 2; ++n) { const f32x4 xv = *(const f32x4*)(x + off + bj * 128 + n * 16);
                        const f32x4 o = xv + gt[bj][n] * (acc[ai][bj][m][n] * f);
                        *(f32x4*)(X1 + off + bj * 128 + n * 16) = o;
                        ss += (o[0] * o[0] + o[1] * o[1]) + (o[2] * o[2] + o[3] * o[3]); }
                ss += __shfl_xor(ss, 16); ss += __shfl_xor(ss, 32);
                if (fq == 0) SSQ1[(size_t)(u.pm * 256 + r) * 16 + u.pn * 4 + wc] = ss; }
    }
};
__device__ __forceinline__ void p5_phase(Frame& F, const Args& a) {
    unsigned char* ws = F.ws;
    const float* X1 = (const float*)(ws + WS_X1);
    const float* mod = (const float*)(ws + WS_MOD);
    LAS float* WR = (LAS float*)F.lds;
    LAS float* TAB = (LAS float*)(F.lds + TAB_OFF);
    LAS float* CST = TAB;
    LAS float* RSQ = TAB + 32;
    LAS int* LCNT = (LAS int*)(TAB + 96);
    LAS int* LBASE = (LAS int*)(TAB + 128);
    LAS float* LG = TAB + 160;
    LAS float* CRED = TAB + 160 + 64 * 33;
    const int tid = F.tid, lane = F.lane, w = F.wave;
    for (int tile = F.bx; tile < T / 64; tile += F.G) {
        const int tok0 = tile * 64, b = tok0 / SEQ;
        const float* sh2 = mod + b * 6144 + 3072; const float* sc2 = mod + b * 6144 + 4096;
        { const int e = tid & 31, part = tid >> 5; float cp = 0.f;
          for (int i = 0; i < 64; ++i) { const int k = part * 64 + i; const float wv = a.in[I_WR][k * 32 + e];
              WR[k * 32 + e] = a.in[I_GFFN][k] * (1.0f + sc2[k]) * wv; cp += sh2[k] * wv; }
          CRED[part * 32 + e] = cp;
          if (tid < 64) { const float* sp = (const float*)(ws + WS_SSQ1) + (size_t)(tok0 + tid) * 16; float s = 0.f;
#pragma unroll
              for (int i = 0; i < 16; ++i) s += sp[i];
              RSQ[tid] = rsqrtf(s * (1.0f / D) + EPS); }
          if (tid < 32) LCNT[tid] = 0; }
        __syncthreads();
        if (tid < 32) { float s = a.in[I_BR][tid];
#pragma unroll
            for (int p = 0; p < 16; ++p) s += CRED[p * 32 + tid];
            CST[tid] = s; }
        f32x16 acc = {};
        { const int tw = w >> 2, kq4 = w & 3, i = lane & 31, hi = lane >> 5;
          const float* xrow = X1 + (size_t)(tok0 + 32 * tw + i) * D + 256 * kq4 + 128 * hi;
          const LAS float* wrow = WR + (256 * kq4 + 128 * hi) * 32 + i;
#pragma unroll 1
          for (int c4 = 0; c4 < 4; ++c4) {
              f32x4 xv[8];
#pragma unroll
              for (int q = 0; q < 8; ++q) xv[q] = *(const GAS f32x4*)(xrow + 32 * c4 + 4 * q);
#pragma unroll
              for (int q = 0; q < 8; ++q)
#pragma unroll
                  for (int r = 0; r < 4; ++r) { const int s = 32 * c4 + 4 * q + r;
                      acc = __builtin_amdgcn_mfma_f32_32x32x2f32(xv[q][r], wrow[s * 32], acc, 0, 0, 0); }
          } }
        __syncthreads();
        {
          LAS float* PART = WR + w * (32 * 33); const int e = lane & 31, hi = lane >> 5;
#pragma unroll
          for (int r = 0; r < 16; ++r) PART[crow(r, hi) * 33 + e] = acc[r]; }
        __syncthreads();
        {
          const int tk = tid >> 3, e0 = (tid & 7) * 4, tw = tk >> 5, tl = tk & 31; const float rs = RSQ[tk];
#pragma unroll
          for (int j = 0; j < 4; ++j) { float s = 0.f;
#pragma unroll
              for (int q = 0; q < 4; ++q) s += WR[(tw * 4 + q) * (32 * 33) + tl * 33 + e0 + j];
              LG[tk * 33 + e0 + j] = rs * s + CST[e0 + j]; } }
        __syncthreads();
        int eidx[4] = {0, 0, 0, 0}; int lpos[4] = {0, 0, 0, 0};
        if (tid < 64) {
            float val[4]; unsigned used = 0u;
#pragma unroll
            for (int k = 0; k < 4; ++k) { float best = -3.0e38f; int bi = 0;
                for (int j = 0; j < 32; ++j) { const float v = LG[tid * 33 + j]; if (!((used >> j) & 1u) && v > best) { best = v; bi = j; } }
                used |= 1u << bi; eidx[k] = bi; val[k] = best; }
            float ex[4], den = 0.f;
#pragma unroll
            for (int k = 0; k < 4; ++k) { ex[k] = __expf(val[k] - val[0]); den += ex[k]; }
            const float inv = 1.0f / den;
            *(f32x4*)((float*)(ws + WS_TOPG) + (size_t)(tok0 + tid) * 4) = (f32x4){ex[0] * inv, ex[1] * inv, ex[2] * inv, ex[3] * inv};
#pragma unroll
            for (int k = 0; k < 4; ++k) lpos[k] = __hip_atomic_fetch_add(LCNT + eidx[k], 1, __ATOMIC_RELAXED, __HIP_MEMORY_SCOPE_WORKGROUP);
        }
        __syncthreads();
        if (tid < 32) { const int c = LCNT[tid]; LBASE[tid] = c > 0 ? (int)__hip_atomic_fetch_add((unsigned*)(ws + WS_CTL) + CW_CNT + tid, (unsigned)c, RLX_AGENT) : 0; }
        __syncthreads();
        if (tid < 64) {
#pragma unroll
            for (int k = 0; k < 4; ++k) ((int*)(ws + WS_LIST))[eidx[k] * LISTCAP + LBASE[eidx[k]] + lpos[k]] = (tok0 + tid) * 4 + k;
        }
        for (int tk = w; tk < 64; tk += NWAVES) {
            const int m = tok0 + tk; const float rs = RSQ[tk];
            const GAS f32x4* xr = (const GAS f32x4*)(X1 + (size_t)m * D) + lane;
            const GAS f32x4* g4 = (const GAS f32x4*)a.in[I_GFFN] + lane;
            const GAS f32x4* sh = (const GAS f32x4*)sh2 + lane; const GAS f32x4* sc = (const GAS f32x4*)sc2 + lane;
            GAS u32x2* o8 = (GAS u32x2*)((bf16_t*)(ws + WS_H) + (size_t)m * D) + lane;
#pragma unroll
            for (int j = 0; j < 4; ++j) { const f32x4 y = xr[64 * j] * rs * g4[64 * j] * (sc[64 * j] + 1.0f) + sh[64 * j];
                u32x2 o; o.x = pk2(y.x, y.y); o.y = pk2(y.z, y.w); o8[64 * j] = o; }
        }
        __syncthreads();
    }
}

struct GroupedOrder {
    const LAS int* TP; const LAS unsigned* AOFF;
    int ntiles, npn, nun, G, c, K; const char* Wt; size_t estride;
    __device__ __forceinline__ bool next(int i, pg8::Unit& u) const {
        const long L = (long)i * G + c; if (L >= nun) return false;
        int wgid = (int)L; { const int q = nun / 8, r = nun % 8, xcd = wgid % 8, off = wgid / 8; wgid = (xcd < r ? xcd * (q + 1) : r * (q + 1) + (xcd - r) * q) + off; }
        const int WGM = 8;
        const int nig = WGM * npn, gid = wgid / nig, fm = gid * WGM, gsz = (ntiles - fm) < WGM ? (ntiles - fm) : WGM;
        u.pm = fm + ((wgid % nig) % gsz); u.pn = (wgid % nig) / gsz; u.li = i;
        int e = 0;
        for (int j = 1; j < NE; ++j) e += (TP[j] <= u.pm) ? 1 : 0;
        u.e = e;
        u.bptr = Wt + (size_t)e * estride + (size_t)u.pn * 256 * K * 2;
        return true;
    }
    __device__ __forceinline__ unsigned a_off(const pg8::Unit& u, int r) const {
        if (AOFF) return AOFF[u.li * 256 + r];
        return (unsigned)((u.pm * 256 + r) * K * 2);
    }
};

struct EpiSwiglu {
    static constexpr bool PERM = true, MIDK = false;
    bf16_t* ACT; const float* b_gu;
    __device__ __forceinline__ void mid(f32x4 (&acc)[2][2][4][2], const pg8::Unit& u, int wr, int wc, int fr, int fq) const {}
    __device__ __forceinline__ void operator()(const f32x4 (&acc)[2][2][4][2], const pg8::Unit& u, int wr, int wc, int fr, int fq) const {
        const int c0 = u.pn * 128 + wc * 32 + 8 * fq;
        const float* bg = b_gu + u.e * 2048 + c0;
        f32x4 bgate[2], bup[2];
#pragma unroll
        for (int n = 0; n < 2; ++n) { bgate[n] = *(const f32x4*)(bg + 4 * n); bup[n] = *(const f32x4*)(bg + 1024 + 4 * n); }
#pragma unroll
        for (int ai = 0; ai < 2; ++ai)
#pragma unroll
            for (int m = 0; m < 4; ++m) { const int r = ai * 128 + wr * 64 + m * 16 + fr;
                float o[8];
#pragma unroll
                for (int n = 0; n < 2; ++n)
#pragma unroll
                    for (int j = 0; j < 4; ++j) {
                        const float gate = fminf(acc[ai][0][m][n][j] + bgate[n][j], 7.0f);
                        const float up = fminf(fmaxf(acc[ai][1][m][n][j] + bup[n][j], -7.0f), 7.0f);
                        const float glu = gate * __builtin_amdgcn_rcpf(1.0f + __expf(-1.702f * gate));
                        o[4 * n + j] = (up + 1.0f) * glu; }
                u32x4 w; w.x = cvt_pk_bf16(o[0], o[1]); w.y = cvt_pk_bf16(o[2], o[3]); w.z = cvt_pk_bf16(o[4], o[5]); w.w = cvt_pk_bf16(o[6], o[7]);
                *(u32x4*)(ACT + (size_t)(u.pm * 256 + r) * 1024 + c0) = w; }
    }
};
struct EpiDown {
    static constexpr bool PERM = true, MIDK = false;
    bf16_t* YB; const float* b_dn; const LAS int* SLOT;
    __device__ __forceinline__ void mid(f32x4 (&acc)[2][2][4][2], const pg8::Unit& u, int wr, int wc, int fr, int fq) const {}
    __device__ __forceinline__ void operator()(const f32x4 (&acc)[2][2][4][2], const pg8::Unit& u, int wr, int wc, int fr, int fq) const {
        const int col0 = u.pn * 256 + wc * 32 + 8 * fq;
        const float* bd = b_dn + u.e * 1024 + col0;
        f32x4 bv[2][2];
#pragma unroll
        for (int bj = 0; bj < 2; ++bj)
#pragma unroll
            for (int n = 0; n < 2; ++n) bv[bj][n] = *(const f32x4*)(bd + bj * 128 + 4 * n);
#pragma unroll
        for (int ai = 0; ai < 2; ++ai)
#pragma unroll
            for (int m = 0; m < 4; ++m) { const int r = ai * 128 + wr * 64 + m * 16 + fr;
                const int slot = SLOT[u.li * 256 + r];
                bf16_t* rowp = YB + (size_t)slot * 1024 + col0;
#pragma unroll
                for (int bj = 0; bj < 2; ++bj) { const f32x4 v0 = acc[ai][bj][m][0] + bv[bj][0], v1 = acc[ai][bj][m][1] + bv[bj][1];
                    u32x4 w; w.x = cvt_pk_bf16(v0[0], v0[1]); w.y = cvt_pk_bf16(v0[2], v0[3]); w.z = cvt_pk_bf16(v1[0], v1[1]); w.w = cvt_pk_bf16(v1[2], v1[3]);
                    *(u32x4*)(rowp + bj * 128) = w; } }
    }
};

template <int MODE>
__device__ __forceinline__ void grouped_setup(Frame& F, GroupedOrder& S, int npn, const void* Wt, size_t estride) {
    LAS int* TP = (LAS int*)(F.lds + TAB_OFF);
    LAS unsigned* TABR = (LAS unsigned*)(F.lds + TAB_OFF + 256);
    const unsigned* cnt = (const unsigned*)(F.ws + WS_CTL) + CW_CNT;
    if (F.tid == 0) { int acc = 0;
        for (int e = 0; e < NE; ++e) { TP[e] = acc; const int c = (int)__hip_atomic_load(cnt + e, RLX_AGENT); acc += (c + 255) >> 8; }
        TP[NE] = acc; }
    __syncthreads();
    S.TP = TP; S.AOFF = (MODE == 1) ? (const LAS unsigned*)TABR : nullptr;
    S.ntiles = TP[NE]; S.npn = npn; S.nun = S.ntiles * npn; S.G = F.G; S.c = F.bx; S.K = 1024; S.Wt = (const char*)Wt; S.estride = estride;
    const int* LIST = (const int*)(F.ws + WS_LIST);
    pg8::Unit u;
    for (int li = 0; li < 12 && S.next(li, u); ++li) {
        if (F.tid < 256) { const int slot = LIST[u.e * LISTCAP + (u.pm - TP[u.e]) * 256 + F.tid];
            TABR[li * 256 + F.tid] = (MODE == 1) ? (unsigned)(slot >> 2) * 2048u : (unsigned)slot; }
    }
    __syncthreads();
}

__device__ __forceinline__ void p8_phase(Frame& F, const Args& a) {
    const int gw = F.bx * NWAVES + F.wave, NGW = F.G * NWAVES, lane = F.lane;
    const float* X1 = (const float*)(F.ws + WS_X1); const float* mod = (const float*)(F.ws + WS_MOD);
    const bf16_t* YB = (const bf16_t*)(F.ws + WS_YB); const float* TOPG = (const float*)(F.ws + WS_TOPG);
    const GAS f32x4* gf = (const GAS f32x4*)a.in[I_GFIN] + lane;
    for (int m = gw; m < T; m += NGW) {
        const int b = m / SEQ;
        const f32x4 gk = *(const f32x4*)(TOPG + (size_t)m * 4);
        const GAS f32x4* xr = (const GAS f32x4*)(X1 + (size_t)m * D) + lane;
        const GAS f32x4* g2 = (const GAS f32x4*)(mod + b * 6144 + 5120) + lane;
        f32x4 v[4]; float ss = 0.f;
#pragma unroll
        for (int j = 0; j < 4; ++j) { f32x4 s = {0.f, 0.f, 0.f, 0.f};
#pragma unroll
            for (int k = 0; k < 4; ++k) { const u32x2 y = *((const GAS u32x2*)(YB + (size_t)(m * 4 + k) * D) + lane + 64 * j);
                s += (f32x4){bflo(y.x), bfhi(y.x), bflo(y.y), bfhi(y.y)} * gk[k]; }
            v[j] = xr[64 * j] + g2[64 * j] * s;
            ss += (v[j].x * v[j].x + v[j].y * v[j].y) + (v[j].z * v[j].z + v[j].w * v[j].w); }
        const float rs = rsqrtf(wave_sum(ss) * (1.f / D) + EPS);
        GAS f32x4* o = (GAS f32x4*)(a.out + (size_t)m * D) + lane;
#pragma unroll
        for (int j = 0; j < 4; ++j) o[64 * j] = v[j] * rs * gf[64 * j];
    }
}
__global__ void __launch_bounds__(NTHR, 2) mega_fwd(Args args) {
    extern __shared__ __attribute__((aligned(16))) unsigned char lds_raw[];
    Frame F;
    F.lds = (LAS unsigned char*)lds_raw;
    F.tid = threadIdx.x; F.lane = F.tid & 63; F.wave = __builtin_amdgcn_readfirstlane(F.tid >> 6);
    F.G = gridDim.x; F.bx = blockIdx.x; F.ws = args.ws;
    volatile LAS unsigned* MISC = (volatile LAS unsigned*)(F.lds + LDSCTL_OFF);
    for (int u = F.tid; u < 128; u += NTHR) MISC[u] = 0u;
    __syncthreads();
    unsigned* ctl = (unsigned*)(args.ws + WS_CTL);
    XcdBarrier bar = xcd_barrier_post(ctl + CW_BAR, MISC + 8);
    const int lo = args.ph_lo, hi = args.ph_hi;
#define IN(k) (lo <= (k) && (k) < hi)
#define SEAM(k) do { if (IN(k) && IN((k) + 1)) xcd_barrier(bar); } while (0)
    if (IN(0)) { p0_phase(F, args); } SEAM(0);
    if (IN(1)) { p1_phase(F, args); } SEAM(1);
    if (IN(2)) {
        pg8::DenseOrder S; S.init(T, NCOL, D, args.ws + WS_WIN, F.G, F.bx);
        EpiBf16 E{(bf16_t*)(args.ws + WS_P), NCOL};
        pg8::gemm_phase<EpiBf16, pg8::DenseOrder, true>(F.lds, (const char*)(args.ws + WS_H), D, S, E);
    } SEAM(2);
    if (IN(3)) {
        for (int it = F.bx; it < 256; it += F.G) attn_item(F, args, it);
        for (int it = F.bx; it < 256; it += F.G) lru_item(F, args, it);
    } SEAM(3);
    if (IN(4)) {
        pg8::DenseOrder S; S.init(T, D, D, args.ws + WS_WOUT, F.G, F.bx);
        LAS f32x2* RS = (LAS f32x2*)(F.lds + TAB_OFF);
        pg8::Unit u0;
        if (S.next(0, u0)) {
            if (F.tid < 256) { const size_t tok = (size_t)u0.pm * 256 + F.tid;
                const float* sa = (const float*)(args.ws + WS_SSQA) + tok * 8; const float* sl = (const float*)(args.ws + WS_SSQL) + tok * 32;
                float ssa = 0.f, ssl = 0.f;
#pragma unroll
                for (int i = 0; i < 8; ++i) ssa += sa[i];
#pragma unroll
                for (int i = 0; i < 32; ++i) ssl += sl[i];
                const float ra = rsqrtf(ssa * (1.0f / 512) + EPS), rl = rsqrtf(ssl * (1.0f / 512) + EPS);
                RS[F.tid] = (f32x2){ra / rl, rl}; }
        }
        __syncthreads();
        EpiX1 E{args.in[I_X], (const float*)(args.ws + WS_MOD), (float*)(args.ws + WS_X1), (float*)(args.ws + WS_SSQ1), RS};
        pg8::gemm_phase<EpiX1, pg8::DenseOrder, false>(F.lds, (const char*)(args.ws + WS_MIX), D, S, E);
    } SEAM(4);
    if (IN(5)) { p5_phase(F, args); } SEAM(5);
    if (IN(6)) {
        GroupedOrder S; grouped_setup<1>(F, S, 8, args.ws + WS_WGU, (size_t)2048 * 1024 * 2);
        EpiSwiglu E{(bf16_t*)(args.ws + WS_ACT), args.in[I_BGU]};
        pg8::gemm_phase<EpiSwiglu, GroupedOrder, true>(F.lds, (const char*)(args.ws + WS_H), D, S, E);
    } SEAM(6);
    if (IN(7)) {
        GroupedOrder S; grouped_setup<2>(F, S, 4, args.ws + WS_WDN, (size_t)1024 * 1024 * 2);
        EpiDown E{(bf16_t*)(args.ws + WS_YB), args.in[I_BDN], (const LAS int*)(F.lds + TAB_OFF + 256)};
        pg8::gemm_phase<EpiDown, GroupedOrder, true>(F.lds, (const char*)(args.ws + WS_ACT), D, S, E);
    } SEAM(7);
    if (IN(8)) { p8_phase(F, args); }
#undef IN
#undef SEAM
}
}
extern "C" void kernel_launch(void* const* d_in, const int* in_sizes, int n_in, void* d_out, int out_size, void* d_ws, size_t ws_size,
                              hipStream_t stream) {
    static int grid = 0;
    if (grid == 0) {
        if (n_in != 25 || out_size != mk::T * mk::D || ws_size < mk::WS_END) { fprintf(stderr, "kernel_launch: unexpected problem shape (n_in %d out %d ws %zu)\n", n_in, out_size, ws_size); grid = -1; return; }
        int dev = 0, cus = 0, per_cu = 0;
        if (hipGetDevice(&dev) != hipSuccess || hipDeviceGetAttribute(&cus, hipDeviceAttributeMultiprocessorCount, dev) != hipSuccess) { grid = -1; return; }
        if (hipFuncSetAttribute((const void*)mk::mega_fwd, hipFuncAttributeMaxDynamicSharedMemorySize, mk::LDS_BYTES) != hipSuccess) { fprintf(stderr, "kernel_launch: hipFuncSetAttribute failed\n"); grid = -1; return; }
        if (hipOccupancyMaxActiveBlocksPerMultiprocessor(&per_cu, (const void*)mk::mega_fwd, mk::NTHR, mk::LDS_BYTES) != hipSuccess || per_cu < 1) { fprintf(stderr, "kernel_launch: occupancy query says %d workgroups per CU\n", per_cu); grid = -1; return; }
        grid = cus;
    }
    if (grid < 0) return;
    if (hipMemsetAsync((char*)d_ws + mk::WS_CTL, 0, mk::CTL_ZERO_BYTES, stream) != hipSuccess) return;
    mk::Args a{};
    for (int i = 0; i < 25; ++i) a.in[i] = (const float*)d_in[i];
    a.out = (float*)d_out; a.ws = (unsigned char*)d_ws; a.ph_lo = 0; a.ph_hi = 9;
    void* kargs[] = {&a};
    hipError_t le = hipLaunchCooperativeKernel((const void*)mk::mega_fwd, dim3(grid), dim3(mk::NTHR), kargs, mk::LDS_BYTES, stream);
    if (le != hipSuccess) fprintf(stderr, "kernel_launch: cooperative launch failed: %s (grid %d)\n", hipGetErrorString(le), grid);
}
```

```cpp
#include <hip/hip_runtime.h>
#include <stdint.h>
#include <stdio.h>
namespace mk {
#define LAS __attribute__((address_space(3)))
#define GAS __attribute__((address_space(1)))
typedef unsigned short bf16_t;
typedef short bf16x8 __attribute__((ext_vector_type(8)));
typedef short s16x4 __attribute__((ext_vector_type(4)));
typedef float f32x2 __attribute__((ext_vector_type(2)));
typedef float f32x4 __attribute__((ext_vector_type(4)));
typedef float f32x16 __attribute__((ext_vector_type(16)));
typedef unsigned u32x2 __attribute__((ext_vector_type(2)));
typedef unsigned u32x4 __attribute__((ext_vector_type(4)));

constexpr int NWAVES = 8, NTHR = 512;
constexpr int NB = 8, SEQ = 2048, D = 1024, T = NB * SEQ, NCOL = 1792, NE = 32;
constexpr int QOFF = 0, KOFF = 512, VOFF = 640, XROFF = 768, XGOFF = 1280;
constexpr int LISTCAP = 16384, DUMP = 65536, MAXTILES = 288;
constexpr float EPS = 1e-6f;

constexpr size_t MiB = 1u << 20;
constexpr size_t WS_CTL = 0, CTL_ZERO_BYTES = 64 * 1024;
constexpr int CW_CNT = 64;
constexpr int CW_BAR = 4096;
constexpr size_t WS_MOD = 1 * MiB;
constexpr size_t WS_CSTB = 1 * MiB + 256 * 1024;
constexpr size_t WS_TOPG = 2 * MiB;
constexpr size_t WS_WRP = 3 * MiB;
constexpr size_t WS_LIST = 4 * MiB;
constexpr size_t WS_SSQA = 6 * MiB;
constexpr size_t WS_SSQL = 7 * MiB;
constexpr size_t WS_SSQ1 = 9 * MiB;
constexpr size_t WS_WIN = 10 * MiB;
constexpr size_t WS_WOUT = 14 * MiB;
constexpr size_t WS_WGU = 16 * MiB;
constexpr size_t WS_WDN = 144 * MiB;
constexpr size_t WS_H = 208 * MiB;
constexpr size_t WS_P = 242 * MiB;
constexpr size_t WS_MIX = 298 * MiB;
constexpr size_t WS_X1 = 330 * MiB;
constexpr size_t WS_ACT = 394 * MiB;
constexpr size_t WS_YB = 538 * MiB;
constexpr size_t WS_END = 668 * MiB;

constexpr int RING_BYTES = 131072;
constexpr int LDSCTL_OFF = RING_BYTES;
constexpr int TAB_OFF = RING_BYTES + 512;
constexpr int LDS_BYTES = 147456;

#define RLX_AGENT __ATOMIC_RELAXED, __HIP_MEMORY_SCOPE_AGENT
#define LDS_WAIT() asm volatile("s_waitcnt lgkmcnt(0)" ::: "memory")
#define VM_WAIT() asm volatile("s_waitcnt vmcnt(0)" ::: "memory")
__device__ __forceinline__ unsigned f2bf(float f) { unsigned u = __builtin_bit_cast(unsigned, f); return (u + 0x7fffu + ((u >> 16) & 1u)) >> 16; }
__device__ __forceinline__ unsigned pk2(float lo, float hi) { return f2bf(lo) | (f2bf(hi) << 16); }
__device__ __forceinline__ float bf2f(unsigned short h) { return __builtin_bit_cast(float, (unsigned)h << 16); }
__device__ __forceinline__ float bflo(unsigned w) { return __builtin_bit_cast(float, w << 16); }
__device__ __forceinline__ float bfhi(unsigned w) { return __builtin_bit_cast(float, w & 0xffff0000u); }
__device__ __forceinline__ unsigned cvt_pk_bf16(float lo, float hi) { unsigned r; asm volatile("v_cvt_pk_bf16_f32 %0, %1, %2" : "=v"(r) : "v"(lo), "v"(hi)); return r; }
__device__ __forceinline__ float wave_sum(float v) {
#pragma unroll
    for (int o = 1; o < 64; o <<= 1) v += __shfl_xor(v, o);
    return v;
}

#define XB_TMO      128
#define XB_XCNT(j)  (256  + 64 * (j))
#define XB_XSUB(j)  (1280 + 64 * (j))
#define XB_XGEN(j)  (2304 + 64 * (j))
#define XB_TOP      3328
#define XB_TOPGEN   3392
#define XCD_BAR_WORDS 3456
#define XB_SPIN_CAP (1u << 20)
__device__ __forceinline__ unsigned xb_ld(unsigned* p)              { return __hip_atomic_load(p, __ATOMIC_RELAXED, __HIP_MEMORY_SCOPE_AGENT); }
__device__ __forceinline__ unsigned xb_add(unsigned* p, unsigned v) { return __hip_atomic_fetch_add(p, v, __ATOMIC_RELAXED, __HIP_MEMORY_SCOPE_AGENT); }
__device__ __forceinline__ unsigned xb_xcc_id() { return (unsigned)__builtin_amdgcn_s_getreg((3 << 11) | 20) & 0xFu; }
#define XB_SPIN(cond, bar) do { unsigned _sp = 0; while (cond) { __builtin_amdgcn_s_sleep(1); \
    if ((++_sp & 255u) == 0u) { if (xb_ld(&(bar)[XB_TMO])) break; if (_sp > XB_SPIN_CAP) { atomicAdd(&(bar)[XB_TMO], 1u); break; } } } } while (0)
struct XcdBarrier { unsigned* bar; unsigned x; volatile LAS unsigned* st; };
__device__ __forceinline__ XcdBarrier xcd_barrier_post(unsigned* bar, volatile LAS unsigned* st) {
    XcdBarrier b; b.bar = bar; b.x = xb_xcc_id(); b.st = st;
    if (threadIdx.x == 0) (void)xb_add(&bar[XB_XCNT(b.x)], 1u);
    return b;
}
__device__ __forceinline__ void xcd_barrier_complete(unsigned* bar, unsigned x, unsigned& nloc, unsigned& nx) {
    const unsigned G = gridDim.x * gridDim.y * gridDim.z;
    unsigned sum, cnt, mine, sp = 0u;
    for (;;) {
        sum = 0u; cnt = 0u; mine = 0u;
#pragma unroll
        for (unsigned j = 0; j < 16; ++j) { const unsigned c = xb_ld(&bar[XB_XCNT(j)]); sum += c; cnt += (c > 0u) ? 1u : 0u; mine = (j == x) ? c : mine; }
        if (sum == G) break;
        __builtin_amdgcn_s_sleep(1);
        if ((++sp & 255u) == 0u) { if (xb_ld(&bar[XB_TMO])) break; if (sp > XB_SPIN_CAP) { atomicAdd(&bar[XB_TMO], 1u); break; } }
    }
    nloc = mine > 0u ? mine : 1u; nx = cnt > 0u ? cnt : 1u;
}
__device__ __forceinline__ void xcd_barrier(const XcdBarrier& b) {
    asm volatile("s_waitcnt vmcnt(0)" ::: "memory");
    __syncthreads();
    if (threadIdx.x == 0) {
        unsigned* bar = b.bar;
        __builtin_amdgcn_s_waitcnt(0);
        unsigned nloc = b.st[0], nx = b.st[1];
        if (nloc == 0u) { xcd_barrier_complete(bar, b.x, nloc, nx); b.st[0] = nloc; b.st[1] = nx; }
        const unsigned old = xb_add(&bar[XB_XSUB(b.x)], 1u);
        const unsigned gen = old / nloc;
        if (old + 1u == (gen + 1u) * nloc) {
            __builtin_amdgcn_fence(__ATOMIC_RELEASE, "agent");
            asm volatile("s_waitcnt vmcnt(0)" ::: "memory");
            const unsigned og = xb_add(&bar[XB_TOP], 1u);
            const unsigned tg = og / nx;
            if (og + 1u == (tg + 1u) * nx) xb_add(&bar[XB_TOPGEN], 1u);
            else XB_SPIN(xb_ld(&bar[XB_TOPGEN]) == tg, bar);
            __builtin_amdgcn_fence(__ATOMIC_ACQUIRE, "agent");
            xb_add(&bar[XB_XGEN(b.x)], 1u);
            asm volatile("s_waitcnt vmcnt(0)" ::: "memory");
        } else {
            XB_SPIN(xb_ld(&bar[XB_XGEN(b.x)]) == gen, bar);
            __builtin_amdgcn_fence(__ATOMIC_ACQUIRE, "agent");
            asm volatile("s_waitcnt vmcnt(0)" ::: "memory");
        }
    }
    __syncthreads();
}

namespace pg8 {
constexpr int BM = 256, BK = 64, HALF = 128, HTB = HALF * BK * 2, STAGE_BYTES = 8 * HTB, NXCD = 8;
__device__ __forceinline__ int lds_byte(int r, int c) { const int st = (r >> 4) * 2 + (c >> 5), rr = r & 15, cc = c & 31, ob = rr * 64 + cc * 2; return st * 1024 + (ob ^ (((ob >> 9) & 1) << 5)); }
__device__ __forceinline__ void stage_rc(int b, int& R, int& C) { const int st = b / 1024, sb = b % 1024, swz = sb ^ (((sb >> 9) & 1) << 5); R = (st >> 1) * 16 + swz / 64; C = (st & 1) * 32 + (swz % 64) / 2; }
__device__ __forceinline__ int perm32(int rho) { const int n = rho >> 4, i = rho & 15; return 8 * (i >> 2) + 4 * n + (i & 3); }

struct Unit { int pm, pn, e, li; const char* bptr; };

template <class Epi, class Sched, bool ALIGN_EPI>
__device__ __forceinline__ void gemm_phase(LAS unsigned char* lds, const char* Abase, const int K, const Sched& S, const Epi& E) {
    const int tid = threadIdx.x, wid = __builtin_amdgcn_readfirstlane(tid >> 6), lane = tid & 63, wr = wid >> 2, wc = wid & 3, fr = lane & 15, fq = lane >> 4;
    const int nt = K / BK;
    int R_[2], C2_[2]; unsigned voffB[2];
#pragma unroll
    for (int i = 0; i < 2; ++i) { int R, C; stage_rc(tid * 16 + i * 8192, R, C); const int Rb = Epi::PERM ? ((R & ~31) + perm32(R & 31)) : R;
        R_[i] = R; C2_[i] = C * 2; voffB[i] = (unsigned)(Rb * K + C) * 2u; }
    const size_t kstep = (size_t)(BK * 2);
    const size_t hstepB = (size_t)HALF * K * 2;
    const unsigned ldsw = (unsigned)wid * 1024u;
    const int aoff = lds_byte(wr * 64 + fr, fq * 8), boff = lds_byte(wc * 32 + fr, fq * 8);
#define PG8_SA(b, h) (((b) * 2 + (h)) * HTB)
#define PG8_SB(b, h) ((4 + (b) * 2 + (h)) * HTB)
#define PG8_STAGE_B(bufoff, gbase) do { _Pragma("unroll") for (int _i = 0; _i < 2; ++_i) \
        __builtin_amdgcn_global_load_lds((const unsigned*)((const char*)(gbase) + voffB[_i]), (LAS unsigned*)(lds + (bufoff) + ldsw + _i * 8192), 16, 0, 0); } while (0)
#define PG8_STAGE_A(bufoff, OFF, h, kb) do { _Pragma("unroll") for (int _i = 0; _i < 2; ++_i) \
        __builtin_amdgcn_global_load_lds((const unsigned*)(Abase + (size_t)(OFF)[h][_i] + (size_t)(kb)), (LAS unsigned*)(lds + (bufoff) + ldsw + _i * 8192), 16, 0, 0); } while (0)
#define PG8_LDA(dst, b, h) do { _Pragma("unroll") for (int m = 0; m < 4; ++m) _Pragma("unroll") for (int k = 0; k < 2; ++k) dst[m][k] = *(const LAS bf16x8*)(lds + PG8_SA(b, h) + aoff + m * 2048 + k * 1024); } while (0)
#define PG8_LDB(dst, b, h) do { _Pragma("unroll") for (int n = 0; n < 2; ++n) _Pragma("unroll") for (int k = 0; k < 2; ++k) dst[n][k] = *(const LAS bf16x8*)(lds + PG8_SB(b, h) + boff + n * 2048 + k * 1024); } while (0)
#define PG8_MMA(ai, bj, At, Bt) do { __builtin_amdgcn_s_setprio(1); _Pragma("unroll") for (int m = 0; m < 4; ++m) _Pragma("unroll") for (int n = 0; n < 2; ++n) _Pragma("unroll") for (int k = 0; k < 2; ++k) \
        acc[ai][bj][m][n] = __builtin_amdgcn_mfma_f32_16x16x32_bf16(Bt[n][k], At[m][k], acc[ai][bj][m][n], 0, 0, 0); __builtin_amdgcn_s_setprio(0); } while (0)
#define PG8_WAIT_V(n) asm volatile("s_waitcnt vmcnt(" #n ")" ::: "memory")
#define PG8_WAIT_L(n) asm volatile("s_waitcnt lgkmcnt(" #n ")" ::: "memory")
#define PG8_BAR __builtin_amdgcn_s_barrier()
#define PG8_SCHED __builtin_amdgcn_sched_barrier(0)
    Unit cur, nxt; int ui = 0;
    if (!S.next(0, cur)) return;
    f32x4 acc[2][2][4][2];
#pragma unroll
    for (int a = 0; a < 2; ++a)
#pragma unroll
        for (int b = 0; b < 2; ++b)
#pragma unroll
            for (int m = 0; m < 4; ++m)
#pragma unroll
                for (int n = 0; n < 2; ++n) acc[a][b][m][n] = (f32x4){0.f, 0.f, 0.f, 0.f};
    bf16x8 At[4][2], B0[2][2], B1[2][2];
    unsigned aC[2][2], aN[2][2];
#pragma unroll
    for (int h = 0; h < 2; ++h)
#pragma unroll
        for (int i = 0; i < 2; ++i) aC[h][i] = S.a_off(cur, h * HALF + R_[i]) + (unsigned)C2_[i];
    const char* cB = cur.bptr;
    PG8_STAGE_B(PG8_SB(0, 0), cB); PG8_STAGE_B(PG8_SB(0, 1), cB + hstepB); PG8_STAGE_A(PG8_SA(0, 0), aC, 0, 0); PG8_STAGE_A(PG8_SA(0, 1), aC, 1, 0);
    if (wr == 1) PG8_BAR;
    PG8_WAIT_V(2); PG8_BAR;
    PG8_STAGE_B(PG8_SB(1, 0), cB + kstep); PG8_STAGE_A(PG8_SA(1, 0), aC, 0, kstep); PG8_STAGE_B(PG8_SB(1, 1), cB + hstepB + kstep);
    PG8_WAIT_V(6); PG8_BAR;
    for (;;) {
        const bool has_next = S.next(ui + 1, nxt);
        const char* nB = has_next ? nxt.bptr : cB;
#pragma unroll
        for (int h = 0; h < 2; ++h)
#pragma unroll
            for (int i = 0; i < 2; ++i) aN[h][i] = has_next ? (S.a_off(nxt, h * HALF + R_[i]) + (unsigned)C2_[i]) : aC[h][i];
        for (int t = 0; t < nt; t += 2) {
            const bool last = (t == nt - 2);
            const size_t k1 = (size_t)(t + 1) * kstep;
            const size_t k2 = last ? 0 : (size_t)(t + 2) * kstep, k3 = k2 + kstep;
            const char* b2 = last ? nB : cB + (size_t)(t + 2) * kstep; const char* b3 = b2 + kstep;
            unsigned a2[2][2];
#pragma unroll
            for (int h = 0; h < 2; ++h)
#pragma unroll
                for (int i = 0; i < 2; ++i) a2[h][i] = last ? aN[h][i] : aC[h][i];
            if constexpr (Epi::MIDK) { if (t == nt / 2) E.mid(acc, cur, wr, wc, fr, fq); }
            PG8_LDB(B0, 0, 0); PG8_LDB(B1, 0, 1); PG8_SCHED; PG8_LDA(At, 0, 0); PG8_STAGE_A(PG8_SA(1, 1), aC, 1, k1);
            PG8_WAIT_V(8); PG8_WAIT_L(0); PG8_BAR; PG8_MMA(0, 0, At, B0); PG8_MMA(0, 1, At, B1); PG8_BAR; PG8_SCHED;
            PG8_LDA(At, 0, 1); PG8_STAGE_B(PG8_SB(0, 0), b2); PG8_STAGE_B(PG8_SB(0, 1), b2 + hstepB); PG8_STAGE_A(PG8_SA(0, 0), a2, 0, k2);
            PG8_WAIT_V(8); PG8_WAIT_L(0); PG8_BAR; PG8_MMA(1, 0, At, B0); PG8_MMA(1, 1, At, B1); PG8_BAR; PG8_SCHED;
            PG8_LDB(B0, 1, 0); PG8_LDB(B1, 1, 1); PG8_SCHED; PG8_LDA(At, 1, 0); PG8_STAGE_A(PG8_SA(0, 1), a2, 1, k2);
            PG8_WAIT_V(8); PG8_WAIT_L(0); PG8_BAR; PG8_MMA(0, 0, At, B0); PG8_MMA(0, 1, At, B1); PG8_BAR; PG8_SCHED;
            PG8_LDA(At, 1, 1); PG8_STAGE_B(PG8_SB(1, 0), b3); PG8_STAGE_B(PG8_SB(1, 1), b3 + hstepB); PG8_STAGE_A(PG8_SA(1, 0), a2, 0, k3);
            PG8_WAIT_V(8); PG8_WAIT_L(0); PG8_BAR; PG8_MMA(1, 0, At, B0); PG8_MMA(1, 1, At, B1); PG8_BAR; PG8_SCHED;
        }
        if constexpr (ALIGN_EPI) { if (wr == 0) PG8_BAR; }
        E(acc, cur, wr, wc, fr, fq);
        if (!has_next) break;
#pragma unroll
        for (int a = 0; a < 2; ++a)
#pragma unroll
            for (int b = 0; b < 2; ++b)
#pragma unroll
                for (int m = 0; m < 4; ++m)
#pragma unroll
                    for (int n = 0; n < 2; ++n) acc[a][b][m][n] = (f32x4){0.f, 0.f, 0.f, 0.f};
        cur = nxt; cB = nB; ++ui;
#pragma unroll
        for (int h = 0; h < 2; ++h)
#pragma unroll
            for (int i = 0; i < 2; ++i) aC[h][i] = aN[h][i];
        if constexpr (ALIGN_EPI) { if (wr == 1) PG8_BAR; }
    }
    PG8_WAIT_V(0);
    if constexpr (!ALIGN_EPI) { if (wr == 0) PG8_BAR; }
    PG8_BAR;
#undef PG8_SA
#undef PG8_SB
#undef PG8_STAGE_A
#undef PG8_STAGE_B
#undef PG8_LDA
#undef PG8_LDB
#undef PG8_MMA
#undef PG8_WAIT_V
#undef PG8_WAIT_L
#undef PG8_BAR
#undef PG8_SCHED
}

struct DenseOrder {
    int nM, nN, nwg, G, c, K; const char* Bt;
    __device__ void init(int M, int N, int K_, const void* Bt_, int G_, int c_) { nM = M / BM; nN = N / BM; nwg = nM * nN; G = G_; c = c_; K = K_; Bt = (const char*)Bt_; }
    __device__ __forceinline__ bool next(int i, Unit& u) const {
        const long L = (long)i * G + c; if (L >= nwg) return false;
        int wgid = (int)L; { const int q = nwg / NXCD, r = nwg % NXCD, xcd = wgid % NXCD, off = wgid / NXCD; wgid = (xcd < r ? xcd * (q + 1) : r * (q + 1) + (xcd - r) * q) + off; }
        const int WGM = 8;
        const int nig = WGM * nN, gid = wgid / nig, fm = gid * WGM, gsz = (nM - fm) < WGM ? (nM - fm) : WGM;
        u.pm = fm + ((wgid % nig) % gsz); u.pn = (wgid % nig) / gsz; u.e = 0; u.li = i;
        u.bptr = Bt + (size_t)u.pn * BM * K * 2;
        return true;
    }
    __device__ __forceinline__ unsigned a_off(const Unit& u, int r) const { return (unsigned)((u.pm * BM + r) * K * 2); }
};
}
struct Args { const float* in[25]; float* out; unsigned char* ws; int ph_lo, ph_hi; };
enum { I_X = 0, I_C, I_WADA, I_BADA, I_GMIX, I_WIN, I_CONVW, I_CONVB, I_WRGA, I_BRGA, I_WRGX, I_BRGX, I_LAM, I_SINKS, I_GATT, I_GLRU, I_WOUT, I_GFFN,
       I_WR, I_BR, I_WGU, I_BGU, I_WDN, I_BDN, I_GFIN };

struct Frame {
    LAS unsigned char* lds;
    int tid, lane, wave, G, bx;
    unsigned char* ws;
};

struct CvtItem { const float* src; bf16_t* dst; const float* ks; int N; };
__device__ __forceinline__ CvtItem p0_decode(const Args& a, unsigned char* ws, int it) {
    constexpr int I_IN = 16 * 56, I_OUT = 16 * 32, I_GU = 32 * 16 * 64;
    CvtItem d; int r = it; d.ks = nullptr;
    if (r < I_IN) { const int kb = r / 56, nb = r % 56; d.N = 1792; d.src = a.in[I_WIN] + (size_t)kb * 64 * 1792 + nb * 32; d.dst = (bf16_t*)(ws + WS_WIN) + (size_t)nb * 32 * 1024 + kb * 64; return d; } r -= I_IN;
    if (r < I_OUT) { const int kb = r / 32, nb = r % 32; d.N = 1024; d.src = a.in[I_WOUT] + (size_t)kb * 64 * 1024 + nb * 32; d.dst = (bf16_t*)(ws + WS_WOUT) + (size_t)nb * 32 * 1024 + kb * 64;
        d.ks = ((kb < 8) ? a.in[I_GATT] : (a.in[I_GLRU] - 512)) + kb * 64; return d; } r -= I_OUT;
    if (r < I_GU) { const int e = r / 1024, q = r % 1024, kb = q / 64, nb = q % 64, n0 = nb * 32;
        const int drow = ((n0 & 1023) >> 7) * 256 + (n0 >> 10) * 128 + (n0 & 127);
        d.N = 2048; d.src = a.in[I_WGU] + (size_t)e * 1024 * 2048 + (size_t)kb * 64 * 2048 + n0; d.dst = (bf16_t*)(ws + WS_WGU) + ((size_t)e * 2048 + drow) * 1024 + kb * 64; return d; } r -= I_GU;
    { const int e = r / 512, q = r % 512, kb = q / 32, nb = q % 32;
      d.N = 1024; d.src = a.in[I_WDN] + (size_t)e * 1024 * 1024 + (size_t)kb * 64 * 1024 + nb * 32; d.dst = (bf16_t*)(ws + WS_WDN) + ((size_t)e * 1024 + nb * 32) * 1024 + kb * 64; return d; }
}
__device__ __forceinline__ void p0_load(const CvtItem& d, int lane, float (&v)[32]) {
    const float* p = d.src + (size_t)(lane >> 5) * d.N + (lane & 31);
#pragma unroll
    for (int i = 0; i < 32; ++i) v[i] = __builtin_nontemporal_load(p + (size_t)(2 * i) * d.N);
}

__device__ __forceinline__ void p0_phase(Frame& F, const Args& a) {
    unsigned char* ws = F.ws;
    if (F.bx < 192) {
        LAS float* cs = (LAS float*)F.lds;
        LAS float* red = (LAS float*)(F.lds + 32768);
        const float* c = a.in[I_C];
        for (int i = F.tid; i < 8 * 1024; i += NTHR) cs[i] = c[i];
        __syncthreads();
        const int col = F.tid & 31, kg = F.tid >> 5, j0 = F.bx * 32;
        const float* w = a.in[I_WADA] + j0 + col;
        float acc[8];
#pragma unroll
        for (int b = 0; b < 8; ++b) acc[b] = 0.f;
#pragma unroll 16
        for (int i = 0; i < 64; ++i) { const int k = kg + 16 * i; const float wv = w[(size_t)k * 6144];
#pragma unroll
            for (int b = 0; b < 8; ++b) acc[b] += cs[b * 1024 + k] * wv; }
#pragma unroll
        for (int b = 0; b < 8; ++b) red[(kg * 8 + b) * 32 + col] = acc[b];
        __syncthreads();
        if (F.tid < 256) { const int b = F.tid >> 5; float s = a.in[I_BADA][j0 + col];
#pragma unroll
            for (int g = 0; g < 16; ++g) s += red[(g * 8 + b) * 32 + col];
            ((float*)(ws + WS_MOD))[b * 6144 + j0 + col] = s; }
        __syncthreads();
    }
    { u32x4* L = (u32x4*)(ws + WS_LIST); const int n4 = NE * LISTCAP / 4; const unsigned dv = (unsigned)DUMP;
      for (int i = F.bx * NTHR + F.tid; i < n4; i += F.G * NTHR) L[i] = (u32x4){dv, dv, dv, dv};
      if (F.bx == 0 && F.tid < 128) ((u32x4*)(ws + WS_H + (size_t)T * D * 2))[F.tid] = (u32x4){0u, 0u, 0u, 0u}; }
    LAS float* scr = (LAS float*)(F.lds + F.wave * 16384);
    const int gw = F.bx * NWAVES + F.wave, NGW = F.G * NWAVES, lane = F.lane;
    constexpr int NITEMS = 16 * 56 + 16 * 32 + 32 * 16 * 64 + 32 * 16 * 32;
    const int NBASE = (F.G == 256) ? 24 : (NITEMS + NGW - 1) / NGW;
    const int nstrided = NBASE * NGW < NITEMS ? NBASE * NGW : NITEMS;
    const int xw = gw - 192 * NWAVES, NXW = NGW - 192 * NWAVES;
    int seq = 0;
    auto item_at = [&](int q) -> int { if (q < NBASE) { const int it = gw + NGW * q; return it < nstrided ? it : -1; }
        if (xw < 0) return -1; const int it = nstrided + xw + NXW * (q - NBASE); return it < NITEMS ? it : -1; };
    float v[32];
    int it = item_at(0);
    CvtItem d = p0_decode(a, ws, it < 0 ? 0 : it);
    if (it >= 0) p0_load(d, lane, v);
    while (it >= 0) {
        float ksc0 = 1.f, ksc1 = 1.f;
#pragma unroll
        for (int i = 0; i < 32; ++i) { const int kk = 2 * i + (lane >> 5); float x = v[i]; if (d.ks) x *= d.ks[kk]; scr[kk * 33 + (lane & 31)] = x; }
        (void)ksc0; (void)ksc1;
        ++seq; const int itn = item_at(seq);
        const CvtItem dn = p0_decode(a, ws, itn < 0 ? 0 : itn);
        if (itn >= 0) p0_load(dn, lane, v);
        LDS_WAIT(); asm volatile("" ::: "memory");
        const int c = lane & 7;
#pragma unroll
        for (int j = 0; j < 4; ++j) { const int n = (lane >> 3) + 8 * j; const LAS float* s = scr + (8 * c) * 33 + n;
            u32x4 o; o.x = pk2(s[0 * 33], s[1 * 33]); o.y = pk2(s[2 * 33], s[3 * 33]); o.z = pk2(s[4 * 33], s[5 * 33]); o.w = pk2(s[6 * 33], s[7 * 33]);
            *(GAS u32x4*)(d.dst + (size_t)n * 1024 + 8 * c) = o; }
        LDS_WAIT(); asm volatile("" ::: "memory");
        d = dn; it = itn;
    }
}

__device__ __forceinline__ void p1_phase(Frame& F, const Args& a) {
    const int gw = F.bx * NWAVES + F.wave, NGW = F.G * NWAVES;
    const float* mod = (const float*)(F.ws + WS_MOD);
    { float* WRP = (float*)(F.ws + WS_WRP);
      for (int idx = F.bx * NTHR + F.tid; idx < NB * 1024 * 32; idx += F.G * NTHR) { const int b = idx >> 15, k = (idx >> 5) & 1023;
          WRP[idx] = a.in[I_GFFN][k] * (1.0f + mod[b * 6144 + 4096 + k]) * a.in[I_WR][idx & 32767]; }
      for (int o = gw; o < NB * NE; o += NGW) { const int b = o >> 5, e = o & 31; float s = 0.f;
#pragma unroll
          for (int j = 0; j < 16; ++j) { const int k = F.lane + 64 * j; s += mod[b * 6144 + 3072 + k] * a.in[I_WR][k * 32 + e]; }
          s = wave_sum(s);
          if (F.lane == 0) ((float*)(F.ws + WS_CSTB))[o] = s + a.in[I_BR][e]; } }
    const GAS f32x4* g4 = (const GAS f32x4*)a.in[I_GMIX] + F.lane;
    for (int m = gw; m < T; m += NGW) {
        const int b = m / SEQ;
        const GAS f32x4* xr = (const GAS f32x4*)(a.in[I_X] + (size_t)m * D) + F.lane;
        f32x4 v[4]; float s = 0.f;
#pragma unroll
        for (int j = 0; j < 4; ++j) { v[j] = xr[64 * j]; s += (v[j].x * v[j].x + v[j].y * v[j].y) + (v[j].z * v[j].z + v[j].w * v[j].w); }
        const float rs = rsqrtf(wave_sum(s) * (1.f / D) + EPS);
        const GAS f32x4* sh = (const GAS f32x4*)(mod + b * 6144) + F.lane;
        const GAS f32x4* sc = (const GAS f32x4*)(mod + b * 6144 + 1024) + F.lane;
        GAS u32x2* o8 = (GAS u32x2*)((bf16_t*)(F.ws + WS_H) + (size_t)m * D) + F.lane;
#pragma unroll
        for (int j = 0; j < 4; ++j) { const f32x4 g = g4[64 * j], h = sh[64 * j], c = sc[64 * j];
            const f32x4 y = v[j] * rs * g * (c + 1.0f) + h;
            u32x2 w; w.x = pk2(y.x, y.y); w.y = pk2(y.z, y.w); o8[64 * j] = w; }
    }
}

struct EpiBf16 {
    static constexpr bool PERM = true, MIDK = false;
    bf16_t* O; int ldc;
    __device__ __forceinline__ void operator()(const f32x4 (&acc)[2][2][4][2], const pg8::Unit& u, int wr, int wc, int fr, int fq) const {
        const int row0 = u.pm * 256 + wr * 64 + fr, col0 = u.pn * 256 + wc * 32 + 8 * fq;
#pragma unroll
        for (int ai = 0; ai < 2; ++ai)
#pragma unroll
            for (int m = 0; m < 4; ++m) { bf16_t* rowp = O + (size_t)(row0 + ai * 128 + m * 16) * ldc + col0;
#pragma unroll
                for (int bj = 0; bj < 2; ++bj) { const f32x4 v0 = acc[ai][bj][m][0], v1 = acc[ai][bj][m][1];
                    u32x4 w; w.x = cvt_pk_bf16(v0[0], v0[1]); w.y = cvt_pk_bf16(v0[2], v0[3]); w.z = cvt_pk_bf16(v1[0], v1[1]); w.w = cvt_pk_bf16(v1[2], v1[3]);
                    *(u32x4*)(rowp + bj * 128) = w; } }
    }
    __device__ __forceinline__ void mid(f32x4 (&acc)[2][2][4][2], const pg8::Unit& u, int wr, int wc, int fr, int fq) const {}
};
__device__ __forceinline__ int crow(int r, int hi) { return (r & 3) + 8 * (r >> 2) + 4 * hi; }
__device__ __forceinline__ s16x4 vtr(const LAS unsigned char* p) {
    typedef short v4i16_t __attribute__((ext_vector_type(4)));
    return __builtin_bit_cast(s16x4, __builtin_amdgcn_ds_read_tr16_b64_v4i16((LAS v4i16_t*)p));
}

__device__ __forceinline__ void attn_item(Frame& F, const Args& a, int item) {
    const int b = item >> 5, n = (item >> 1) & 15, j = item & 1;
    const bf16_t* P = (const bf16_t*)(F.ws + WS_P);
    LAS unsigned char* Kl = F.lds;
    LAS unsigned char* Vl = F.lds + 32768;
    LAS unsigned char* ost = F.lds + 65536 + F.wave * 4608;
    LAS float* wsf = (LAS float*)(ost + 4096);
    const int lane = F.lane, ql = lane & 31, hi = lane >> 5;
    {
        const int row = F.tid >> 1, half = F.tid & 1;
        int tb = 128 * (n - 1) + row; if (tb < 0) tb += 128;
        const bf16_t* src = P + (size_t)(b * SEQ + tb) * NCOL + 64 * j;
#pragma unroll
        for (int i = 0; i < 4; ++i) { const int c = half * 4 + i;
            const u32x4 kv = *(const GAS u32x4*)(src + KOFF + 8 * c);
            const u32x4 vv = *(const GAS u32x4*)(src + VOFF + 8 * c);
            *(LAS u32x4*)(Kl + row * 128 + ((c ^ (row & 7)) * 16)) = kv;
            *(LAS u32x4*)(Vl + row * 128 + c * 16) = vv; }
    }
    __syncthreads();
    const int g = F.wave >> 1, qh = F.wave & 1, h = 4 * j + g;
    const float sink = a.in[I_SINKS][h];
    constexpr float L2E = 1.4426950408889634f, C1 = 0.125f * 1.4426950408889634f;
    for (int qb = 0; qb < 2; ++qb) {
        const int o = 64 * qh + 32 * qb;
        const int tq0 = b * SEQ + 128 * n + o;
        bf16x8 qr[4];
#pragma unroll
        for (int d0 = 0; d0 < 4; ++d0) qr[d0] = *(const GAS bf16x8*)(P + (size_t)(tq0 + ql) * NCOL + QOFF + 64 * h + 16 * d0 + 8 * hi);
        f32x16 S[5];
#pragma unroll
        for (int kt = 0; kt < 5; ++kt) {
            const int key = o + 32 * kt + ql;
            f32x16 acc = {};
#pragma unroll
            for (int d0 = 0; d0 < 4; ++d0) { const int c = 2 * d0 + hi;
                const bf16x8 kf = *(const LAS bf16x8*)(Kl + key * 128 + ((c ^ (key & 7)) * 16));
                acc = __builtin_amdgcn_mfma_f32_32x32x16_bf16(kf, qr[d0], acc, 0, 0, 0); }
            S[kt] = acc;
        }
        constexpr float NEG = -1.0e30f;
#pragma unroll
        for (int r = 0; r < 16; ++r) { const int cr = crow(r, hi);
            if (!(cr > ql)) S[0][r] = NEG;
            if (!(cr <= ql)) S[4][r] = NEG; }
        if (n == 0) {
#pragma unroll
            for (int kt = 0; kt < 4; ++kt)
#pragma unroll
                for (int r = 0; r < 16; ++r) if (o + 32 * kt + crow(r, hi) < 128) S[kt][r] = NEG;
        }
        float mx = NEG;
#pragma unroll
        for (int kt = 0; kt < 5; ++kt)
#pragma unroll
            for (int r = 0; r < 16; ++r) mx = fmaxf(mx, S[kt][r]);
        mx = fmaxf(mx, __shfl_xor(mx, 32));
        const float m = fmaxf(mx * 0.125f, sink);
        const float mb = m * L2E;
        float l = 0.f;
#pragma unroll
        for (int kt = 0; kt < 5; ++kt)
#pragma unroll
            for (int r = 0; r < 16; ++r) { const float p = __builtin_amdgcn_exp2f(S[kt][r] * C1 - mb); S[kt][r] = p; l += p; }
        l += __shfl_xor(l, 32);
        l += __builtin_amdgcn_exp2f((sink - m) * L2E);
        if (hi == 0) wsf[ql] = 1.0f / l;
        f32x16 O0 = {}, O1 = {};
        const int gi = (lane >> 4) & 1, li = lane & 15;
        const LAS unsigned char* vb = Vl + (o + 4 * hi + (li >> 2)) * 128 + (16 * gi + 4 * (li & 3)) * 2;
#pragma unroll
        for (int kt = 0; kt < 5; ++kt)
#pragma unroll
            for (int s = 0; s < 2; ++s) {
                bf16x8 pa;
                { const f32x16& X = S[kt];
                  const unsigned w0 = cvt_pk_bf16(X[8 * s + 0], X[8 * s + 1]), w1 = cvt_pk_bf16(X[8 * s + 2], X[8 * s + 3]);
                  const unsigned w2 = cvt_pk_bf16(X[8 * s + 4], X[8 * s + 5]), w3 = cvt_pk_bf16(X[8 * s + 6], X[8 * s + 7]);
                  pa = __builtin_bit_cast(bf16x8, (u32x4){w0, w1, w2, w3}); }
                const LAS unsigned char* vp = vb + (32 * kt + 16 * s) * 128;
                const s16x4 lo0 = vtr(vp), hi0 = vtr(vp + 8 * 128);
                const s16x4 lo1 = vtr(vp + 64), hi1 = vtr(vp + 8 * 128 + 64);
                const bf16x8 v0 = (bf16x8){lo0[0], lo0[1], lo0[2], lo0[3], hi0[0], hi0[1], hi0[2], hi0[3]};
                const bf16x8 v1 = (bf16x8){lo1[0], lo1[1], lo1[2], lo1[3], hi1[0], hi1[1], hi1[2], hi1[3]};
                O0 = __builtin_amdgcn_mfma_f32_32x32x16_bf16(pa, v0, O0, 0, 0, 0);
                O1 = __builtin_amdgcn_mfma_f32_32x32x16_bf16(pa, v1, O1, 0, 0, 0);
            }
        LDS_WAIT(); asm volatile("" ::: "memory");
#pragma unroll
        for (int r = 0; r < 16; ++r) { const int q = crow(r, hi); const float il = wsf[q];
            *(LAS unsigned short*)(ost + q * 128 + ql * 2) = (unsigned short)f2bf(O0[r] * il);
            *(LAS unsigned short*)(ost + q * 128 + (32 + ql) * 2) = (unsigned short)f2bf(O1[r] * il); }
        LDS_WAIT(); asm volatile("" ::: "memory");
        bf16_t* MIXp = (bf16_t*)(F.ws + WS_MIX);
        float* SSQA = (float*)(F.ws + WS_SSQA);
#pragma unroll
        for (int i = 0; i < 4; ++i) { const int id = lane + 64 * i, row = id >> 3, ch = id & 7;
            const u32x4 w = *(const LAS u32x4*)(ost + row * 128 + ch * 16);
            *(GAS u32x4*)(MIXp + (size_t)(tq0 + row) * D + 64 * h + 8 * ch) = w;
            float ss = bflo(w.x) * bflo(w.x) + bfhi(w.x) * bfhi(w.x) + bflo(w.y) * bflo(w.y) + bfhi(w.y) * bfhi(w.y)
                     + bflo(w.z) * bflo(w.z) + bfhi(w.z) * bfhi(w.z) + bflo(w.w) * bflo(w.w) + bfhi(w.w) * bfhi(w.w);
            ss += __shfl_xor(ss, 1); ss += __shfl_xor(ss, 2); ss += __shfl_xor(ss, 4);
            if (ch == 0) SSQA[(size_t)(tq0 + row) * 8 + h] = ss; }
        LDS_WAIT(); asm volatile("" ::: "memory");
    }
    __syncthreads();
}

__device__ __forceinline__ void lru_item(Frame& F, const Args& a, int item) {
    const int b = item >> 5, hb = (item >> 2) & 7, qt = item & 3;
    const int c0 = hb * 64 + qt * 16;
    const bf16_t* P = (const bf16_t*)(F.ws + WS_P);
    constexpr int PITCH = 260;
    LAS unsigned char* XC = F.lds;
    LAS float* XCF = (LAS float*)(F.lds + 32768);
    LAS float* AA = XCF + 16 * PITCH;
    LAS float* UU = AA + 16 * PITCH;
    LAS float* XG = UU + 16 * PITCH;
    LAS float* OUT = XG + 16 * PITCH;
    const int tid = F.tid, lane = F.lane, w = F.wave;
    const int cg = tid & 7, tg = tid >> 3;
    LAS float* CWT = OUT + 16 * PITCH;
    if (tid < 320) CWT[tid] = (tid < 256) ? a.in[I_CONVW][(tid >> 6) * 512 + hb * 64 + (tid & 63)] : a.in[I_CONVB][hb * 64 + (tid & 63)];
    bf16x8 wb[2][2];
    { const int nn = lane & 15, kq = lane >> 4;
#pragma unroll
      for (int nt = 0; nt < 2; ++nt) { const float* Wg = (nt == 0 ? a.in[I_WRGA] : a.in[I_WRGX]) + (size_t)hb * 64 * 64 + qt * 16 + nn;
#pragma unroll
        for (int ks = 0; ks < 2; ++ks) { unsigned pw[4];
#pragma unroll
            for (int jj = 0; jj < 4; ++jj) { const int k = 32 * ks + 8 * kq + 2 * jj; pw[jj] = pk2(Wg[(size_t)k * 64], Wg[(size_t)(k + 1) * 64]); }
            wb[nt][ks] = __builtin_bit_cast(bf16x8, (u32x4){pw[0], pw[1], pw[2], pw[3]}); } } }
    const int chn = c0 + (lane & 15);
    const float ba = a.in[I_BRGA][chn], bx = a.in[I_BRGX][chn];
    const float lg8 = -8.0f * log1pf(expf(-a.in[I_LAM][chn]));
    float hcarry = 0.f;
    bf16_t* MIXp = (bf16_t*)(F.ws + WS_MIX);
    float* SSQL = (float*)(F.ws + WS_SSQL);
    u32x4 cin[7], cxg;
#define LRU_LOAD_TILE(tile_) do { const int t0_ = (tile_) * 256; \
        _Pragma("unroll") for (int rr = 0; rr < 7; ++rr) { const int s_ = t0_ + 4 * tg - 3 + rr; cin[rr] = (u32x4){0u, 0u, 0u, 0u}; \
            if (s_ >= 0) cin[rr] = *(const GAS u32x4*)(P + ((size_t)b * SEQ + s_) * NCOL + XROFF + hb * 64 + 8 * cg); } \
        cxg = *(const GAS u32x4*)(P + ((size_t)b * SEQ + t0_ + (tid >> 1)) * NCOL + XGOFF + c0 + 8 * (tid & 1)); } while (0)
    LRU_LOAD_TILE(0);
    __syncthreads();
    for (int tile = 0; tile < 8; ++tile) {
        const int t0 = tile * 256;
        const size_t tokbase = (size_t)b * SEQ + t0;
        {
            f32x4 xin[7][2];
#pragma unroll
            for (int rr = 0; rr < 7; ++rr) { const u32x4 v = cin[rr];
                xin[rr][0] = (f32x4){bflo(v.x), bfhi(v.x), bflo(v.y), bfhi(v.y)};
                xin[rr][1] = (f32x4){bflo(v.z), bfhi(v.z), bflo(v.w), bfhi(v.w)}; }
            float xo[4][8];
            { const f32x4 b0 = *(const LAS f32x4*)(CWT + 256 + 8 * cg), b1 = *(const LAS f32x4*)(CWT + 256 + 8 * cg + 4);
#pragma unroll
              for (int tt = 0; tt < 4; ++tt)
#pragma unroll
                  for (int e = 0; e < 8; ++e) xo[tt][e] = (e < 4) ? b0[e & 3] : b1[e & 3];
#pragma unroll
              for (int k = 0; k < 4; ++k) { const f32x4 w0 = *(const LAS f32x4*)(CWT + 64 * k + 8 * cg), w1 = *(const LAS f32x4*)(CWT + 64 * k + 8 * cg + 4);
#pragma unroll
                  for (int tt = 0; tt < 4; ++tt)
#pragma unroll
                      for (int e = 0; e < 8; ++e) xo[tt][e] += ((e < 4) ? w0[e & 3] : w1[e & 3]) * xin[tt + k][e >> 2][e & 3]; } }
#pragma unroll
            for (int tt = 0; tt < 4; ++tt) { const int tl = 4 * tg + tt;
                u32x4 pkv; pkv.x = pk2(xo[tt][0], xo[tt][1]); pkv.y = pk2(xo[tt][2], xo[tt][3]); pkv.z = pk2(xo[tt][4], xo[tt][5]); pkv.w = pk2(xo[tt][6], xo[tt][7]);
                *(LAS u32x4*)(XC + tl * 128 + ((cg ^ (tl & 7)) * 16)) = pkv; }
            if ((cg >> 1) == qt) {
#pragma unroll
                for (int e = 0; e < 8; ++e) *(LAS f32x4*)(XCF + ((cg & 1) * 8 + e) * PITCH + 4 * tg) = (f32x4){xo[0][e], xo[1][e], xo[2][e], xo[3][e]};
            }
            { const int tk = tid >> 1, hf = tid & 1;
              const u32x4 v = cxg;
              const float xv[8] = {bflo(v.x), bfhi(v.x), bflo(v.y), bfhi(v.y), bflo(v.z), bfhi(v.z), bflo(v.w), bfhi(v.w)};
#pragma unroll
              for (int e = 0; e < 8; ++e) XG[(hf * 8 + e) * PITCH + tk] = xv[e]; }
            if (tile + 1 < 8) LRU_LOAD_TILE(tile + 1);
        }
        __syncthreads();
        {
            const int kq = lane >> 4, rl = lane & 15;
#pragma unroll
            for (int mt = 0; mt < 2; ++mt) {
                const int row = 32 * w + 16 * mt + rl;
                f32x4 accR = {0.f, 0.f, 0.f, 0.f}, accI = {0.f, 0.f, 0.f, 0.f};
#pragma unroll
                for (int ks = 0; ks < 2; ++ks) { const int c = 4 * ks + kq;
                    const bf16x8 af = *(const LAS bf16x8*)(XC + row * 128 + ((c ^ (row & 7)) * 16));
                    accR = __builtin_amdgcn_mfma_f32_16x16x32_bf16(af, wb[0][ks], accR, 0, 0, 0);
                    accI = __builtin_amdgcn_mfma_f32_16x16x32_bf16(af, wb[1][ks], accI, 0, 0, 0); }
                const int tl0 = 32 * w + 16 * mt + 4 * kq;
                const f32x4 xcf = *(const LAS f32x4*)(XCF + rl * PITCH + tl0);
                f32x4 av, uv;
#pragma unroll
                for (int r = 0; r < 4; ++r) {
                    const float rg = __builtin_amdgcn_rcpf(1.0f + __expf(-(accR[r] + ba)));
                    const float ig = __builtin_amdgcn_rcpf(1.0f + __expf(-(accI[r] + bx)));
                    const float log_a = rg * lg8;
                    av[r] = __expf(log_a);
                    const float x2 = 2.0f * log_a;
                    const float ser = -x2 * (1.0f + x2 * (0.5f + x2 * (0.16666667f + x2 * (0.041666668f + x2 * (0.008333334f + x2 * 0.0013888889f)))));
                    const float om = (x2 > -0.25f) ? ser : (1.0f - __expf(x2));
                    uv[r] = __builtin_amdgcn_sqrtf(fmaxf(om, 0.0f)) * (ig * xcf[r]);
                }
                *(LAS f32x4*)(AA + rl * PITCH + tl0) = av;
                *(LAS f32x4*)(UU + rl * PITCH + tl0) = uv;
            }
        }
        __syncthreads();
        {
            const int ch = 2 * w + (lane >> 5), chunk = lane & 31;
            const f32x4 a0 = *(const LAS f32x4*)(AA + ch * PITCH + 8 * chunk), a1 = *(const LAS f32x4*)(AA + ch * PITCH + 8 * chunk + 4);
            const f32x4 u0 = *(const LAS f32x4*)(UU + ch * PITCH + 8 * chunk), u1 = *(const LAS f32x4*)(UU + ch * PITCH + 8 * chunk + 4);
            const float av[8] = {a0[0], a0[1], a0[2], a0[3], a1[0], a1[1], a1[2], a1[3]};
            const float uv[8] = {u0[0], u0[1], u0[2], u0[3], u1[0], u1[1], u1[2], u1[3]};
            float Ac = 1.f, Hc = 0.f;
#pragma unroll
            for (int s = 0; s < 8; ++s) { Hc = av[s] * Hc + uv[s]; Ac *= av[s]; }
#pragma unroll
            for (int off = 1; off < 32; off <<= 1) {
                const float Ap = __shfl_up(Ac, off, 32), Hp = __shfl_up(Hc, off, 32);
                if (chunk >= off) { Hc = Ac * Hp + Hc; Ac = Ac * Ap; }
            }
            float Ae = __shfl_up(Ac, 1, 32), He = __shfl_up(Hc, 1, 32);
            if (chunk == 0) { Ae = 1.f; He = 0.f; }
            float hh = He + Ae * hcarry;
            const float Hl = __shfl(Hc, 31, 32), Al = __shfl(Ac, 31, 32);
            hcarry = Hl + Al * hcarry;
            const f32x4 g0 = *(const LAS f32x4*)(XG + ch * PITCH + 8 * chunk), g1 = *(const LAS f32x4*)(XG + ch * PITCH + 8 * chunk + 4);
            const float gv[8] = {g0[0], g0[1], g0[2], g0[3], g1[0], g1[1], g1[2], g1[3]};
            float yo[8];
#pragma unroll
            for (int s = 0; s < 8; ++s) { hh = av[s] * hh + uv[s];
                const float x = gv[s];
                const float z2 = 1.5957691216057308f * (x + 0.044715f * x * x * x);
                yo[s] = hh * (x * __builtin_amdgcn_rcpf(1.0f + __expf(-z2))); }
            *(LAS f32x4*)(OUT + ch * PITCH + 8 * chunk) = (f32x4){yo[0], yo[1], yo[2], yo[3]};
            *(LAS f32x4*)(OUT + ch * PITCH + 8 * chunk + 4) = (f32x4){yo[4], yo[5], yo[6], yo[7]};
        }
        __syncthreads();
        {
            const int tk = tid >> 1, hf = tid & 1;
            float yv[8];
#pragma unroll
            for (int e = 0; e < 8; ++e) yv[e] = OUT[(hf * 8 + e) * PITCH + tk];
            u32x4 o; o.x = pk2(yv[0], yv[1]); o.y = pk2(yv[2], yv[3]); o.z = pk2(yv[4], yv[5]); o.w = pk2(yv[6], yv[7]);
            *(GAS u32x4*)(MIXp + (tokbase + tk) * D + 512 + c0 + 8 * hf) = o;
            float ss = bflo(o.x) * bflo(o.x) + bfhi(o.x) * bfhi(o.x) + bflo(o.y) * bflo(o.y) + bfhi(o.y) * bfhi(o.y)
                     + bflo(o.z) * bflo(o.z) + bfhi(o.z) * bfhi(o.z) + bflo(o.w) * bflo(o.w) + bfhi(o.w) * bfhi(o.w);
            ss += __shfl_xor(ss, 1);
            if (hf == 0) SSQL[(tokbase + tk) * 32 + hb * 4 + qt] = ss;
        }
    }
    __syncthreads();
}

struct EpiX1 {
    static constexpr bool PERM = false, MIDK = true;
    const float* x; const float* mod; float* X1; float* SSQ1; const LAS f32x2* RS;
    __device__ __forceinline__ void mid(f32x4 (&acc)[2][2][4][2], const pg8::Unit& u, int wr, int wc, int fr, int fq) const {
#pragma unroll
        for (int ai = 0; ai < 2; ++ai)
#pragma unroll
            for (int m = 0; m < 4; ++m) { const float f = RS[ai * 128 + wr * 64 + m * 16 + fr].x;
#pragma unroll
                for (int bj = 0; bj < 2; ++bj)
#pragma unroll
                    for (int n = 0; n < 2; ++n) acc[ai][bj][m][n] = acc[ai][bj][m][n] * f; }
    }
    __device__ __forceinline__ void operator()(const f32x4 (&acc)[2][2][4][2], const pg8::Unit& u, int wr, int wc, int fr, int fq) const {
        const int col0 = u.pn * 256 + wc * 32 + 4 * fq;
        const int b = (u.pm * 256) / SEQ;
        f32x4 gt[2][2];
#pragma unroll
        for (int bj = 0; bj < 2; ++bj)
#pragma unroll
            for (int n = 0; n < 2; ++n) gt[bj][n] = *(const f32x4*)(mod + b * 6144 + 2048 + col0 + bj * 128 + n * 16);
#pragma unroll
        for (int ai = 0; ai < 2; ++ai)
#pragma unroll
            for (int m = 0; m < 4; ++m) { const int r = ai * 128 + wr * 64 + m * 16 + fr; const float f = RS[r].y;
                const size_t off = (size_t)(u.pm * 256 + r) * D + col0; float ss = 0.f;
#pragma unroll
                for (int bj = 0; bj < 2; ++bj)
#pragma unroll
                    for (int n = 0; n < 2; ++n) { const f32x4 xv = *(const f32x4*)(x + off + bj * 128 + n * 16);
                        const f32x4 o = xv + gt[bj][n] * (acc[ai][bj][m][n] * f);
                        *(f32x4*)(X1 + off + bj * 128 + n * 16) = o;
                        ss += (o[0] * o[0] + o[1] * o[1]) + (o[2] * o[2] + o[3] * o[3]); }
                ss += __shfl_xor(ss, 16); ss += __shfl_xor(ss, 32);
                if (fq == 0) SSQ1[(size_t)(u.pm * 256 + r) * 16 + u.pn * 4 + wc] = ss; }
    }
};
__device__ __forceinline__ void p5_phase(Frame& F, const Args& a) {
    unsigned char* ws = F.ws;
    const float* X1 = (const float*)(ws + WS_X1);
    const float* mod = (const float*)(ws + WS_MOD);
    LAS float* WR = (LAS float*)F.lds;
    LAS float* TAB = (LAS float*)(F.lds + TAB_OFF);
    LAS float* CST = TAB;
    LAS float* RSQ = TAB + 32;
    LAS int* LCNT = (LAS int*)(TAB + 96);
    LAS int* LBASE = (LAS int*)(TAB + 128);
    LAS float* LG = TAB + 160;
    LAS float* CRED = TAB + 160 + 64 * 33;
    const int tid = F.tid, lane = F.lane, w = F.wave;
    for (int tile = F.bx; tile < T / 64; tile += F.G) {
        const int tok0 = tile * 64, b = tok0 / SEQ;
        const float* sh2 = mod + b * 6144 + 3072; const float* sc2 = mod + b * 6144 + 4096;
        { const GAS f32x4* src = (const GAS f32x4*)((const float*)(ws + WS_WRP) + (size_t)b * 32768);
#pragma unroll
          for (int i = 0; i < 16; ++i) ((LAS f32x4*)WR)[tid + NTHR * i] = src[tid + NTHR * i];
          if (tid < 64) { const float* sp = (const float*)(ws + WS_SSQ1) + (size_t)(tok0 + tid) * 16; float s = 0.f;
#pragma unroll
              for (int i = 0; i < 16; ++i) s += sp[i];
              RSQ[tid] = rsqrtf(s * (1.0f / D) + EPS); }
          if (tid < 32) { LCNT[tid] = 0; CST[tid] = ((const float*)(ws + WS_CSTB))[b * 32 + tid]; } }
        __syncthreads();
        f32x16 acc = {};
        { const int tw = w >> 2, kq4 = w & 3, i = lane & 31, hi = lane >> 5;
          const float* xrow = X1 + (size_t)(tok0 + 32 * tw + i) * D + 256 * kq4 + 128 * hi;
          const LAS float* wrow = WR + (256 * kq4 + 128 * hi) * 32 + i;
#pragma unroll 1
          for (int c4 = 0; c4 < 4; ++c4) {
              f32x4 xv[8];
#pragma unroll
              for (int q = 0; q < 8; ++q) xv[q] = *(const GAS f32x4*)(xrow + 32 * c4 + 4 * q);
#pragma unroll
              for (int q = 0; q < 8; ++q)
#pragma unroll
                  for (int r = 0; r < 4; ++r) { const int s = 32 * c4 + 4 * q + r;
                      acc = __builtin_amdgcn_mfma_f32_32x32x2f32(xv[q][r], wrow[s * 32], acc, 0, 0, 0); }
          } }
        __syncthreads();
        {
          LAS float* PART = WR + w * (32 * 33); const int e = lane & 31, hi = lane >> 5;
#pragma unroll
          for (int r = 0; r < 16; ++r) PART[crow(r, hi) * 33 + e] = acc[r]; }
        __syncthreads();
        {
          const int tk = tid >> 3, e0 = (tid & 7) * 4, tw = tk >> 5, tl = tk & 31; const float rs = RSQ[tk];
#pragma unroll
          for (int j = 0; j < 4; ++j) { float s = 0.f;
#pragma unroll
              for (int q = 0; q < 4; ++q) s += WR[(tw * 4 + q) * (32 * 33) + tl * 33 + e0 + j];
              LG[tk * 33 + e0 + j] = rs * s + CST[e0 + j]; } }
        __syncthreads();
        int eidx[4] = {0, 0, 0, 0}; int lpos[4] = {0, 0, 0, 0};
        if (tid < 64) {
            float val[4]; unsigned used = 0u;
#pragma unroll
            for (int k = 0; k < 4; ++k) { float best = -3.0e38f; int bi = 0;
                for (int j = 0; j < 32; ++j) { const float v = LG[tid * 33 + j]; if (!((used >> j) & 1u) && v > best) { best = v; bi = j; } }
                used |= 1u << bi; eidx[k] = bi; val[k] = best; }
            float ex[4], den = 0.f;
#pragma unroll
            for (int k = 0; k < 4; ++k) { ex[k] = __expf(val[k] - val[0]); den += ex[k]; }
            const float inv = 1.0f / den;
            *(f32x4*)((float*)(ws + WS_TOPG) + (size_t)(tok0 + tid) * 4) = (f32x4){ex[0] * inv, ex[1] * inv, ex[2] * inv, ex[3] * inv};
#pragma unroll
            for (int k = 0; k < 4; ++k) lpos[k] = __hip_atomic_fetch_add(LCNT + eidx[k], 1, __ATOMIC_RELAXED, __HIP_MEMORY_SCOPE_WORKGROUP);
        }
        __syncthreads();
        if (tid < 32) { const int c = LCNT[tid]; LBASE[tid] = c > 0 ? (int)__hip_atomic_fetch_add((unsigned*)(ws + WS_CTL) + CW_CNT + tid, (unsigned)c, RLX_AGENT) : 0; }
        __syncthreads();
        if (tid < 64) {
#pragma unroll
            for (int k = 0; k < 4; ++k) ((int*)(ws + WS_LIST))[eidx[k] * LISTCAP + LBASE[eidx[k]] + lpos[k]] = (tok0 + tid) * 4 + k;
        }
        for (int tk = w; tk < 64; tk += NWAVES) {
            const int m = tok0 + tk; const float rs = RSQ[tk];
            const GAS f32x4* xr = (const GAS f32x4*)(X1 + (size_t)m * D) + lane;
            const GAS f32x4* g4 = (const GAS f32x4*)a.in[I_GFFN] + lane;
            const GAS f32x4* sh = (const GAS f32x4*)sh2 + lane; const GAS f32x4* sc = (const GAS f32x4*)sc2 + lane;
            GAS u32x2* o8 = (GAS u32x2*)((bf16_t*)(ws + WS_H) + (size_t)m * D) + lane;
#pragma unroll
            for (int j = 0; j < 4; ++j) { const f32x4 y = xr[64 * j] * rs * g4[64 * j] * (sc[64 * j] + 1.0f) + sh[64 * j];
                u32x2 o; o.x = pk2(y.x, y.y); o.y = pk2(y.z, y.w); o8[64 * j] = o; }
        }
        __syncthreads();
    }
}

struct GroupedOrder {
    const LAS int* TP; const LAS unsigned* AOFF;
    int ntiles, npn, nun, G, c, K; const char* Wt; size_t estride;
    __device__ __forceinline__ bool next(int i, pg8::Unit& u) const {
        const long L = (long)i * G + c; if (L >= nun) return false;
        int wgid = (int)L; { const int q = nun / 8, r = nun % 8, xcd = wgid % 8, off = wgid / 8; wgid = (xcd < r ? xcd * (q + 1) : r * (q + 1) + (xcd - r) * q) + off; }
        const int WGM = 8;
        const int nig = WGM * npn, gid = wgid / nig, fm = gid * WGM, gsz = (ntiles - fm) < WGM ? (ntiles - fm) : WGM;
        u.pm = fm + ((wgid % nig) % gsz); u.pn = (wgid % nig) / gsz; u.li = i;
        int e = 0;
        for (int j = 1; j < NE; ++j) e += (TP[j] <= u.pm) ? 1 : 0;
        u.e = e;
        u.bptr = Wt + (size_t)e * estride + (size_t)u.pn * 256 * K * 2;
        return true;
    }
    __device__ __forceinline__ unsigned a_off(const pg8::Unit& u, int r) const {
        if (AOFF) return AOFF[u.li * 256 + r];
        return (unsigned)((u.pm * 256 + r) * K * 2);
    }
};

struct EpiSwiglu {
    static constexpr bool PERM = true, MIDK = false;
    bf16_t* ACT; const float* b_gu;
    __device__ __forceinline__ void mid(f32x4 (&acc)[2][2][4][2], const pg8::Unit& u, int wr, int wc, int fr, int fq) const {}
    __device__ __forceinline__ void operator()(const f32x4 (&acc)[2][2][4][2], const pg8::Unit& u, int wr, int wc, int fr, int fq) const {
        const int c0 = u.pn * 128 + wc * 32 + 8 * fq;
        const float* bg = b_gu + u.e * 2048 + c0;
        f32x4 bgate[2], bup[2];
#pragma unroll
        for (int n = 0; n < 2; ++n) { bgate[n] = *(const f32x4*)(bg + 4 * n); bup[n] = *(const f32x4*)(bg + 1024 + 4 * n); }
#pragma unroll
        for (int ai = 0; ai < 2; ++ai)
#pragma unroll
            for (int m = 0; m < 4; ++m) { const int r = ai * 128 + wr * 64 + m * 16 + fr;
                float o[8];
#pragma unroll
                for (int n = 0; n < 2; ++n)
#pragma unroll
                    for (int j = 0; j < 4; ++j) {
                        const float gate = fminf(acc[ai][0][m][n][j] + bgate[n][j], 7.0f);
                        const float up = fminf(fmaxf(acc[ai][1][m][n][j] + bup[n][j], -7.0f), 7.0f);
                        const float glu = gate * __builtin_amdgcn_rcpf(1.0f + __expf(-1.702f * gate));
                        o[4 * n + j] = (up + 1.0f) * glu; }
                u32x4 w; w.x = cvt_pk_bf16(o[0], o[1]); w.y = cvt_pk_bf16(o[2], o[3]); w.z = cvt_pk_bf16(o[4], o[5]); w.w = cvt_pk_bf16(o[6], o[7]);
                *(u32x4*)(ACT + (size_t)(u.pm * 256 + r) * 1024 + c0) = w; }
    }
};
struct EpiDown {
    static constexpr bool PERM = true, MIDK = false;
    bf16_t* YB; const float* b_dn; const LAS int* SLOT;
    __device__ __forceinline__ void mid(f32x4 (&acc)[2][2][4][2], const pg8::Unit& u, int wr, int wc, int fr, int fq) const {}
    __device__ __forceinline__ void operator()(const f32x4 (&acc)[2][2][4][2], const pg8::Unit& u, int wr, int wc, int fr, int fq) const {
        const int col0 = u.pn * 256 + wc * 32 + 8 * fq;
        const float* bd = b_dn + u.e * 1024 + col0;
        f32x4 bv[2][2];
#pragma unroll
        for (int bj = 0; bj < 2; ++bj)
#pragma unroll
            for (int n = 0; n < 2; ++n) bv[bj][n] = *(const f32x4*)(bd + bj * 128 + 4 * n);
#pragma unroll
        for (int ai = 0; ai < 2; ++ai)
#pragma unroll
            for (int m = 0; m < 4; ++m) { const int r = ai * 128 + wr * 64 + m * 16 + fr;
                const int slot = SLOT[u.li * 256 + r];
                bf16_t* rowp = YB + (size_t)slot * 1024 + col0;
#pragma unroll
                for (int bj = 0; bj < 2; ++bj) { const f32x4 v0 = acc[ai][bj][m][0] + bv[bj][0], v1 = acc[ai][bj][m][1] + bv[bj][1];
                    u32x4 w; w.x = cvt_pk_bf16(v0[0], v0[1]); w.y = cvt_pk_bf16(v0[2], v0[3]); w.z = cvt_pk_bf16(v1[0], v1[1]); w.w = cvt_pk_bf16(v1[2], v1[3]);
                    *(u32x4*)(rowp + bj * 128) = w; } }
    }
};

template <int MODE>
__device__ __forceinline__ void grouped_setup(Frame& F, GroupedOrder& S, int npn, const void* Wt, size_t estride) {
    LAS int* TP = (LAS int*)(F.lds + TAB_OFF);
    LAS unsigned* TABR = (LAS unsigned*)(F.lds + TAB_OFF + 256);
    const unsigned* cnt = (const unsigned*)(F.ws + WS_CTL) + CW_CNT;
    if (F.tid == 0) { int acc = 0;
        for (int e = 0; e < NE; ++e) { TP[e] = acc; const int c = (int)__hip_atomic_load(cnt + e, RLX_AGENT); acc += (c + 255) >> 8; }
        TP[NE] = acc; }
    __syncthreads();
    S.TP = TP; S.AOFF = (MODE == 1) ? (const LAS unsigned*)TABR : nullptr;
    S.ntiles = TP[NE]; S.npn = npn; S.nun = S.ntiles * npn; S.G = F.G; S.c = F.bx; S.K = 1024; S.Wt = (const char*)Wt; S.estride = estride;
    const int* LIST = (const int*)(F.ws + WS_LIST);
    pg8::Unit u;
    for (int li = 0; li < 12 && S.next(li, u); ++li) {
        if (F.tid < 256) { const int slot = LIST[u.e * LISTCAP + (u.pm - TP[u.e]) * 256 + F.tid];
            TABR[li * 256 + F.tid] = (MODE == 1) ? (unsigned)(slot >> 2) * 2048u : (unsigned)slot; }
    }
    __syncthreads();
}

__device__ __forceinline__ void p8_phase(Frame& F, const Args& a) {
    const int gw = F.bx * NWAVES + F.wave, NGW = F.G * NWAVES, lane = F.lane;
    const float* X1 = (const float*)(F.ws + WS_X1); const float* mod = (const float*)(F.ws + WS_MOD);
    const bf16_t* YB = (const bf16_t*)(F.ws + WS_YB); const float* TOPG = (const float*)(F.ws + WS_TOPG);
    const GAS f32x4* gf = (const GAS f32x4*)a.in[I_GFIN] + lane;
    for (int m = gw; m < T; m += NGW) {
        const int b = m / SEQ;
        const f32x4 gk = *(const f32x4*)(TOPG + (size_t)m * 4);
        const GAS f32x4* xr = (const GAS f32x4*)(X1 + (size_t)m * D) + lane;
        const GAS f32x4* g2 = (const GAS f32x4*)(mod + b * 6144 + 5120) + lane;
        f32x4 v[4]; float ss = 0.f;
#pragma unroll
        for (int j = 0; j < 4; ++j) { f32x4 s = {0.f, 0.f, 0.f, 0.f};
#pragma unroll
            for (int k = 0; k < 4; ++k) { const u32x2 y = *((const GAS u32x2*)(YB + (size_t)(m * 4 + k) * D) + lane + 64 * j);
                s += (f32x4){bflo(y.x), bfhi(y.x), bflo(y.y), bfhi(y.y)} * gk[k]; }
            v[j] = xr[64 * j] + g2[64 * j] * s;
            ss += (v[j].x * v[j].x + v[j].y * v[j].y) + (v[j].z * v[j].z + v[j].w * v[j].w); }
        const float rs = rsqrtf(wave_sum(ss) * (1.f / D) + EPS);
        GAS f32x4* o = (GAS f32x4*)(a.out + (size_t)m * D) + lane;
#pragma unroll
        for (int j = 0; j < 4; ++j) o[64 * j] = v[j] * rs * gf[64 * j];
    }
}
__global__ void __launch_bounds__(NTHR, 2) mega_fwd(Args args) {
    extern __shared__ __attribute__((aligned(16))) unsigned char lds_raw[];
    Frame F;
    F.lds = (LAS unsigned char*)lds_raw;
    F.tid = threadIdx.x; F.lane = F.tid & 63; F.wave = __builtin_amdgcn_readfirstlane(F.tid >> 6);
    F.G = gridDim.x; F.bx = blockIdx.x; F.ws = args.ws;
    volatile LAS unsigned* MISC = (volatile LAS unsigned*)(F.lds + LDSCTL_OFF);
    for (int u = F.tid; u < 128; u += NTHR) MISC[u] = 0u;
    __syncthreads();
    unsigned* ctl = (unsigned*)(args.ws + WS_CTL);
    XcdBarrier bar = xcd_barrier_post(ctl + CW_BAR, MISC + 8);
    const int lo = args.ph_lo, hi = args.ph_hi;
#define IN(k) (lo <= (k) && (k) < hi)
#define SEAM(k) do { if (IN(k) && IN((k) + 1)) xcd_barrier(bar); } while (0)
    if (IN(0)) { p0_phase(F, args); } SEAM(0);
    if (IN(1)) { p1_phase(F, args); } SEAM(1);
    if (IN(2)) {
        pg8::DenseOrder S; S.init(T, NCOL, D, args.ws + WS_WIN, F.G, F.bx);
        EpiBf16 E{(bf16_t*)(args.ws + WS_P), NCOL};
        pg8::gemm_phase<EpiBf16, pg8::DenseOrder, true>(F.lds, (const char*)(args.ws + WS_H), D, S, E);
    } SEAM(2);
    if (IN(3)) {
        for (int it = F.bx; it < 256; it += F.G) attn_item(F, args, it);
        for (int it = F.bx; it < 256; it += F.G) lru_item(F, args, it);
    } SEAM(3);
    if (IN(4)) {
        pg8::DenseOrder S; S.init(T, D, D, args.ws + WS_WOUT, F.G, F.bx);
        LAS f32x2* RS = (LAS f32x2*)(F.lds + TAB_OFF);
        pg8::Unit u0;
        if (S.next(0, u0)) {
            if (F.tid < 256) { const size_t tok = (size_t)u0.pm * 256 + F.tid;
                const float* sa = (const float*)(args.ws + WS_SSQA) + tok * 8; const float* sl = (const float*)(args.ws + WS_SSQL) + tok * 32;
                float ssa = 0.f, ssl = 0.f;
#pragma unroll
                for (int i = 0; i < 8; ++i) ssa += sa[i];
#pragma unroll
                for (int i = 0; i < 32; ++i) ssl += sl[i];
                const float ra = rsqrtf(ssa * (1.0f / 512) + EPS), rl = rsqrtf(ssl * (1.0f / 512) + EPS);
                RS[F.tid] = (f32x2){ra / rl, rl}; }
        }
        __syncthreads();
        EpiX1 E{args.in[I_X], (const float*)(args.ws + WS_MOD), (float*)(args.ws + WS_X1), (float*)(args.ws + WS_SSQ1), RS};
        pg8::gemm_phase<EpiX1, pg8::DenseOrder, false>(F.lds, (const char*)(args.ws + WS_MIX), D, S, E);
    } SEAM(4);
    if (IN(5)) { p5_phase(F, args); } SEAM(5);
    if (IN(6)) {
        GroupedOrder S; grouped_setup<1>(F, S, 8, args.ws + WS_WGU, (size_t)2048 * 1024 * 2);
        EpiSwiglu E{(bf16_t*)(args.ws + WS_ACT), args.in[I_BGU]};
        pg8::gemm_phase<EpiSwiglu, GroupedOrder, true>(F.lds, (const char*)(args.ws + WS_H), D, S, E);
    } SEAM(6);
    if (IN(7)) {
        GroupedOrder S; grouped_setup<2>(F, S, 4, args.ws + WS_WDN, (size_t)1024 * 1024 * 2);
        EpiDown E{(bf16_t*)(args.ws + WS_YB), args.in[I_BDN], (const LAS int*)(F.lds + TAB_OFF + 256)};
        pg8::gemm_phase<EpiDown, GroupedOrder, true>(F.lds, (const char*)(args.ws + WS_ACT), D, S, E);
    } SEAM(7);
    if (IN(8)) { p8_phase(F, args); }
#undef IN
#undef SEAM
}
}
extern "C" void kernel_launch(void* const* d_in, const int* in_sizes, int n_in, void* d_out, int out_size, void* d_ws, size_t ws_size,
                              hipStream_t stream) {
    static int grid = 0;
    if (grid == 0) {
        if (n_in != 25 || out_size != mk::T * mk::D || ws_size < mk::WS_END) { fprintf(stderr, "kernel_launch: unexpected problem shape (n_in %d out %d ws %zu)\n", n_in, out_size, ws_size); grid = -1; return; }
        int dev = 0, cus = 0, per_cu = 0;
        if (hipGetDevice(&dev) != hipSuccess || hipDeviceGetAttribute(&cus, hipDeviceAttributeMultiprocessorCount, dev) != hipSuccess) { grid = -1; return; }
        if (hipFuncSetAttribute((const void*)mk::mega_fwd, hipFuncAttributeMaxDynamicSharedMemorySize, mk::LDS_BYTES) != hipSuccess) { fprintf(stderr, "kernel_launch: hipFuncSetAttribute failed\n"); grid = -1; return; }
        if (hipOccupancyMaxActiveBlocksPerMultiprocessor(&per_cu, (const void*)mk::mega_fwd, mk::NTHR, mk::LDS_BYTES) != hipSuccess || per_cu < 1) { fprintf(stderr, "kernel_launch: occupancy query says %d workgroups per CU\n", per_cu); grid = -1; return; }
        grid = cus;
    }
    if (grid < 0) return;
    if (hipMemsetAsync((char*)d_ws + mk::WS_CTL, 0, mk::CTL_ZERO_BYTES, stream) != hipSuccess) return;
    mk::Args a{};
    for (int i = 0; i < 25; ++i) a.in[i] = (const float*)d_in[i];
    a.out = (float*)d_out; a.ws = (unsigned char*)d_ws; a.ph_lo = 0; a.ph_hi = 9;
    void* kargs[] = {&a};
    hipError_t le = hipLaunchCooperativeKernel((const void*)mk::mega_fwd, dim3(grid), dim3(mk::NTHR), kargs, mk::LDS_BYTES, stream);
    if (le != hipSuccess) fprintf(stderr, "kernel_launch: cooperative launch failed: %s (grid %d)\n", hipGetErrorString(le), grid);
}
```

```cpp
#include <hip/hip_runtime.h>
#include <stdint.h>
#include <stdio.h>
namespace mk {
#define LAS __attribute__((address_space(3)))
#define GAS __attribute__((address_space(1)))
typedef unsigned short bf16_t;
typedef short bf16x8 __attribute__((ext_vector_type(8)));
typedef short s16x4 __attribute__((ext_vector_type(4)));
typedef float f32x2 __attribute__((ext_vector_type(2)));
typedef float f32x4 __attribute__((ext_vector_type(4)));
typedef float f32x16 __attribute__((ext_vector_type(16)));
typedef unsigned u32x2 __attribute__((ext_vector_type(2)));
typedef unsigned u32x4 __attribute__((ext_vector_type(4)));

constexpr int NWAVES = 8, NTHR = 512;
constexpr int NB = 8, SEQ = 2048, D = 1024, T = NB * SEQ, NCOL = 1792, NE = 32;
constexpr int QOFF = 0, KOFF = 512, VOFF = 640, XROFF = 768, XGOFF = 1280;
constexpr int LISTCAP = 16384, DUMP = 65536, MAXTILES = 288;
constexpr float EPS = 1e-6f;
constexpr float WSCALE = 32.0f, WUNSCALE = 1.0f / 32.0f;

constexpr size_t MiB = 1u << 20;
constexpr size_t WS_CTL = 0, CTL_ZERO_BYTES = 64 * 1024;
constexpr int CW_CNT = 64;
constexpr int CW_BAR = 4096;
constexpr size_t WS_MOD = 1 * MiB;
constexpr size_t WS_CSTB = 1 * MiB + 256 * 1024;
constexpr size_t WS_TOPG = 2 * MiB;
constexpr size_t WS_WRP = 3 * MiB;
constexpr size_t WS_LIST = 4 * MiB;
constexpr size_t WS_SSQA = 6 * MiB;
constexpr size_t WS_SSQL = 7 * MiB;
constexpr size_t WS_SSQ1 = 9 * MiB;
constexpr size_t WS_WIN = 10 * MiB;
constexpr size_t WS_WOUT = 14 * MiB;
constexpr size_t WS_WGU = 16 * MiB;
constexpr size_t WS_WDN = 144 * MiB;
constexpr size_t WS_H = 208 * MiB;
constexpr size_t WS_P = 242 * MiB;
constexpr size_t WS_MIX = 298 * MiB;
constexpr size_t WS_X1 = 330 * MiB;
constexpr size_t WS_ACT = 394 * MiB;
constexpr size_t WS_YB = 538 * MiB;
constexpr size_t WS_END = 668 * MiB;

constexpr int RING_BYTES = 131072;
constexpr int LDSCTL_OFF = RING_BYTES;
constexpr int TAB_OFF = RING_BYTES + 512;
constexpr int LDS_BYTES = 147456;

#define RLX_AGENT __ATOMIC_RELAXED, __HIP_MEMORY_SCOPE_AGENT
#define LDS_WAIT() asm volatile("s_waitcnt lgkmcnt(0)" ::: "memory")
#define VM_WAIT() asm volatile("s_waitcnt vmcnt(0)" ::: "memory")
__device__ __forceinline__ unsigned f2bf(float f) { unsigned u = __builtin_bit_cast(unsigned, f); return (u + 0x7fffu + ((u >> 16) & 1u)) >> 16; }
__device__ __forceinline__ unsigned pk2(float lo, float hi) { return f2bf(lo) | (f2bf(hi) << 16); }
__device__ __forceinline__ float bf2f(unsigned short h) { return __builtin_bit_cast(float, (unsigned)h << 16); }
__device__ __forceinline__ float bflo(unsigned w) { return __builtin_bit_cast(float, w << 16); }
__device__ __forceinline__ float bfhi(unsigned w) { return __builtin_bit_cast(float, w & 0xffff0000u); }
__device__ __forceinline__ unsigned cvt_pk_bf16(float lo, float hi) { unsigned r; asm volatile("v_cvt_pk_bf16_f32 %0, %1, %2" : "=v"(r) : "v"(lo), "v"(hi)); return r; }
__device__ __forceinline__ float wave_sum(float v) {
#pragma unroll
    for (int o = 1; o < 64; o <<= 1) v += __shfl_xor(v, o);
    return v;
}

#define XB_TMO      128
#define XB_XCNT(j)  (256  + 64 * (j))
#define XB_XSUB(j)  (1280 + 64 * (j))
#define XB_XGEN(j)  (2304 + 64 * (j))
#define XB_TOP      3328
#define XB_TOPGEN   3392
#define XCD_BAR_WORDS 3456
#define XB_SPIN_CAP (1u << 20)
__device__ __forceinline__ unsigned xb_ld(unsigned* p)              { return __hip_atomic_load(p, __ATOMIC_RELAXED, __HIP_MEMORY_SCOPE_AGENT); }
__device__ __forceinline__ unsigned xb_add(unsigned* p, unsigned v) { return __hip_atomic_fetch_add(p, v, __ATOMIC_RELAXED, __HIP_MEMORY_SCOPE_AGENT); }
__device__ __forceinline__ unsigned xb_xcc_id() { return (unsigned)__builtin_amdgcn_s_getreg((3 << 11) | 20) & 0xFu; }
#define XB_SPIN(cond, bar) do { unsigned _sp = 0; while (cond) { __builtin_amdgcn_s_sleep(1); \
    if ((++_sp & 255u) == 0u) { if (xb_ld(&(bar)[XB_TMO])) break; if (_sp > XB_SPIN_CAP) { atomicAdd(&(bar)[XB_TMO], 1u); break; } } } } while (0)
struct XcdBarrier { unsigned* bar; unsigned x; volatile LAS unsigned* st; };
__device__ __forceinline__ XcdBarrier xcd_barrier_post(unsigned* bar, volatile LAS unsigned* st) {
    XcdBarrier b; b.bar = bar; b.x = xb_xcc_id(); b.st = st;
    if (threadIdx.x == 0) (void)xb_add(&bar[XB_XCNT(b.x)], 1u);
    return b;
}
__device__ __forceinline__ void xcd_barrier_complete(unsigned* bar, unsigned x, unsigned& nloc, unsigned& nx) {
    const unsigned G = gridDim.x * gridDim.y * gridDim.z;
    unsigned sum, cnt, mine, sp = 0u;
    for (;;) {
        sum = 0u; cnt = 0u; mine = 0u;
#pragma unroll
        for (unsigned j = 0; j < 16; ++j) { const unsigned c = xb_ld(&bar[XB_XCNT(j)]); sum += c; cnt += (c > 0u) ? 1u : 0u; mine = (j == x) ? c : mine; }
        if (sum == G) break;
        __builtin_amdgcn_s_sleep(1);
        if ((++sp & 255u) == 0u) { if (xb_ld(&bar[XB_TMO])) break; if (sp > XB_SPIN_CAP) { atomicAdd(&bar[XB_TMO], 1u); break; } }
    }
    nloc = mine > 0u ? mine : 1u; nx = cnt > 0u ? cnt : 1u;
}
__device__ __forceinline__ void xcd_barrier(const XcdBarrier& b) {
    asm volatile("s_waitcnt vmcnt(0)" ::: "memory");
    __syncthreads();
    if (threadIdx.x == 0) {
        unsigned* bar = b.bar;
        __builtin_amdgcn_s_waitcnt(0);
        unsigned nloc = b.st[0], nx = b.st[1];
        if (nloc == 0u) { xcd_barrier_complete(bar, b.x, nloc, nx); b.st[0] = nloc; b.st[1] = nx; }
        const unsigned old = xb_add(&bar[XB_XSUB(b.x)], 1u);
        const unsigned gen = old / nloc;
        if (old + 1u == (gen + 1u) * nloc) {
            __builtin_amdgcn_fence(__ATOMIC_RELEASE, "agent");
            asm volatile("s_waitcnt vmcnt(0)" ::: "memory");
            const unsigned og = xb_add(&bar[XB_TOP], 1u);
            const unsigned tg = og / nx;
            if (og + 1u == (tg + 1u) * nx) xb_add(&bar[XB_TOPGEN], 1u);
            else XB_SPIN(xb_ld(&bar[XB_TOPGEN]) == tg, bar);
            __builtin_amdgcn_fence(__ATOMIC_ACQUIRE, "agent");
            xb_add(&bar[XB_XGEN(b.x)], 1u);
            asm volatile("s_waitcnt vmcnt(0)" ::: "memory");
        } else {
            XB_SPIN(xb_ld(&bar[XB_XGEN(b.x)]) == gen, bar);
            __builtin_amdgcn_fence(__ATOMIC_ACQUIRE, "agent");
            asm volatile("s_waitcnt vmcnt(0)" ::: "memory");
        }
    }
    __syncthreads();
}

namespace pg8 {
constexpr int BM = 256, BK = 64, HALF = 128, HTB = HALF * BK * 2, STAGE_BYTES = 8 * HTB, NXCD = 8;
__device__ __forceinline__ int lds_byte(int r, int c) { const int st = (r >> 4) * 2 + (c >> 5), rr = r & 15, cc = c & 31, ob = rr * 64 + cc * 2; return st * 1024 + (ob ^ (((ob >> 9) & 1) << 5)); }
__device__ __forceinline__ void stage_rc(int b, int& R, int& C) { const int st = b / 1024, sb = b % 1024, swz = sb ^ (((sb >> 9) & 1) << 5); R = (st >> 1) * 16 + swz / 64; C = (st & 1) * 32 + (swz % 64) / 2; }
__device__ __forceinline__ int perm32(int rho) { const int n = rho >> 4, i = rho & 15; return 8 * (i >> 2) + 4 * n + (i & 3); }

struct Unit { int pm, pn, e, li; const char* bptr; };
typedef int v8i_t __attribute__((ext_vector_type(8)));
typedef int v4i_t __attribute__((ext_vector_type(4)));
__device__ __forceinline__ const char* uniform_ptr(const char* p) { const unsigned long long v = (unsigned long long)p;
    const unsigned lo = __builtin_amdgcn_readfirstlane((unsigned)v), hi = __builtin_amdgcn_readfirstlane((unsigned)(v >> 32)); return (const char*)(((unsigned long long)hi << 32) | lo); }
__device__ __forceinline__ v8i_t cat8(bf16x8 lo, bf16x8 hi) { const v4i_t a = __builtin_bit_cast(v4i_t, lo), b = __builtin_bit_cast(v4i_t, hi); return __builtin_shufflevector(a, b, 0, 1, 2, 3, 4, 5, 6, 7); }

template <class Epi, class Sched, bool ALIGN_EPI, bool F8>
__device__ __forceinline__ void gemm_phase(LAS unsigned char* lds, const char* Abase, const int rowbytes, const Sched& S, const Epi& E) {
    const int tid = threadIdx.x, wid = __builtin_amdgcn_readfirstlane(tid >> 6), lane = tid & 63, wr = wid >> 2, wc = wid & 3, fr = lane & 15, fq = lane >> 4;
    const int nt = rowbytes / 128;
    unsigned voffB[2];
#pragma unroll
    for (int i = 0; i < 2; ++i) { int R, C; stage_rc(tid * 16 + i * 8192, R, C); const int Rb = Epi::PERM ? ((R & ~31) + perm32(R & 31)) : R;
        voffB[i] = (unsigned)(Rb * rowbytes + C * 2); }
#define PG8_AOFF(dst, unit) do { _Pragma("unroll") for (int _i = 0; _i < 2; ++_i) { int R, C; stage_rc(tid * 16 + _i * 8192, R, C); \
        dst[0][_i] = S.a_off(unit, R) + (unsigned)(C * 2); dst[1][_i] = S.a_off(unit, HALF + R) + (unsigned)(C * 2); } } while (0)
    const size_t kstep = (size_t)(BK * 2);
    const size_t hstepB = (size_t)HALF * rowbytes;
    const unsigned ldsw = (unsigned)wid * 1024u;
    const int aoff = lds_byte(wr * 64 + fr, fq * 8), boff = lds_byte(wc * 32 + fr, fq * 8);
#define PG8_SA(b, h) (((b) * 2 + (h)) * HTB)
#define PG8_SB(b, h) ((4 + (b) * 2 + (h)) * HTB)
#define PG8_STAGE_B(bufoff, gbase) do { const char* _gb = (const char*)(gbase); asm volatile("" : "+s"(_gb)); _Pragma("unroll") for (int _i = 0; _i < 2; ++_i) { \
        unsigned _o = voffB[_i]; asm volatile("" : "+v"(_o)); \
        __builtin_amdgcn_global_load_lds((const unsigned*)(_gb + _o), (LAS unsigned*)(lds + (bufoff) + ldsw + _i * 8192), 16, 0, 0); } } while (0)
#define PG8_STAGE_A(bufoff, OFF, h, kb) do { const char* _ab = Abase + (size_t)(kb); asm volatile("" : "+s"(_ab)); _Pragma("unroll") for (int _i = 0; _i < 2; ++_i) { \
        unsigned _o = (OFF)[h][_i]; asm volatile("" : "+v"(_o)); \
        __builtin_amdgcn_global_load_lds((const unsigned*)(_ab + _o), (LAS unsigned*)(lds + (bufoff) + ldsw + _i * 8192), 16, 0, 0); } } while (0)
#define PG8_LDA(dst, b, h) do { _Pragma("unroll") for (int m = 0; m < 4; ++m) _Pragma("unroll") for (int k = 0; k < 2; ++k) dst[m][k] = *(const LAS bf16x8*)(lds + PG8_SA(b, h) + aoff + m * 2048 + k * 1024); } while (0)
#define PG8_LDB(dst, b, h) do { _Pragma("unroll") for (int n = 0; n < 2; ++n) _Pragma("unroll") for (int k = 0; k < 2; ++k) dst[n][k] = *(const LAS bf16x8*)(lds + PG8_SB(b, h) + boff + n * 2048 + k * 1024); } while (0)
#define PG8_MMA(ai, bj, At, Bt) do { __builtin_amdgcn_s_setprio(1); _Pragma("unroll") for (int m = 0; m < 4; ++m) _Pragma("unroll") for (int n = 0; n < 2; ++n) { \
        if constexpr (F8) { acc[ai][bj][m][n] = __builtin_amdgcn_mfma_scale_f32_16x16x128_f8f6f4(cat8(Bt[n][0], Bt[n][1]), cat8(At[m][0], At[m][1]), acc[ai][bj][m][n], 0, 0, 0, 0x7f7f7f7f, 0, 0x7f7f7f7f); } \
        else { _Pragma("unroll") for (int k = 0; k < 2; ++k) acc[ai][bj][m][n] = __builtin_amdgcn_mfma_f32_16x16x32_bf16(Bt[n][k], At[m][k], acc[ai][bj][m][n], 0, 0, 0); } } \
        __builtin_amdgcn_s_setprio(0); } while (0)
#define PG8_WAIT_V(n) asm volatile("s_waitcnt vmcnt(" #n ")" ::: "memory")
#define PG8_WAIT_L(n) asm volatile("s_waitcnt lgkmcnt(" #n ")" ::: "memory")
#define PG8_BAR __builtin_amdgcn_s_barrier()
#define PG8_SCHED __builtin_amdgcn_sched_barrier(0)
    Unit cur, nxt; int ui = 0;
    if (!S.next(0, cur)) return;
    f32x4 acc[2][2][4][2];
#pragma unroll
    for (int a = 0; a < 2; ++a)
#pragma unroll
        for (int b = 0; b < 2; ++b)
#pragma unroll
            for (int m = 0; m < 4; ++m)
#pragma unroll
                for (int n = 0; n < 2; ++n) acc[a][b][m][n] = (f32x4){0.f, 0.f, 0.f, 0.f};
    bf16x8 At[4][2], B0[2][2], B1[2][2];
    unsigned aC[2][2];
    PG8_AOFF(aC, cur);
    const char* cB = uniform_ptr(cur.bptr);
    PG8_STAGE_B(PG8_SB(0, 0), cB); PG8_STAGE_B(PG8_SB(0, 1), cB + hstepB); PG8_STAGE_A(PG8_SA(0, 0), aC, 0, 0); PG8_STAGE_A(PG8_SA(0, 1), aC, 1, 0);
    if (wr == 1) PG8_BAR;
    PG8_WAIT_V(2); PG8_BAR;
    PG8_STAGE_B(PG8_SB(1, 0), cB + kstep); PG8_STAGE_A(PG8_SA(1, 0), aC, 0, kstep); PG8_STAGE_B(PG8_SB(1, 1), cB + hstepB + kstep);
    PG8_WAIT_V(6); PG8_BAR;
    for (;;) {
        bool has_next = false; const char* nB = cB;
#pragma unroll 1
        for (int t = 0; t < nt; t += 2) {
            const bool last = (t == nt - 2);
            const size_t k1 = (size_t)(t + 1) * kstep;
            const size_t k2 = last ? 0 : (size_t)(t + 2) * kstep, k3 = k2 + kstep;
            if constexpr (Epi::MIDK) { if (t == nt / 2) { int fr_ = fr; asm volatile("" : "+v"(fr_)); E.mid(acc, cur, wr, wc, fr_, fq); } }
            PG8_LDB(B0, 0, 0); PG8_LDB(B1, 0, 1); PG8_SCHED; PG8_LDA(At, 0, 0); PG8_STAGE_A(PG8_SA(1, 1), aC, 1, k1);
            if (last) {
                has_next = S.next(ui + 1, nxt);
                if (has_next) { nB = uniform_ptr(nxt.bptr); PG8_AOFF(aC, nxt); }
            }
            const char* b2 = last ? nB : cB + (size_t)(t + 2) * kstep; const char* b3 = b2 + kstep;
            PG8_WAIT_V(8); PG8_WAIT_L(0); PG8_BAR; PG8_MMA(0, 0, At, B0); PG8_MMA(0, 1, At, B1); PG8_BAR; PG8_SCHED;
            PG8_LDA(At, 0, 1); PG8_STAGE_B(PG8_SB(0, 0), b2); PG8_STAGE_B(PG8_SB(0, 1), b2 + hstepB); PG8_STAGE_A(PG8_SA(0, 0), aC, 0, k2);
            PG8_WAIT_V(8); PG8_WAIT_L(0); PG8_BAR; PG8_MMA(1, 0, At, B0); PG8_MMA(1, 1, At, B1); PG8_BAR; PG8_SCHED;
            PG8_LDB(B0, 1, 0); PG8_LDB(B1, 1, 1); PG8_SCHED; PG8_LDA(At, 1, 0); PG8_STAGE_A(PG8_SA(0, 1), aC, 1, k2);
            PG8_WAIT_V(8); PG8_WAIT_L(0); PG8_BAR; PG8_MMA(0, 0, At, B0); PG8_MMA(0, 1, At, B1); PG8_BAR; PG8_SCHED;
            PG8_LDA(At, 1, 1); PG8_STAGE_B(PG8_SB(1, 0), b3); PG8_STAGE_B(PG8_SB(1, 1), b3 + hstepB); PG8_STAGE_A(PG8_SA(1, 0), aC, 0, k3);
            PG8_WAIT_V(8); PG8_WAIT_L(0); PG8_BAR; PG8_MMA(1, 0, At, B0); PG8_MMA(1, 1, At, B1); PG8_BAR; PG8_SCHED;
        }
        if constexpr (ALIGN_EPI) { if (wr == 0) PG8_BAR; }
        { int fr_ = fr, fq_ = fq; asm volatile("" : "+v"(fr_), "+v"(fq_));
          E(acc, cur, wr, wc, fr_, fq_); }
        if (!has_next) break;
#pragma unroll
        for (int a = 0; a < 2; ++a)
#pragma unroll
            for (int b = 0; b < 2; ++b)
#pragma unroll
                for (int m = 0; m < 4; ++m)
#pragma unroll
                    for (int n = 0; n < 2; ++n) acc[a][b][m][n] = (f32x4){0.f, 0.f, 0.f, 0.f};
        cur = nxt; cB = nB; ++ui;
        if constexpr (ALIGN_EPI) { if (wr == 1) PG8_BAR; }
    }
    PG8_WAIT_V(0);
    if constexpr (!ALIGN_EPI) { if (wr == 0) PG8_BAR; }
    PG8_BAR;
#undef PG8_AOFF
#undef PG8_SA
#undef PG8_SB
#undef PG8_STAGE_A
#undef PG8_STAGE_B
#undef PG8_LDA
#undef PG8_LDB
#undef PG8_MMA
#undef PG8_WAIT_V
#undef PG8_WAIT_L
#undef PG8_BAR
#undef PG8_SCHED
}

struct DenseOrder {
    int nM, nN, nwg, G, c, rowbytes; const char* Bt;
    __device__ void init(int M, int N, int rowbytes_, const void* Bt_, int G_, int c_) { nM = M / BM; nN = N / BM; nwg = nM * nN; G = G_; c = c_; rowbytes = rowbytes_; Bt = (const char*)Bt_; }
    __device__ __forceinline__ bool next(int i, Unit& u) const {
        const long L = (long)i * G + c; if (L >= nwg) return false;
        int wgid = (int)L; { const int q = nwg / NXCD, r = nwg % NXCD, xcd = wgid % NXCD, off = wgid / NXCD; wgid = (xcd < r ? xcd * (q + 1) : r * (q + 1) + (xcd - r) * q) + off; }
        const int WGM = 8;
        const int nig = WGM * nN, gid = wgid / nig, fm = gid * WGM, gsz = (nM - fm) < WGM ? (nM - fm) : WGM;
        u.pm = fm + ((wgid % nig) % gsz); u.pn = (wgid % nig) / gsz; u.e = 0; u.li = i;
        u.bptr = Bt + (size_t)u.pn * BM * rowbytes;
        return true;
    }
    __device__ __forceinline__ unsigned a_off(const Unit& u, int r) const { return (unsigned)((u.pm * BM + r) * rowbytes); }
};
}
struct Args { const float* in[25]; float* out; unsigned char* ws; int ph_lo, ph_hi; };
enum { I_X = 0, I_C, I_WADA, I_BADA, I_GMIX, I_WIN, I_CONVW, I_CONVB, I_WRGA, I_BRGA, I_WRGX, I_BRGX, I_LAM, I_SINKS, I_GATT, I_GLRU, I_WOUT, I_GFFN,
       I_WR, I_BR, I_WGU, I_BGU, I_WDN, I_BDN, I_GFIN };

struct Frame {
    LAS unsigned char* lds;
    int tid, lane, wave, G, bx;
    unsigned char* ws;
};

struct CvtItem { const float* src; unsigned char* dst; const float* ks; int N; int f8; };
__device__ __forceinline__ CvtItem p0_decode(const Args& a, unsigned char* ws, int it) {
    constexpr int I_IN = 16 * 56, I_OUT = 16 * 32, I_GU = 32 * 16 * 64;
    CvtItem d; int r = it; d.ks = nullptr; d.f8 = 0;
    if (r < I_IN) { const int kb = r / 56, nb = r % 56; d.N = 1792; d.src = a.in[I_WIN] + (size_t)kb * 64 * 1792 + nb * 32; d.dst = ws + WS_WIN + ((size_t)nb * 32 * 1024 + kb * 64) * 2; return d; } r -= I_IN;
    if (r < I_OUT) { const int kb = r / 32, nb = r % 32; d.N = 1024; d.src = a.in[I_WOUT] + (size_t)kb * 64 * 1024 + nb * 32; d.dst = ws + WS_WOUT + ((size_t)nb * 32 * 1024 + kb * 64) * 2;
        d.ks = ((kb < 8) ? a.in[I_GATT] : (a.in[I_GLRU] - 512)) + kb * 64; return d; } r -= I_OUT;
    if (r < I_GU) { const int e = r / 1024, q = r % 1024, kb = q / 64, nb = q % 64, n0 = nb * 32;
        const int drow = ((n0 & 1023) >> 7) * 256 + (n0 >> 10) * 128 + (n0 & 127);
        d.N = 2048; d.src = a.in[I_WGU] + (size_t)e * 1024 * 2048 + (size_t)kb * 64 * 2048 + n0; d.dst = ws + WS_WGU + ((size_t)e * 2048 + drow) * 1024 + kb * 64; d.f8 = 1; return d; } r -= I_GU;
    { const int e = r / 512, q = r % 512, kb = q / 32, nb = q % 32;
      d.N = 1024; d.src = a.in[I_WDN] + (size_t)e * 1024 * 1024 + (size_t)kb * 64 * 1024 + nb * 32; d.dst = ws + WS_WDN + ((size_t)e * 1024 + nb * 32) * 1024 + kb * 64; d.f8 = 1; return d; }
}
__device__ __forceinline__ void p0_load(const CvtItem& d, int lane, float (&v)[32]) {
    const float* p = d.src + (size_t)(lane >> 5) * d.N + (lane & 31);
#pragma unroll
    for (int i = 0; i < 32; ++i) v[i] = __builtin_nontemporal_load(p + (size_t)(2 * i) * d.N);
}

__device__ __forceinline__ void p0_phase(Frame& F, const Args& a) {
    unsigned char* ws = F.ws;
    if (F.bx < 192) {
        LAS float* cs = (LAS float*)F.lds;
        LAS float* red = (LAS float*)(F.lds + 32768);
        const float* c = a.in[I_C];
        for (int i = F.tid; i < 8 * 1024; i += NTHR) cs[i] = c[i];
        __syncthreads();
        const int col = F.tid & 31, kg = F.tid >> 5, j0 = F.bx * 32;
        const float* w = a.in[I_WADA] + j0 + col;
        float acc[8];
#pragma unroll
        for (int b = 0; b < 8; ++b) acc[b] = 0.f;
#pragma unroll 16
        for (int i = 0; i < 64; ++i) { const int k = kg + 16 * i; const float wv = w[(size_t)k * 6144];
#pragma unroll
            for (int b = 0; b < 8; ++b) acc[b] += cs[b * 1024 + k] * wv; }
#pragma unroll
        for (int b = 0; b < 8; ++b) red[(kg * 8 + b) * 32 + col] = acc[b];
        __syncthreads();
        if (F.tid < 256) { const int b = F.tid >> 5; float s = a.in[I_BADA][j0 + col];
#pragma unroll
            for (int g = 0; g < 16; ++g) s += red[(g * 8 + b) * 32 + col];
            ((float*)(ws + WS_MOD))[b * 6144 + j0 + col] = s; }
        __syncthreads();
    }
    { u32x4* L = (u32x4*)(ws + WS_LIST); const int n4 = NE * LISTCAP / 4; const unsigned dv = (unsigned)DUMP;
      for (int i = F.bx * NTHR + F.tid; i < n4; i += F.G * NTHR) L[i] = (u32x4){dv, dv, dv, dv};
    }
    LAS float* scr = (LAS float*)(F.lds + F.wave * 16384);
    const int gw = F.bx * NWAVES + F.wave, NGW = F.G * NWAVES, lane = F.lane;
    constexpr int NITEMS = 16 * 56 + 16 * 32 + 32 * 16 * 64 + 32 * 16 * 32;
    const int NBASE = (F.G == 256) ? 24 : (NITEMS + NGW - 1) / NGW;
    const int nstrided = NBASE * NGW < NITEMS ? NBASE * NGW : NITEMS;
    const int xw = gw - 192 * NWAVES, NXW = NGW - 192 * NWAVES;
    int seq = 0;
    auto item_at = [&](int q) -> int { if (q < NBASE) { const int it = gw + NGW * q; return it < nstrided ? it : -1; }
        if (xw < 0) return -1; const int it = nstrided + xw + NXW * (q - NBASE); return it < NITEMS ? it : -1; };
    float v[32];
    int it = item_at(0);
    CvtItem d = p0_decode(a, ws, it < 0 ? 0 : it);
    if (it >= 0) p0_load(d, lane, v);
    while (it >= 0) {
        float ksc0 = 1.f, ksc1 = 1.f;
#pragma unroll
        for (int i = 0; i < 32; ++i) { const int kk = 2 * i + (lane >> 5); float x = v[i]; if (d.ks) x *= d.ks[kk]; scr[kk * 33 + (lane & 31)] = x; }
        (void)ksc0; (void)ksc1;
        ++seq; const int itn = item_at(seq);
        const CvtItem dn = p0_decode(a, ws, itn < 0 ? 0 : itn);
        if (itn >= 0) p0_load(dn, lane, v);
        LDS_WAIT(); asm volatile("" ::: "memory");
        if (d.f8) {
            const int c = lane & 3;
#pragma unroll
            for (int j = 0; j < 2; ++j) { const int n = (lane >> 2) + 16 * j; const LAS float* s = scr + (16 * c) * 33 + n; unsigned w[4];
#pragma unroll
                for (int q = 0; q < 4; ++q) { unsigned x = 0u;
                    x = __builtin_amdgcn_cvt_pk_fp8_f32(s[(4 * q + 0) * 33] * WSCALE, s[(4 * q + 1) * 33] * WSCALE, x, false);
                    x = __builtin_amdgcn_cvt_pk_fp8_f32(s[(4 * q + 2) * 33] * WSCALE, s[(4 * q + 3) * 33] * WSCALE, x, true); w[q] = x; }
                *(GAS u32x4*)(d.dst + (size_t)n * 1024 + 16 * c) = (u32x4){w[0], w[1], w[2], w[3]}; }
        } else {
            const int c = lane & 7;
#pragma unroll
            for (int j = 0; j < 4; ++j) { const int n = (lane >> 3) + 8 * j; const LAS float* s = scr + (8 * c) * 33 + n;
                u32x4 o; o.x = pk2(s[0 * 33], s[1 * 33]); o.y = pk2(s[2 * 33], s[3 * 33]); o.z = pk2(s[4 * 33], s[5 * 33]); o.w = pk2(s[6 * 33], s[7 * 33]);
                *(GAS u32x4*)(d.dst + ((size_t)n * 1024 + 8 * c) * 2) = o; }
        }
        LDS_WAIT(); asm volatile("" ::: "memory");
        d = dn; it = itn;
    }
}

__device__ __forceinline__ void p1_phase(Frame& F, const Args& a) {
    const int gw = F.bx * NWAVES + F.wave, NGW = F.G * NWAVES;
    const float* mod = (const float*)(F.ws + WS_MOD);
    { float* WRP = (float*)(F.ws + WS_WRP);
      for (int idx = F.bx * NTHR + F.tid; idx < NB * 1024 * 32; idx += F.G * NTHR) { const int b = idx >> 15, k = (idx >> 5) & 1023;
          WRP[idx] = a.in[I_GFFN][k] * (1.0f + mod[b * 6144 + 4096 + k]) * a.in[I_WR][idx & 32767]; }
      for (int o = gw; o < NB * NE; o += NGW) { const int b = o >> 5, e = o & 31; float s = 0.f;
#pragma unroll
          for (int j = 0; j < 16; ++j) { const int k = F.lane + 64 * j; s += mod[b * 6144 + 3072 + k] * a.in[I_WR][k * 32 + e]; }
          s = wave_sum(s);
          if (F.lane == 0) ((float*)(F.ws + WS_CSTB))[o] = s + a.in[I_BR][e]; } }
    const GAS f32x4* g4 = (const GAS f32x4*)a.in[I_GMIX] + F.lane;
    for (int m = gw; m < T; m += NGW) {
        const int b = m / SEQ;
        const GAS f32x4* xr = (const GAS f32x4*)(a.in[I_X] + (size_t)m * D) + F.lane;
        f32x4 v[4]; float s = 0.f;
#pragma unroll
        for (int j = 0; j < 4; ++j) { v[j] = xr[64 * j]; s += (v[j].x * v[j].x + v[j].y * v[j].y) + (v[j].z * v[j].z + v[j].w * v[j].w); }
        const float rs = rsqrtf(wave_sum(s) * (1.f / D) + EPS);
        const GAS f32x4* sh = (const GAS f32x4*)(mod + b * 6144) + F.lane;
        const GAS f32x4* sc = (const GAS f32x4*)(mod + b * 6144 + 1024) + F.lane;
        GAS u32x2* o8 = (GAS u32x2*)((bf16_t*)(F.ws + WS_H) + (size_t)m * D) + F.lane;
#pragma unroll
        for (int j = 0; j < 4; ++j) { const f32x4 g = g4[64 * j], h = sh[64 * j], c = sc[64 * j];
            const f32x4 y = v[j] * rs * g * (c + 1.0f) + h;
            u32x2 w; w.x = pk2(y.x, y.y); w.y = pk2(y.z, y.w); o8[64 * j] = w; }
    }
}

struct EpiBf16 {
    static constexpr bool PERM = true, MIDK = false;
    bf16_t* O; int ldc;
    __device__ __forceinline__ void operator()(const f32x4 (&acc)[2][2][4][2], const pg8::Unit& u, int wr, int wc, int fr, int fq) const {
        const int row0 = u.pm * 256 + wr * 64 + fr, col0 = u.pn * 256 + wc * 32 + 8 * fq;
#pragma unroll
        for (int ai = 0; ai < 2; ++ai)
#pragma unroll
            for (int m = 0; m < 4; ++m) { bf16_t* rowp = O + (size_t)(row0 + ai * 128 + m * 16) * ldc + col0;
#pragma unroll
                for (int bj = 0; bj < 2; ++bj) { const f32x4 v0 = acc[ai][bj][m][0], v1 = acc[ai][bj][m][1];
                    u32x4 w; w.x = cvt_pk_bf16(v0[0], v0[1]); w.y = cvt_pk_bf16(v0[2], v0[3]); w.z = cvt_pk_bf16(v1[0], v1[1]); w.w = cvt_pk_bf16(v1[2], v1[3]);
                    *(u32x4*)(rowp + bj * 128) = w; } }
    }
    __device__ __forceinline__ void mid(f32x4 (&acc)[2][2][4][2], const pg8::Unit& u, int wr, int wc, int fr, int fq) const {}
};
__device__ __forceinline__ int crow(int r, int hi) { return (r & 3) + 8 * (r >> 2) + 4 * hi; }
__device__ __forceinline__ s16x4 vtr(const LAS unsigned char* p) {
    typedef short v4i16_t __attribute__((ext_vector_type(4)));
    return __builtin_bit_cast(s16x4, __builtin_amdgcn_ds_read_tr16_b64_v4i16((LAS v4i16_t*)p));
}

__device__ __forceinline__ void attn_item(Frame& F, const Args& a, int item) {
    const int b = item >> 5, n = (item >> 1) & 15, j = item & 1;
    const bf16_t* P = (const bf16_t*)(F.ws + WS_P);
    LAS unsigned char* Kl = F.lds;
    LAS unsigned char* Vl = F.lds + 32768;
    LAS unsigned char* ost = F.lds + 65536 + F.wave * 4608;
    LAS float* wsf = (LAS float*)(ost + 4096);
    const int lane = F.lane, ql = lane & 31, hi = lane >> 5;
    {
        const int row = F.tid >> 1, half = F.tid & 1;
        int tb = 128 * (n - 1) + row; if (tb < 0) tb += 128;
        const bf16_t* src = P + (size_t)(b * SEQ + tb) * NCOL + 64 * j;
#pragma unroll
        for (int i = 0; i < 4; ++i) { const int c = half * 4 + i;
            const u32x4 kv = *(const GAS u32x4*)(src + KOFF + 8 * c);
            const u32x4 vv = *(const GAS u32x4*)(src + VOFF + 8 * c);
            *(LAS u32x4*)(Kl + row * 128 + ((c ^ (row & 7)) * 16)) = kv;
            *(LAS u32x4*)(Vl + row * 128 + c * 16) = vv; }
    }
    __syncthreads();
    const int g = F.wave >> 1, qh = F.wave & 1, h = 4 * j + g;
    const float sink = a.in[I_SINKS][h];
    constexpr float L2E = 1.4426950408889634f, C1 = 0.125f * 1.4426950408889634f;
    for (int qb = 0; qb < 2; ++qb) {
        const int o = 64 * qh + 32 * qb;
        const int tq0 = b * SEQ + 128 * n + o;
        bf16x8 qr[4];
#pragma unroll
        for (int d0 = 0; d0 < 4; ++d0) qr[d0] = *(const GAS bf16x8*)(P + (size_t)(tq0 + ql) * NCOL + QOFF + 64 * h + 16 * d0 + 8 * hi);
        f32x16 S[5];
#pragma unroll
        for (int kt = 0; kt < 5; ++kt) {
            const int key = o + 32 * kt + ql;
            f32x16 acc = {};
#pragma unroll
            for (int d0 = 0; d0 < 4; ++d0) { const int c = 2 * d0 + hi;
                const bf16x8 kf = *(const LAS bf16x8*)(Kl + key * 128 + ((c ^ (key & 7)) * 16));
                acc = __builtin_amdgcn_mfma_f32_32x32x16_bf16(kf, qr[d0], acc, 0, 0, 0); }
            S[kt] = acc;
        }
        constexpr float NEG = -1.0e30f;
#pragma unroll
        for (int r = 0; r < 16; ++r) { const int cr = crow(r, hi);
            if (!(cr > ql)) S[0][r] = NEG;
            if (!(cr <= ql)) S[4][r] = NEG; }
        if (n == 0) {
#pragma unroll
            for (int kt = 0; kt < 4; ++kt)
#pragma unroll
                for (int r = 0; r < 16; ++r) if (o + 32 * kt + crow(r, hi) < 128) S[kt][r] = NEG;
        }
        float mx = NEG;
#pragma unroll
        for (int kt = 0; kt < 5; ++kt)
#pragma unroll
            for (int r = 0; r < 16; ++r) mx = fmaxf(mx, S[kt][r]);
        mx = fmaxf(mx, __shfl_xor(mx, 32));
        const float m = fmaxf(mx * 0.125f, sink);
        const float mb = m * L2E;
        float l = 0.f;
#pragma unroll
        for (int kt = 0; kt < 5; ++kt)
#pragma unroll
            for (int r = 0; r < 16; ++r) { const float p = __builtin_amdgcn_exp2f(S[kt][r] * C1 - mb); S[kt][r] = p; l += p; }
        l += __shfl_xor(l, 32);
        l += __builtin_amdgcn_exp2f((sink - m) * L2E);
        if (hi == 0) wsf[ql] = 1.0f / l;
        f32x16 O0 = {}, O1 = {};
        const int gi = (lane >> 4) & 1, li = lane & 15;
        const LAS unsigned char* vb = Vl + (o + 4 * hi + (li >> 2)) * 128 + (16 * gi + 4 * (li & 3)) * 2;
#pragma unroll
        for (int kt = 0; kt < 5; ++kt)
#pragma unroll
            for (int s = 0; s < 2; ++s) {
                bf16x8 pa;
                { const f32x16& X = S[kt];
                  const unsigned w0 = cvt_pk_bf16(X[8 * s + 0], X[8 * s + 1]), w1 = cvt_pk_bf16(X[8 * s + 2], X[8 * s + 3]);
                  const unsigned w2 = cvt_pk_bf16(X[8 * s + 4], X[8 * s + 5]), w3 = cvt_pk_bf16(X[8 * s + 6], X[8 * s + 7]);
                  pa = __builtin_bit_cast(bf16x8, (u32x4){w0, w1, w2, w3}); }
                const LAS unsigned char* vp = vb + (32 * kt + 16 * s) * 128;
                const s16x4 lo0 = vtr(vp), hi0 = vtr(vp + 8 * 128);
                const s16x4 lo1 = vtr(vp + 64), hi1 = vtr(vp + 8 * 128 + 64);
                const bf16x8 v0 = (bf16x8){lo0[0], lo0[1], lo0[2], lo0[3], hi0[0], hi0[1], hi0[2], hi0[3]};
                const bf16x8 v1 = (bf16x8){lo1[0], lo1[1], lo1[2], lo1[3], hi1[0], hi1[1], hi1[2], hi1[3]};
                O0 = __builtin_amdgcn_mfma_f32_32x32x16_bf16(pa, v0, O0, 0, 0, 0);
                O1 = __builtin_amdgcn_mfma_f32_32x32x16_bf16(pa, v1, O1, 0, 0, 0);
            }
        LDS_WAIT(); asm volatile("" ::: "memory");
#pragma unroll
        for (int r = 0; r < 16; ++r) { const int q = crow(r, hi); const float il = wsf[q];
            *(LAS unsigned short*)(ost + q * 128 + ql * 2) = (unsigned short)f2bf(O0[r] * il);
            *(LAS unsigned short*)(ost + q * 128 + (32 + ql) * 2) = (unsigned short)f2bf(O1[r] * il); }
        LDS_WAIT(); asm volatile("" ::: "memory");
        bf16_t* MIXp = (bf16_t*)(F.ws + WS_MIX);
        float* SSQA = (float*)(F.ws + WS_SSQA);
#pragma unroll
        for (int i = 0; i < 4; ++i) { const int id = lane + 64 * i, row = id >> 3, ch = id & 7;
            const u32x4 w = *(const LAS u32x4*)(ost + row * 128 + ch * 16);
            *(GAS u32x4*)(MIXp + (size_t)(tq0 + row) * D + 64 * h + 8 * ch) = w;
            float ss = bflo(w.x) * bflo(w.x) + bfhi(w.x) * bfhi(w.x) + bflo(w.y) * bflo(w.y) + bfhi(w.y) * bfhi(w.y)
                     + bflo(w.z) * bflo(w.z) + bfhi(w.z) * bfhi(w.z) + bflo(w.w) * bflo(w.w) + bfhi(w.w) * bfhi(w.w);
            ss += __shfl_xor(ss, 1); ss += __shfl_xor(ss, 2); ss += __shfl_xor(ss, 4);
            if (ch == 0) SSQA[(size_t)(tq0 + row) * 8 + h] = ss; }
        LDS_WAIT(); asm volatile("" ::: "memory");
    }
    __syncthreads();
}

__device__ __forceinline__ void lru_item(Frame& F, const Args& a, int item) {
    const int b = item >> 5, hb = (item >> 2) & 7, qt = item & 3;
    const int c0 = hb * 64 + qt * 16;
    const bf16_t* P = (const bf16_t*)(F.ws + WS_P);
    constexpr int PITCH = 260;
    LAS unsigned char* XC = F.lds;
    LAS float* XCF = (LAS float*)(F.lds + 32768);
    LAS float* AA = XCF + 16 * PITCH;
    LAS float* UU = AA + 16 * PITCH;
    LAS float* XG = UU + 16 * PITCH;
    LAS float* OUT = XG + 16 * PITCH;
    const int tid = F.tid, lane = F.lane, w = F.wave;
    const int cg = tid & 7, tg = tid >> 3;
    LAS float* CWT = OUT + 16 * PITCH;
    if (tid < 320) CWT[tid] = (tid < 256) ? a.in[I_CONVW][(tid >> 6) * 512 + hb * 64 + (tid & 63)] : a.in[I_CONVB][hb * 64 + (tid & 63)];
    bf16x8 wb[2][2];
    { const int nn = lane & 15, kq = lane >> 4;
#pragma unroll
      for (int nt = 0; nt < 2; ++nt) { const float* Wg = (nt == 0 ? a.in[I_WRGA] : a.in[I_WRGX]) + (size_t)hb * 64 * 64 + qt * 16 + nn;
#pragma unroll
        for (int ks = 0; ks < 2; ++ks) { unsigned pw[4];
#pragma unroll
            for (int jj = 0; jj < 4; ++jj) { const int k = 32 * ks + 8 * kq + 2 * jj; pw[jj] = pk2(Wg[(size_t)k * 64], Wg[(size_t)(k + 1) * 64]); }
            wb[nt][ks] = __builtin_bit_cast(bf16x8, (u32x4){pw[0], pw[1], pw[2], pw[3]}); } } }
    const int chn = c0 + (lane & 15);
    const float ba = a.in[I_BRGA][chn], bx = a.in[I_BRGX][chn];
    const float lg8 = -8.0f * log1pf(expf(-a.in[I_LAM][chn]));
    float hcarry = 0.f;
    bf16_t* MIXp = (bf16_t*)(F.ws + WS_MIX);
    float* SSQL = (float*)(F.ws + WS_SSQL);
    u32x4 cin[7], cxg;
#define LRU_LOAD_TILE(tile_) do { const int t0_ = (tile_) * 256; \
        _Pragma("unroll") for (int rr = 0; rr < 7; ++rr) { const int s_ = t0_ + 4 * tg - 3 + rr; cin[rr] = (u32x4){0u, 0u, 0u, 0u}; \
            if (s_ >= 0) cin[rr] = *(const GAS u32x4*)(P + ((size_t)b * SEQ + s_) * NCOL + XROFF + hb * 64 + 8 * cg); } \
        cxg = *(const GAS u32x4*)(P + ((size_t)b * SEQ + t0_ + (tid >> 1)) * NCOL + XGOFF + c0 + 8 * (tid & 1)); } while (0)
    LRU_LOAD_TILE(0);
    __syncthreads();
    for (int tile = 0; tile < 8; ++tile) {
        const int t0 = tile * 256;
        const size_t tokbase = (size_t)b * SEQ + t0;
        {
            f32x4 xin[7][2];
#pragma unroll
            for (int rr = 0; rr < 7; ++rr) { const u32x4 v = cin[rr];
                xin[rr][0] = (f32x4){bflo(v.x), bfhi(v.x), bflo(v.y), bfhi(v.y)};
                xin[rr][1] = (f32x4){bflo(v.z), bfhi(v.z), bflo(v.w), bfhi(v.w)}; }
            float xo[4][8];
            { const f32x4 b0 = *(const LAS f32x4*)(CWT + 256 + 8 * cg), b1 = *(const LAS f32x4*)(CWT + 256 + 8 * cg + 4);
#pragma unroll
              for (int tt = 0; tt < 4; ++tt)
#pragma unroll
                  for (int e = 0; e < 8; ++e) xo[tt][e] = (e < 4) ? b0[e & 3] : b1[e & 3];
#pragma unroll
              for (int k = 0; k < 4; ++k) { const f32x4 w0 = *(const LAS f32x4*)(CWT + 64 * k + 8 * cg), w1 = *(const LAS f32x4*)(CWT + 64 * k + 8 * cg + 4);
#pragma unroll
                  for (int tt = 0; tt < 4; ++tt)
#pragma unroll
                      for (int e = 0; e < 8; ++e) xo[tt][e] += ((e < 4) ? w0[e & 3] : w1[e & 3]) * xin[tt + k][e >> 2][e & 3]; } }
#pragma unroll
            for (int tt = 0; tt < 4; ++tt) { const int tl = 4 * tg + tt;
                u32x4 pkv; pkv.x = pk2(xo[tt][0], xo[tt][1]); pkv.y = pk2(xo[tt][2], xo[tt][3]); pkv.z = pk2(xo[tt][4], xo[tt][5]); pkv.w = pk2(xo[tt][6], xo[tt][7]);
                *(LAS u32x4*)(XC + tl * 128 + ((cg ^ (tl & 7)) * 16)) = pkv; }
            if ((cg >> 1) == qt) {
#pragma unroll
                for (int e = 0; e < 8; ++e) *(LAS f32x4*)(XCF + ((cg & 1) * 8 + e) * PITCH + 4 * tg) = (f32x4){xo[0][e], xo[1][e], xo[2][e], xo[3][e]};
            }
            { const int tk = tid >> 1, hf = tid & 1;
              const u32x4 v = cxg;
              const float xv[8] = {bflo(v.x), bfhi(v.x), bflo(v.y), bfhi(v.y), bflo(v.z), bfhi(v.z), bflo(v.w), bfhi(v.w)};
#pragma unroll
              for (int e = 0; e < 8; ++e) XG[(hf * 8 + e) * PITCH + tk] = xv[e]; }
            if (tile + 1 < 8) LRU_LOAD_TILE(tile + 1);
        }
        __syncthreads();
        {
            const int kq = lane >> 4, rl = lane & 15;
#pragma unroll
            for (int mt = 0; mt < 2; ++mt) {
                const int row = 32 * w + 16 * mt + rl;
                f32x4 accR = {0.f, 0.f, 0.f, 0.f}, accI = {0.f, 0.f, 0.f, 0.f};
#pragma unroll
                for (int ks = 0; ks < 2; ++ks) { const int c = 4 * ks + kq;
                    const bf16x8 af = *(const LAS bf16x8*)(XC + row * 128 + ((c ^ (row & 7)) * 16));
                    accR = __builtin_amdgcn_mfma_f32_16x16x32_bf16(af, wb[0][ks], accR, 0, 0, 0);
                    accI = __builtin_amdgcn_mfma_f32_16x16x32_bf16(af, wb[1][ks], accI, 0, 0, 0); }
                const int tl0 = 32 * w + 16 * mt + 4 * kq;
                const f32x4 xcf = *(const LAS f32x4*)(XCF + rl * PITCH + tl0);
                f32x4 av, uv;
#pragma unroll
                for (int r = 0; r < 4; ++r) {
                    const float rg = __builtin_amdgcn_rcpf(1.0f + __expf(-(accR[r] + ba)));
                    const float ig = __builtin_amdgcn_rcpf(1.0f + __expf(-(accI[r] + bx)));
                    const float log_a = rg * lg8;
                    av[r] = __expf(log_a);
                    const float x2 = 2.0f * log_a;
                    const float ser = -x2 * (1.0f + x2 * (0.5f + x2 * (0.16666667f + x2 * (0.041666668f + x2 * (0.008333334f + x2 * 0.0013888889f)))));
                    const float om = (x2 > -0.25f) ? ser : (1.0f - __expf(x2));
                    uv[r] = __builtin_amdgcn_sqrtf(fmaxf(om, 0.0f)) * (ig * xcf[r]);
                }
                *(LAS f32x4*)(AA + rl * PITCH + tl0) = av;
                *(LAS f32x4*)(UU + rl * PITCH + tl0) = uv;
            }
        }
        __syncthreads();
        {
            const int ch = 2 * w + (lane >> 5), chunk = lane & 31;
            const f32x4 a0 = *(const LAS f32x4*)(AA + ch * PITCH + 8 * chunk), a1 = *(const LAS f32x4*)(AA + ch * PITCH + 8 * chunk + 4);
            const f32x4 u0 = *(const LAS f32x4*)(UU + ch * PITCH + 8 * chunk), u1 = *(const LAS f32x4*)(UU + ch * PITCH + 8 * chunk + 4);
            const float av[8] = {a0[0], a0[1], a0[2], a0[3], a1[0], a1[1], a1[2], a1[3]};
            const float uv[8] = {u0[0], u0[1], u0[2], u0[3], u1[0], u1[1], u1[2], u1[3]};
            float Ac = 1.f, Hc = 0.f;
#pragma unroll
            for (int s = 0; s < 8; ++s) { Hc = av[s] * Hc + uv[s]; Ac *= av[s]; }
#pragma unroll
            for (int off = 1; off < 32; off <<= 1) {
                const float Ap = __shfl_up(Ac, off, 32), Hp = __shfl_up(Hc, off, 32);
                if (chunk >= off) { Hc = Ac * Hp + Hc; Ac = Ac * Ap; }
            }
            float Ae = __shfl_up(Ac, 1, 32), He = __shfl_up(Hc, 1, 32);
            if (chunk == 0) { Ae = 1.f; He = 0.f; }
            float hh = He + Ae * hcarry;
            const float Hl = __shfl(Hc, 31, 32), Al = __shfl(Ac, 31, 32);
            hcarry = Hl + Al * hcarry;
            const f32x4 g0 = *(const LAS f32x4*)(XG + ch * PITCH + 8 * chunk), g1 = *(const LAS f32x4*)(XG + ch * PITCH + 8 * chunk + 4);
            const float gv[8] = {g0[0], g0[1], g0[2], g0[3], g1[0], g1[1], g1[2], g1[3]};
            float yo[8];
#pragma unroll
            for (int s = 0; s < 8; ++s) { hh = av[s] * hh + uv[s];
                const float x = gv[s];
                const float z2 = 1.5957691216057308f * (x + 0.044715f * x * x * x);
                yo[s] = hh * (x * __builtin_amdgcn_rcpf(1.0f + __expf(-z2))); }
            *(LAS f32x4*)(OUT + ch * PITCH + 8 * chunk) = (f32x4){yo[0], yo[1], yo[2], yo[3]};
            *(LAS f32x4*)(OUT + ch * PITCH + 8 * chunk + 4) = (f32x4){yo[4], yo[5], yo[6], yo[7]};
        }
        __syncthreads();
        {
            const int tk = tid >> 1, hf = tid & 1;
            float yv[8];
#pragma unroll
            for (int e = 0; e < 8; ++e) yv[e] = OUT[(hf * 8 + e) * PITCH + tk];
            u32x4 o; o.x = pk2(yv[0], yv[1]); o.y = pk2(yv[2], yv[3]); o.z = pk2(yv[4], yv[5]); o.w = pk2(yv[6], yv[7]);
            *(GAS u32x4*)(MIXp + (tokbase + tk) * D + 512 + c0 + 8 * hf) = o;
            float ss = bflo(o.x) * bflo(o.x) + bfhi(o.x) * bfhi(o.x) + bflo(o.y) * bflo(o.y) + bfhi(o.y) * bfhi(o.y)
                     + bflo(o.z) * bflo(o.z) + bfhi(o.z) * bfhi(o.z) + bflo(o.w) * bflo(o.w) + bfhi(o.w) * bfhi(o.w);
            ss += __shfl_xor(ss, 1);
            if (hf == 0) SSQL[(tokbase + tk) * 32 + hb * 4 + qt] = ss;
        }
    }
    __syncthreads();
}

struct EpiX1 {
    static constexpr bool PERM = false, MIDK = true;
    const float* x; const float* mod; float* X1; float* SSQ1; const LAS f32x2* RS;
    __device__ __forceinline__ void mid(f32x4 (&acc)[2][2][4][2], const pg8::Unit& u, int wr, int wc, int fr, int fq) const {
#pragma unroll
        for (int ai = 0; ai < 2; ++ai)
#pragma unroll
            for (int m = 0; m < 4; ++m) { const float f = RS[ai * 128 + wr * 64 + m * 16 + fr].x;
#pragma unroll
                for (int bj = 0; bj < 2; ++bj)
#pragma unroll
                    for (int n = 0; n < 2; ++n) acc[ai][bj][m][n] = acc[ai][bj][m][n] * f; }
    }
    __device__ __forceinline__ void operator()(const f32x4 (&acc)[2][2][4][2], const pg8::Unit& u, int wr, int wc, int fr, int fq) const {
        const int col0 = u.pn * 256 + wc * 32 + 4 * fq;
        const int b = (u.pm * 256) / SEQ;
        f32x4 gt[2][2];
#pragma unroll
        for (int bj = 0; bj < 2; ++bj)
#pragma unroll
            for (int n = 0; n < 2; ++n) gt[bj][n] = *(const f32x4*)(mod + b * 6144 + 2048 + col0 + bj * 128 + n * 16);
#pragma unroll
        for (int ai = 0; ai < 2; ++ai)
#pragma unroll
            for (int m = 0; m < 4; ++m) { const int r = ai * 128 + wr * 64 + m * 16 + fr; const float f = RS[r].y;
                const size_t off = (size_t)(u.pm * 256 + r) * D + col0; float ss = 0.f;
#pragma unroll
                for (int bj = 0; bj < 2; ++bj)
#pragma unroll
                    for (int n = 0; n < 2; ++n) { const f32x4 xv = *(const f32x4*)(x + off + bj * 128 + n * 16);
                        const f32x4 o = xv + gt[bj][n] * (acc[ai][bj][m][n] * f);
                        *(f32x4*)(X1 + off + bj * 128 + n * 16) = o;
                        ss += (o[0] * o[0] + o[1] * o[1]) + (o[2] * o[2] + o[3] * o[3]); }
                ss += __shfl_xor(ss, 16); ss += __shfl_xor(ss, 32);
                if (fq == 0) SSQ1[(size_t)(u.pm * 256 + r) * 16 + u.pn * 4 + wc] = ss; }
    }
};
__device__ __forceinline__ void p5_phase(Frame& F, const Args& a) {
    unsigned char* ws = F.ws;
    const float* X1 = (const float*)(ws + WS_X1);
    const float* mod = (const float*)(ws + WS_MOD);
    LAS float* WR = (LAS float*)F.lds;
    LAS float* TAB = (LAS float*)(F.lds + TAB_OFF);
    LAS float* CST = TAB;
    LAS float* RSQ = TAB + 32;
    LAS int* LCNT = (LAS int*)(TAB + 96);
    LAS int* LBASE = (LAS int*)(TAB + 128);
    LAS float* LG = TAB + 160;
    LAS float* CRED = TAB + 160 + 64 * 33;
    const int tid = F.tid, lane = F.lane, w = F.wave;
    for (int tile = F.bx; tile < T / 64; tile += F.G) {
        const int tok0 = tile * 64, b = tok0 / SEQ;
        const float* sh2 = mod + b * 6144 + 3072; const float* sc2 = mod + b * 6144 + 4096;
        { const GAS f32x4* src = (const GAS f32x4*)((const float*)(ws + WS_WRP) + (size_t)b * 32768);
#pragma unroll
          for (int i = 0; i < 16; ++i) ((LAS f32x4*)WR)[tid + NTHR * i] = src[tid + NTHR * i];
          if (tid < 64) { const float* sp = (const float*)(ws + WS_SSQ1) + (size_t)(tok0 + tid) * 16; float s = 0.f;
#pragma unroll
              for (int i = 0; i < 16; ++i) s += sp[i];
              RSQ[tid] = rsqrtf(s * (1.0f / D) + EPS); }
          if (tid < 32) { LCNT[tid] = 0; CST[tid] = ((const float*)(ws + WS_CSTB))[b * 32 + tid]; } }
        __syncthreads();
        f32x16 acc = {};
        { const int tw = w >> 2, kq4 = w & 3, i = lane & 31, hi = lane >> 5;
          const float* xrow = X1 + (size_t)(tok0 + 32 * tw + i) * D + 256 * kq4 + 128 * hi;
          const LAS float* wrow = WR + (256 * kq4 + 128 * hi) * 32 + i;
#pragma unroll 1
          for (int c4 = 0; c4 < 4; ++c4) {
              f32x4 xv[8];
#pragma unroll
              for (int q = 0; q < 8; ++q) xv[q] = *(const GAS f32x4*)(xrow + 32 * c4 + 4 * q);
#pragma unroll
              for (int q = 0; q < 8; ++q)
#pragma unroll
                  for (int r = 0; r < 4; ++r) { const int s = 32 * c4 + 4 * q + r;
                      acc = __builtin_amdgcn_mfma_f32_32x32x2f32(xv[q][r], wrow[s * 32], acc, 0, 0, 0); }
          } }
        __syncthreads();
        {
          LAS float* PART = WR + w * (32 * 33); const int e = lane & 31, hi = lane >> 5;
#pragma unroll
          for (int r = 0; r < 16; ++r) PART[crow(r, hi) * 33 + e] = acc[r]; }
        __syncthreads();
        {
          const int tk = tid >> 3, e0 = (tid & 7) * 4, tw = tk >> 5, tl = tk & 31; const float rs = RSQ[tk];
#pragma unroll
          for (int j = 0; j < 4; ++j) { float s = 0.f;
#pragma unroll
              for (int q = 0; q < 4; ++q) s += WR[(tw * 4 + q) * (32 * 33) + tl * 33 + e0 + j];
              LG[tk * 33 + e0 + j] = rs * s + CST[e0 + j]; } }
        __syncthreads();
        int eidx[4] = {0, 0, 0, 0}; int lpos[4] = {0, 0, 0, 0};
        if (tid < 64) {
            float val[4]; unsigned used = 0u;
#pragma unroll
            for (int k = 0; k < 4; ++k) { float best = -3.0e38f; int bi = 0;
                for (int j = 0; j < 32; ++j) { const float v = LG[tid * 33 + j]; if (!((used >> j) & 1u) && v > best) { best = v; bi = j; } }
                used |= 1u << bi; eidx[k] = bi; val[k] = best; }
            float ex[4], den = 0.f;
#pragma unroll
            for (int k = 0; k < 4; ++k) { ex[k] = __expf(val[k] - val[0]); den += ex[k]; }
            const float inv = 1.0f / den;
            *(f32x4*)((float*)(ws + WS_TOPG) + (size_t)(tok0 + tid) * 4) = (f32x4){ex[0] * inv, ex[1] * inv, ex[2] * inv, ex[3] * inv};
#pragma unroll
            for (int k = 0; k < 4; ++k) lpos[k] = __hip_atomic_fetch_add(LCNT + eidx[k], 1, __ATOMIC_RELAXED, __HIP_MEMORY_SCOPE_WORKGROUP);
        }
        __syncthreads();
        if (tid < 32) { const int c = LCNT[tid]; LBASE[tid] = c > 0 ? (int)__hip_atomic_fetch_add((unsigned*)(ws + WS_CTL) + CW_CNT + tid, (unsigned)c, RLX_AGENT) : 0; }
        __syncthreads();
        if (tid < 64) {
#pragma unroll
            for (int k = 0; k < 4; ++k) ((int*)(ws + WS_LIST))[eidx[k] * LISTCAP + LBASE[eidx[k]] + lpos[k]] = (tok0 + tid) * 4 + k;
        }
        for (int tk = w; tk < 64; tk += NWAVES) {
            const int m = tok0 + tk; const float rs = RSQ[tk];
            const GAS f32x4* xr = (const GAS f32x4*)(X1 + (size_t)m * D) + lane;
            const GAS f32x4* g4 = (const GAS f32x4*)a.in[I_GFFN] + lane;
            const GAS f32x4* sh = (const GAS f32x4*)sh2 + lane; const GAS f32x4* sc = (const GAS f32x4*)sc2 + lane;
            GAS unsigned* o4 = (GAS unsigned*)(ws + WS_H + (size_t)m * D) + lane;
#pragma unroll
            for (int j = 0; j < 4; ++j) { const f32x4 y = xr[64 * j] * rs * g4[64 * j] * (sc[64 * j] + 1.0f) + sh[64 * j];
                unsigned o = 0u; o = __builtin_amdgcn_cvt_pk_fp8_f32(y.x, y.y, o, false); o = __builtin_amdgcn_cvt_pk_fp8_f32(y.z, y.w, o, true); o4[64 * j] = o; }
        }
        if (tile == 0 && tid < 64) ((GAS u32x4*)(ws + WS_H + (size_t)T * D))[tid] = (u32x4){0u, 0u, 0u, 0u};
        __syncthreads();
    }
}

struct GroupedOrder {
    const LAS int* TP; const LAS unsigned* AOFF;
    int ntiles, npn, nun, G, c, rowbytes; const char* Wt; size_t estride;
    __device__ __forceinline__ bool next(int i, pg8::Unit& u) const {
        const long L = (long)i * G + c; if (L >= nun) return false;
        int wgid = (int)L; { const int q = nun / 8, r = nun % 8, xcd = wgid % 8, off = wgid / 8; wgid = (xcd < r ? xcd * (q + 1) : r * (q + 1) + (xcd - r) * q) + off; }
        const int WGM = 8;
        const int nig = WGM * npn, gid = wgid / nig, fm = gid * WGM, gsz = (ntiles - fm) < WGM ? (ntiles - fm) : WGM;
        u.pm = fm + ((wgid % nig) % gsz); u.pn = (wgid % nig) / gsz; u.li = i;
        int e = 0;
        for (int j = 1; j < NE; ++j) e += (TP[j] <= u.pm) ? 1 : 0;
        u.e = __builtin_amdgcn_readfirstlane(e);
        u.bptr = Wt + (size_t)u.e * estride + (size_t)u.pn * 256 * rowbytes;
        return true;
    }
    __device__ __forceinline__ unsigned a_off(const pg8::Unit& u, int r) const {
        if (AOFF) return AOFF[u.li * 256 + r];
        return (unsigned)((u.pm * 256 + r) * rowbytes);
    }
};

struct EpiSwiglu {
    static constexpr bool PERM = true, MIDK = false;
    unsigned char* ACT; const float* b_gu;
    __device__ __forceinline__ void mid(f32x4 (&acc)[2][2][4][2], const pg8::Unit& u, int wr, int wc, int fr, int fq) const {}
    __device__ __forceinline__ void operator()(const f32x4 (&acc)[2][2][4][2], const pg8::Unit& u, int wr, int wc, int fr, int fq) const {
        const int c0 = u.pn * 128 + wc * 32 + 8 * fq;
        const float* bg = b_gu + u.e * 2048 + c0;
        f32x4 bgate[2], bup[2];
#pragma unroll
        for (int n = 0; n < 2; ++n) { bgate[n] = *(const f32x4*)(bg + 4 * n); bup[n] = *(const f32x4*)(bg + 1024 + 4 * n); }
#pragma unroll
        for (int ai = 0; ai < 2; ++ai)
#pragma unroll
            for (int m = 0; m < 4; ++m) { const int r = ai * 128 + wr * 64 + m * 16 + fr;
                float o[8];
#pragma unroll
                for (int n = 0; n < 2; ++n)
#pragma unroll
                    for (int j = 0; j < 4; ++j) {
                        const float gate = fminf(acc[ai][0][m][n][j] * WUNSCALE + bgate[n][j], 7.0f);
                        const float up = fminf(fmaxf(acc[ai][1][m][n][j] * WUNSCALE + bup[n][j], -7.0f), 7.0f);
                        const float glu = gate * __builtin_amdgcn_rcpf(1.0f + __expf(-1.702f * gate));
                        o[4 * n + j] = (up + 1.0f) * glu; }
                u32x2 w; w.x = 0u; w.y = 0u;
                w.x = __builtin_amdgcn_cvt_pk_fp8_f32(o[0], o[1], w.x, false); w.x = __builtin_amdgcn_cvt_pk_fp8_f32(o[2], o[3], w.x, true);
                w.y = __builtin_amdgcn_cvt_pk_fp8_f32(o[4], o[5], w.y, false); w.y = __builtin_amdgcn_cvt_pk_fp8_f32(o[6], o[7], w.y, true);
                *(u32x2*)(ACT + (size_t)(u.pm * 256 + r) * 1024 + c0) = w; }
    }
};
struct EpiDown {
    static constexpr bool PERM = true, MIDK = false;
    bf16_t* YB; const float* b_dn; const LAS int* SLOT;
    __device__ __forceinline__ void mid(f32x4 (&acc)[2][2][4][2], const pg8::Unit& u, int wr, int wc, int fr, int fq) const {}
    __device__ __forceinline__ void operator()(const f32x4 (&acc)[2][2][4][2], const pg8::Unit& u, int wr, int wc, int fr, int fq) const {
        const int col0 = u.pn * 256 + wc * 32 + 8 * fq;
        const float* bd = b_dn + u.e * 1024 + col0;
        f32x4 bv[2][2];
#pragma unroll
        for (int bj = 0; bj < 2; ++bj)
#pragma unroll
            for (int n = 0; n < 2; ++n) bv[bj][n] = *(const f32x4*)(bd + bj * 128 + 4 * n);
#pragma unroll
        for (int ai = 0; ai < 2; ++ai)
#pragma unroll
            for (int m = 0; m < 4; ++m) { const int r = ai * 128 + wr * 64 + m * 16 + fr;
                const int slot = SLOT[u.li * 256 + r];
                bf16_t* rowp = YB + (size_t)slot * 1024 + col0;
#pragma unroll
                for (int bj = 0; bj < 2; ++bj) { const f32x4 v0 = acc[ai][bj][m][0] * WUNSCALE + bv[bj][0], v1 = acc[ai][bj][m][1] * WUNSCALE + bv[bj][1];
                    u32x4 w; w.x = cvt_pk_bf16(v0[0], v0[1]); w.y = cvt_pk_bf16(v0[2], v0[3]); w.z = cvt_pk_bf16(v1[0], v1[1]); w.w = cvt_pk_bf16(v1[2], v1[3]);
                    *(u32x4*)(rowp + bj * 128) = w; } }
    }
};

template <int MODE>
__device__ __forceinline__ void grouped_setup(Frame& F, GroupedOrder& S, int npn, const void* Wt, size_t estride) {
    LAS int* TP = (LAS int*)(F.lds + TAB_OFF);
    LAS unsigned* TABR = (LAS unsigned*)(F.lds + TAB_OFF + 256);
    const unsigned* cnt = (const unsigned*)(F.ws + WS_CTL) + CW_CNT;
    if (F.tid == 0) { int acc = 0;
        for (int e = 0; e < NE; ++e) { TP[e] = acc; const int c = (int)__hip_atomic_load(cnt + e, RLX_AGENT); acc += (c + 255) >> 8; }
        TP[NE] = acc; }
    __syncthreads();
    S.TP = TP; S.AOFF = (MODE == 1) ? (const LAS unsigned*)TABR : nullptr;
    S.ntiles = __builtin_amdgcn_readfirstlane(TP[NE]); S.npn = npn; S.nun = S.ntiles * npn; S.G = F.G; S.c = F.bx; S.rowbytes = 1024; S.Wt = (const char*)Wt; S.estride = estride;
    const int* LIST = (const int*)(F.ws + WS_LIST);
    pg8::Unit u;
    for (int li = 0; li < 12 && S.next(li, u); ++li) {
        if (F.tid < 256) { const int slot = LIST[u.e * LISTCAP + (u.pm - TP[u.e]) * 256 + F.tid];
            TABR[li * 256 + F.tid] = (MODE == 1) ? (unsigned)(slot >> 2) * 1024u : (unsigned)slot; }
    }
    __syncthreads();
}

__device__ __forceinline__ void p8_phase(Frame& F, const Args& a) {
    const int gw = F.bx * NWAVES + F.wave, NGW = F.G * NWAVES, lane = F.lane;
    const float* X1 = (const float*)(F.ws + WS_X1); const float* mod = (const float*)(F.ws + WS_MOD);
    const bf16_t* YB = (const bf16_t*)(F.ws + WS_YB); const float* TOPG = (const float*)(F.ws + WS_TOPG);
    const GAS f32x4* gf = (const GAS f32x4*)a.in[I_GFIN] + lane;
    for (int m = gw; m < T; m += NGW) {
        const int b = m / SEQ;
        const f32x4 gk = *(const f32x4*)(TOPG + (size_t)m * 4);
        const GAS f32x4* xr = (const GAS f32x4*)(X1 + (size_t)m * D) + lane;
        const GAS f32x4* g2 = (const GAS f32x4*)(mod + b * 6144 + 5120) + lane;
        f32x4 v[4]; float ss = 0.f;
#pragma unroll
        for (int j = 0; j < 4; ++j) { f32x4 s = {0.f, 0.f, 0.f, 0.f};
#pragma unroll
            for (int k = 0; k < 4; ++k) { const u32x2 y = *((const GAS u32x2*)(YB + (size_t)(m * 4 + k) * D) + lane + 64 * j);
                s += (f32x4){bflo(y.x), bfhi(y.x), bflo(y.y), bfhi(y.y)} * gk[k]; }
            v[j] = xr[64 * j] + g2[64 * j] * s;
            ss += (v[j].x * v[j].x + v[j].y * v[j].y) + (v[j].z * v[j].z + v[j].w * v[j].w); }
        const float rs = rsqrtf(wave_sum(ss) * (1.f / D) + EPS);
        GAS f32x4* o = (GAS f32x4*)(a.out + (size_t)m * D) + lane;
#pragma unroll
        for (int j = 0; j < 4; ++j) o[64 * j] = v[j] * rs * gf[64 * j];
    }
}
__global__ void __launch_bounds__(NTHR, 2) mega_fwd(Args args) {
    extern __shared__ __attribute__((aligned(16))) unsigned char lds_raw[];
    Frame F;
    F.lds = (LAS unsigned char*)lds_raw;
    F.tid = threadIdx.x; F.lane = F.tid & 63; F.wave = __builtin_amdgcn_readfirstlane(F.tid >> 6);
    F.G = gridDim.x; F.bx = blockIdx.x; F.ws = args.ws;
    volatile LAS unsigned* MISC = (volatile LAS unsigned*)(F.lds + LDSCTL_OFF);
    for (int u = F.tid; u < 128; u += NTHR) MISC[u] = 0u;
    __syncthreads();
    unsigned* ctl = (unsigned*)(args.ws + WS_CTL);
    XcdBarrier bar = xcd_barrier_post(ctl + CW_BAR, MISC + 8);
    const int lo = args.ph_lo, hi = args.ph_hi;
#define IN(k) (lo <= (k) && (k) < hi)
#define SEAM(k) do { if (IN(k) && IN((k) + 1)) xcd_barrier(bar); } while (0)
    if (IN(0)) { p0_phase(F, args); } SEAM(0);
    if (IN(1)) { p1_phase(F, args); } SEAM(1);
    if (IN(2)) {
        pg8::DenseOrder S; S.init(T, NCOL, D * 2, args.ws + WS_WIN, F.G, F.bx);
        EpiBf16 E{(bf16_t*)(args.ws + WS_P), NCOL};
        pg8::gemm_phase<EpiBf16, pg8::DenseOrder, true, false>(F.lds, (const char*)(args.ws + WS_H), D * 2, S, E);
    } SEAM(2);
    if (IN(3)) {
        for (int it = F.bx; it < 256; it += F.G) attn_item(F, args, it);
        for (int it = F.bx; it < 256; it += F.G) lru_item(F, args, it);
    } SEAM(3);
    if (IN(4)) {
        pg8::DenseOrder S; S.init(T, D, D * 2, args.ws + WS_WOUT, F.G, F.bx);
        LAS f32x2* RS = (LAS f32x2*)(F.lds + TAB_OFF);
        pg8::Unit u0;
        if (S.next(0, u0)) {
            if (F.tid < 256) { const size_t tok = (size_t)u0.pm * 256 + F.tid;
                const float* sa = (const float*)(args.ws + WS_SSQA) + tok * 8; const float* sl = (const float*)(args.ws + WS_SSQL) + tok * 32;
                float ssa = 0.f, ssl = 0.f;
#pragma unroll
                for (int i = 0; i < 8; ++i) ssa += sa[i];
#pragma unroll
                for (int i = 0; i < 32; ++i) ssl += sl[i];
                const float ra = rsqrtf(ssa * (1.0f / 512) + EPS), rl = rsqrtf(ssl * (1.0f / 512) + EPS);
                RS[F.tid] = (f32x2){ra / rl, rl}; }
        }
        __syncthreads();
        EpiX1 E{args.in[I_X], (const float*)(args.ws + WS_MOD), (float*)(args.ws + WS_X1), (float*)(args.ws + WS_SSQ1), RS};
        pg8::gemm_phase<EpiX1, pg8::DenseOrder, false, false>(F.lds, (const char*)(args.ws + WS_MIX), D * 2, S, E);
    } SEAM(4);
    if (IN(5)) { p5_phase(F, args); } SEAM(5);
    if (IN(6)) {
        GroupedOrder S; grouped_setup<1>(F, S, 8, args.ws + WS_WGU, (size_t)2048 * 1024);
        EpiSwiglu E{args.ws + WS_ACT, args.in[I_BGU]};
        pg8::gemm_phase<EpiSwiglu, GroupedOrder, true, true>(F.lds, (const char*)(args.ws + WS_H), D, S, E);
    } SEAM(6);
    if (IN(7)) {
        GroupedOrder S; grouped_setup<2>(F, S, 4, args.ws + WS_WDN, (size_t)1024 * 1024);
        EpiDown E{(bf16_t*)(args.ws + WS_YB), args.in[I_BDN], (const LAS int*)(F.lds + TAB_OFF + 256)};
        pg8::gemm_phase<EpiDown, GroupedOrder, true, true>(F.lds, (const char*)(args.ws + WS_ACT), D, S, E);
    } SEAM(7);
    if (IN(8)) { p8_phase(F, args); }
#undef IN
#undef SEAM
}
}
extern "C" void kernel_launch(void* const* d_in, const int* in_sizes, int n_in, void* d_out, int out_size, void* d_ws, size_t ws_size,
                              hipStream_t stream) {
    static int grid = 0;
    if (grid == 0) {
        if (n_in != 25 || out_size != mk::T * mk::D || ws_size < mk::WS_END) { fprintf(stderr, "kernel_launch: unexpected problem shape (n_in %d out %d ws %zu)\n", n_in, out_size, ws_size); grid = -1; return; }
        int dev = 0, cus = 0, per_cu = 0;
        if (hipGetDevice(&dev) != hipSuccess || hipDeviceGetAttribute(&cus, hipDeviceAttributeMultiprocessorCount, dev) != hipSuccess) { grid = -1; return; }
        if (hipFuncSetAttribute((const void*)mk::mega_fwd, hipFuncAttributeMaxDynamicSharedMemorySize, mk::LDS_BYTES) != hipSuccess) { fprintf(stderr, "kernel_launch: hipFuncSetAttribute failed\n"); grid = -1; return; }
        if (hipOccupancyMaxActiveBlocksPerMultiprocessor(&per_cu, (const void*)mk::mega_fwd, mk::NTHR, mk::LDS_BYTES) != hipSuccess || per_cu < 1) { fprintf(stderr, "kernel_launch: occupancy query says %d workgroups per CU\n", per_cu); grid = -1; return; }
        grid = cus;
    }
    if (grid < 0) return;
    if (hipMemsetAsync((char*)d_ws + mk::WS_CTL, 0, mk::CTL_ZERO_BYTES, stream) != hipSuccess) return;
    mk::Args a{};
    for (int i = 0; i < 25; ++i) a.in[i] = (const float*)d_in[i];
    a.out = (float*)d_out; a.ws = (unsigned char*)d_ws; a.ph_lo = 0; a.ph_hi = 9;
    void* kargs[] = {&a};
    hipError_t le = hipLaunchCooperativeKernel((const void*)mk::mega_fwd, dim3(grid), dim3(mk::NTHR), kargs, mk::LDS_BYTES, stream);
    if (le != hipSuccess) fprintf(stderr, "kernel_launch: cooperative launch failed: %s (grid %d)\n", hipGetErrorString(le), grid);
}
```

```cpp
#include <hip/hip_runtime.h>
#include <stdint.h>
#include <stdio.h>
namespace mk {
#define LAS __attribute__((address_space(3)))
#define GAS __attribute__((address_space(1)))
typedef unsigned short bf16_t;
typedef short bf16x8 __attribute__((ext_vector_type(8)));
typedef short s16x4 __attribute__((ext_vector_type(4)));
typedef float f32x2 __attribute__((ext_vector_type(2)));
typedef float f32x4 __attribute__((ext_vector_type(4)));
typedef float f32x16 __attribute__((ext_vector_type(16)));
typedef unsigned u32x2 __attribute__((ext_vector_type(2)));
typedef unsigned u32x4 __attribute__((ext_vector_type(4)));

constexpr int NWAVES = 8, NTHR = 512;
constexpr int NB = 8, SEQ = 2048, D = 1024, T = NB * SEQ, NCOL = 1792, NE = 32;
constexpr int QOFF = 0, KOFF = 512, VOFF = 640, XROFF = 768, XGOFF = 1280;
constexpr int LISTCAP = 16384, DUMP = 65536, MAXTILES = 288;
constexpr float EPS = 1e-6f;
constexpr float WSCALE = 32.0f, WUNSCALE = 1.0f / 32.0f;

constexpr size_t MiB = 1u << 20;
constexpr size_t WS_CTL = 0, CTL_ZERO_BYTES = 64 * 1024;
constexpr int CW_CNT = 64;
constexpr int CW_RDY = 128;
constexpr int CW_MODCNT = 56;
constexpr int CW_BAR = 4096;
constexpr size_t WS_MOD = 1 * MiB;
constexpr size_t WS_CSTB = 1 * MiB + 256 * 1024;
constexpr size_t WS_TOPG = 2 * MiB;
constexpr size_t WS_WRP = 3 * MiB;
constexpr size_t WS_LIST = 4 * MiB;
constexpr size_t WS_SSQA = 6 * MiB;
constexpr size_t WS_SSQL = 7 * MiB;
constexpr size_t WS_SSQ1 = 9 * MiB;
constexpr size_t WS_WIN = 10 * MiB;
constexpr size_t WS_WOUT = 14 * MiB;
constexpr size_t WS_WGU = 16 * MiB;
constexpr size_t WS_WDN = 144 * MiB;
constexpr size_t WS_H = 208 * MiB;
constexpr size_t WS_P = 242 * MiB;
constexpr size_t WS_MIX = 298 * MiB;
constexpr size_t WS_X1 = 330 * MiB;
constexpr size_t WS_ACT = 394 * MiB;
constexpr size_t WS_YB = 538 * MiB;
constexpr size_t WS_END = 668 * MiB;

constexpr int RING_BYTES = 131072;
constexpr int LDSCTL_OFF = RING_BYTES;
constexpr int TAB_OFF = RING_BYTES + 512;
constexpr int BIAS_OFF = TAB_OFF + 256 + 14 * 1024;
constexpr int LDS_BYTES = 163840;

#define RLX_AGENT __ATOMIC_RELAXED, __HIP_MEMORY_SCOPE_AGENT
#define LDS_WAIT() asm volatile("s_waitcnt lgkmcnt(0)" ::: "memory")
#define VM_WAIT() asm volatile("s_waitcnt vmcnt(0)" ::: "memory")
__device__ __forceinline__ unsigned f2bf(float f) { unsigned u = __builtin_bit_cast(unsigned, f); return (u + 0x7fffu + ((u >> 16) & 1u)) >> 16; }
__device__ __forceinline__ unsigned pk2(float lo, float hi) { return f2bf(lo) | (f2bf(hi) << 16); }
__device__ __forceinline__ float bf2f(unsigned short h) { return __builtin_bit_cast(float, (unsigned)h << 16); }
__device__ __forceinline__ float bflo(unsigned w) { return __builtin_bit_cast(float, w << 16); }
__device__ __forceinline__ float bfhi(unsigned w) { return __builtin_bit_cast(float, w & 0xffff0000u); }
__device__ __forceinline__ unsigned cvt_pk_bf16(float lo, float hi) { unsigned r; asm volatile("v_cvt_pk_bf16_f32 %0, %1, %2" : "=v"(r) : "v"(lo), "v"(hi)); return r; }
__device__ __forceinline__ unsigned xor16(unsigned v, int odd_row) { const auto r = __builtin_amdgcn_permlane16_swap(v, v, false, false); return odd_row ? r[0] : r[1]; }
__device__ __forceinline__ unsigned xor32(unsigned v, int hi_half) { const auto r = __builtin_amdgcn_permlane32_swap(v, v, false, false); return hi_half ? r[0] : r[1]; }
__device__ __forceinline__ float xor16f(float v, int odd_row) { return __builtin_bit_cast(float, xor16(__builtin_bit_cast(unsigned, v), odd_row)); }
__device__ __forceinline__ float xor32f(float v, int hi_half) { return __builtin_bit_cast(float, xor32(__builtin_bit_cast(unsigned, v), hi_half)); }
__device__ __forceinline__ float wave_sum(float v) {
#pragma unroll
    for (int o = 1; o < 16; o <<= 1) v += __shfl_xor(v, o);
    const int l_ = (int)(threadIdx.x & 63);
    v += xor16f(v, (l_ >> 4) & 1); v += xor32f(v, l_ >> 5);
    return v;
}

#define XB_TMO      128
#define XB_XCNT(j)  (256  + 64 * (j))
#define XB_XSUB(j)  (1280 + 64 * (j))
#define XB_XGEN(j)  (2304 + 64 * (j))
#define XB_TOP      3328
#define XB_TOPGEN   3392
#define XCD_BAR_WORDS 3456
#define XB_SPIN_CAP (1u << 20)
__device__ __forceinline__ unsigned xb_ld(unsigned* p)              { return __hip_atomic_load(p, __ATOMIC_RELAXED, __HIP_MEMORY_SCOPE_AGENT); }
__device__ __forceinline__ unsigned xb_add(unsigned* p, unsigned v) { return __hip_atomic_fetch_add(p, v, __ATOMIC_RELAXED, __HIP_MEMORY_SCOPE_AGENT); }
__device__ __forceinline__ unsigned xb_xcc_id() { return (unsigned)__builtin_amdgcn_s_getreg((3 << 11) | 20) & 0xFu; }
#define XB_SPIN(cond, bar) do { unsigned _sp = 0; while (cond) { __builtin_amdgcn_s_sleep(1); \
    if ((++_sp & 255u) == 0u) { if (xb_ld(&(bar)[XB_TMO])) break; if (_sp > XB_SPIN_CAP) { atomicAdd(&(bar)[XB_TMO], 1u); break; } } } } while (0)
struct XcdBarrier { unsigned* bar; unsigned x; volatile LAS unsigned* st; };
__device__ __forceinline__ XcdBarrier xcd_barrier_post(unsigned* bar, volatile LAS unsigned* st) {
    XcdBarrier b; b.bar = bar; b.x = xb_xcc_id(); b.st = st;
    if (threadIdx.x == 0) (void)xb_add(&bar[XB_XCNT(b.x)], 1u);
    return b;
}
__device__ __forceinline__ void xcd_barrier_complete(unsigned* bar, unsigned x, unsigned& nloc, unsigned& nx) {
    const unsigned G = gridDim.x * gridDim.y * gridDim.z;
    unsigned sum, cnt, mine, sp = 0u;
    for (;;) {
        sum = 0u; cnt = 0u; mine = 0u;
#pragma unroll
        for (unsigned j = 0; j < 16; ++j) { const unsigned c = xb_ld(&bar[XB_XCNT(j)]); sum += c; cnt += (c > 0u) ? 1u : 0u; mine = (j == x) ? c : mine; }
        if (sum == G) break;
        __builtin_amdgcn_s_sleep(1);
        if ((++sp & 255u) == 0u) { if (xb_ld(&bar[XB_TMO])) break; if (sp > XB_SPIN_CAP) { atomicAdd(&bar[XB_TMO], 1u); break; } }
    }
    nloc = mine > 0u ? mine : 1u; nx = cnt > 0u ? cnt : 1u;
}
__device__ __forceinline__ void xcd_barrier(const XcdBarrier& b) {
    asm volatile("s_waitcnt vmcnt(0)" ::: "memory");
    __syncthreads();
    if (threadIdx.x == 0) {
        unsigned* bar = b.bar;
        __builtin_amdgcn_s_waitcnt(0);
        unsigned nloc = b.st[0], nx = b.st[1];
        if (nloc == 0u) { xcd_barrier_complete(bar, b.x, nloc, nx); b.st[0] = nloc; b.st[1] = nx; }
        const unsigned old = xb_add(&bar[XB_XSUB(b.x)], 1u);
        const unsigned gen = old / nloc;
        if (old + 1u == (gen + 1u) * nloc) {
            __builtin_amdgcn_fence(__ATOMIC_RELEASE, "agent");
            asm volatile("s_waitcnt vmcnt(0)" ::: "memory");
            const unsigned og = xb_add(&bar[XB_TOP], 1u);
            const unsigned tg = og / nx;
            if (og + 1u == (tg + 1u) * nx) xb_add(&bar[XB_TOPGEN], 1u);
            else XB_SPIN(xb_ld(&bar[XB_TOPGEN]) == tg, bar);
            __builtin_amdgcn_fence(__ATOMIC_ACQUIRE, "agent");
            xb_add(&bar[XB_XGEN(b.x)], 1u);
            asm volatile("s_waitcnt vmcnt(0)" ::: "memory");
        } else {
            XB_SPIN(xb_ld(&bar[XB_XGEN(b.x)]) == gen, bar);
            __builtin_amdgcn_fence(__ATOMIC_ACQUIRE, "agent");
            asm volatile("s_waitcnt vmcnt(0)" ::: "memory");
        }
    }
    __syncthreads();
}

namespace pg8 {
constexpr int BM = 256, BK = 64, HALF = 128, HTB = HALF * BK * 2, STAGE_BYTES = 8 * HTB, NXCD = 8;
__device__ __forceinline__ int lds_byte(int r, int c) { const int st = (r >> 4) * 2 + (c >> 5), rr = r & 15, cc = c & 31, ob = rr * 64 + cc * 2; return st * 1024 + (ob ^ (((ob >> 9) & 1) << 5)); }
__device__ __forceinline__ void stage_rc(int b, int& R, int& C) { const int st = b / 1024, sb = b % 1024, swz = sb ^ (((sb >> 9) & 1) << 5); R = (st >> 1) * 16 + swz / 64; C = (st & 1) * 32 + (swz % 64) / 2; }
__device__ __forceinline__ int perm32(int rho) { const int n = rho >> 4, i = rho & 15; return 8 * (i >> 2) + 4 * n + (i & 3); }

struct Unit { int pm, pn, e, li, kind; const char* bptr; };
typedef int v8i_t __attribute__((ext_vector_type(8)));
typedef int v4i_t __attribute__((ext_vector_type(4)));
__device__ __forceinline__ const char* uniform_ptr(const char* p) { const unsigned long long v = (unsigned long long)p;
    const unsigned lo = __builtin_amdgcn_readfirstlane((unsigned)v), hi = __builtin_amdgcn_readfirstlane((unsigned)(v >> 32)); return (const char*)(((unsigned long long)hi << 32) | lo); }
__device__ __forceinline__ v8i_t cat8(bf16x8 lo, bf16x8 hi) { const v4i_t a = __builtin_bit_cast(v4i_t, lo), b = __builtin_bit_cast(v4i_t, hi); return __builtin_shufflevector(a, b, 0, 1, 2, 3, 4, 5, 6, 7); }

template <class Epi, class Sched, bool ALIGN_EPI, bool F8>
__device__ __forceinline__ void gemm_phase(LAS unsigned char* lds, const char* Abase, const int rowbytes, const Sched& S, const Epi& E) {
    const int tid = threadIdx.x, wid = __builtin_amdgcn_readfirstlane(tid >> 6), lane = tid & 63, wr = wid >> 2, wc = wid & 3, fr = lane & 15, fq = lane >> 4;
    const int nt = rowbytes / 128;
    unsigned voffB[2];
#pragma unroll
    for (int i = 0; i < 2; ++i) { int R, C; stage_rc(tid * 16 + i * 8192, R, C); const int Rb = Epi::PERM ? ((R & ~31) + perm32(R & 31)) : R;
        voffB[i] = (unsigned)(Rb * rowbytes + C * 2); }
#define PG8_AOFF(dst, unit) do { _Pragma("unroll") for (int _i = 0; _i < 2; ++_i) { int R, C; stage_rc(tid * 16 + _i * 8192, R, C); \
        dst[0][_i] = S.a_off(unit, R) + (unsigned)(C * 2); dst[1][_i] = S.a_off(unit, HALF + R) + (unsigned)(C * 2); } } while (0)
    const size_t kstep = (size_t)(BK * 2);
    const size_t hstepB = (size_t)HALF * rowbytes;
    const unsigned ldsw = (unsigned)wid * 1024u;
    const int aoff = lds_byte(wr * 64 + fr, fq * 8), boff = lds_byte(wc * 32 + fr, fq * 8);
#define PG8_SA(b, h) (((b) * 2 + (h)) * HTB)
#define PG8_SB(b, h) ((4 + (b) * 2 + (h)) * HTB)
#define PG8_STAGE_B(bufoff, gbase) do { const char* _gb = (const char*)(gbase); asm volatile("" : "+s"(_gb)); _Pragma("unroll") for (int _i = 0; _i < 2; ++_i) { \
        unsigned _o = voffB[_i]; asm volatile("" : "+v"(_o)); \
        __builtin_amdgcn_global_load_lds((const unsigned*)(_gb + _o), (LAS unsigned*)(lds + (bufoff) + ldsw + _i * 8192), 16, 0, 0); } } while (0)
#define PG8_STAGE_A(bufoff, OFF, h, kb) do { const char* _ab = Abase + (size_t)(kb); asm volatile("" : "+s"(_ab)); _Pragma("unroll") for (int _i = 0; _i < 2; ++_i) { \
        unsigned _o = (OFF)[h][_i]; asm volatile("" : "+v"(_o)); \
        __builtin_amdgcn_global_load_lds((const unsigned*)(_ab + _o), (LAS unsigned*)(lds + (bufoff) + ldsw + _i * 8192), 16, 0, 0); } } while (0)
#define PG8_LDA(dst, b, h) do { _Pragma("unroll") for (int m = 0; m < 4; ++m) _Pragma("unroll") for (int k = 0; k < 2; ++k) dst[m][k] = *(const LAS bf16x8*)(lds + PG8_SA(b, h) + aoff + m * 2048 + k * 1024); } while (0)
#define PG8_LDB(dst, b, h) do { _Pragma("unroll") for (int n = 0; n < 2; ++n) _Pragma("unroll") for (int k = 0; k < 2; ++k) dst[n][k] = *(const LAS bf16x8*)(lds + PG8_SB(b, h) + boff + n * 2048 + k * 1024); } while (0)
#define PG8_MMA(ai, bj, At, Bt) do { __builtin_amdgcn_s_setprio(1); _Pragma("unroll") for (int m = 0; m < 4; ++m) _Pragma("unroll") for (int n = 0; n < 2; ++n) { \
        if constexpr (F8) { acc[ai][bj][m][n] = __builtin_amdgcn_mfma_scale_f32_16x16x128_f8f6f4(cat8(Bt[n][0], Bt[n][1]), cat8(At[m][0], At[m][1]), acc[ai][bj][m][n], 0, 0, 0, 0x7f7f7f7f, 0, 0x7f7f7f7f); } \
        else { _Pragma("unroll") for (int k = 0; k < 2; ++k) acc[ai][bj][m][n] = __builtin_amdgcn_mfma_f32_16x16x32_bf16(Bt[n][k], At[m][k], acc[ai][bj][m][n], 0, 0, 0); } } \
        __builtin_amdgcn_s_setprio(0); } while (0)
#define PG8_WAIT_V(n) asm volatile("s_waitcnt vmcnt(" #n ")" ::: "memory")
#define PG8_WAIT_L(n) asm volatile("s_waitcnt lgkmcnt(" #n ")" ::: "memory")
#define PG8_BAR __builtin_amdgcn_s_barrier()
#define PG8_SCHED __builtin_amdgcn_sched_barrier(0)
    Unit cur, nxt; int ui = 0;
    if (!S.next(0, cur)) return;
    S.ready(cur);
    f32x4 acc[2][2][4][2];
#pragma unroll
    for (int a = 0; a < 2; ++a)
#pragma unroll
        for (int b = 0; b < 2; ++b)
#pragma unroll
            for (int m = 0; m < 4; ++m)
#pragma unroll
                for (int n = 0; n < 2; ++n) acc[a][b][m][n] = (f32x4){0.f, 0.f, 0.f, 0.f};
    bf16x8 At[4][2], B0[2][2], B1[2][2];
    unsigned aC[2][2];
    PG8_AOFF(aC, cur);
    const char* cB = uniform_ptr(cur.bptr);
    E.prefetch(cur, wid, lane);
    PG8_STAGE_B(PG8_SB(0, 0), cB); PG8_STAGE_B(PG8_SB(0, 1), cB + hstepB); PG8_STAGE_A(PG8_SA(0, 0), aC, 0, 0); PG8_STAGE_A(PG8_SA(0, 1), aC, 1, 0);
    if (wr == 1) PG8_BAR;
    PG8_WAIT_V(2); PG8_BAR;
    PG8_STAGE_B(PG8_SB(1, 0), cB + kstep); PG8_STAGE_A(PG8_SA(1, 0), aC, 0, kstep); PG8_STAGE_B(PG8_SB(1, 1), cB + hstepB + kstep);
    PG8_WAIT_V(6); PG8_BAR;
    for (;;) {
        bool has_next = false; const char* nB = cB;
#pragma unroll 1
        for (int t = 0; t < nt; t += 2) {
            const bool last = (t == nt - 2);
            const size_t k1 = (size_t)(t + 1) * kstep;
            const size_t k2 = last ? 0 : (size_t)(t + 2) * kstep, k3 = k2 + kstep;
            if constexpr (Epi::MIDK) { if (t == nt / 2) { int fr_ = fr; asm volatile("" : "+v"(fr_)); E.mid(acc, cur, wr, wc, fr_, fq); } }
            PG8_LDB(B0, 0, 0); PG8_LDB(B1, 0, 1); PG8_SCHED; PG8_LDA(At, 0, 0); PG8_STAGE_A(PG8_SA(1, 1), aC, 1, k1);
            if (last) {
                has_next = S.next(ui + 1, nxt);
                if (has_next) { S.ready(nxt); nB = uniform_ptr(nxt.bptr); PG8_AOFF(aC, nxt); E.prefetch(nxt, wid, lane); }
            }
            const char* b2 = last ? nB : cB + (size_t)(t + 2) * kstep; const char* b3 = b2 + kstep;
            PG8_WAIT_V(8); PG8_WAIT_L(0); PG8_BAR; PG8_MMA(0, 0, At, B0); PG8_MMA(0, 1, At, B1); PG8_BAR; PG8_SCHED;
            PG8_LDA(At, 0, 1); PG8_STAGE_B(PG8_SB(0, 0), b2); PG8_STAGE_B(PG8_SB(0, 1), b2 + hstepB); PG8_STAGE_A(PG8_SA(0, 0), aC, 0, k2);
            PG8_WAIT_V(8); PG8_WAIT_L(0); PG8_BAR; PG8_MMA(1, 0, At, B0); PG8_MMA(1, 1, At, B1); PG8_BAR; PG8_SCHED;
            PG8_LDB(B0, 1, 0); PG8_LDB(B1, 1, 1); PG8_SCHED; PG8_LDA(At, 1, 0); PG8_STAGE_A(PG8_SA(0, 1), aC, 1, k2);
            PG8_WAIT_V(8); PG8_WAIT_L(0); PG8_BAR; PG8_MMA(0, 0, At, B0); PG8_MMA(0, 1, At, B1); PG8_BAR; PG8_SCHED;
            PG8_LDA(At, 1, 1); PG8_STAGE_B(PG8_SB(1, 0), b3); PG8_STAGE_B(PG8_SB(1, 1), b3 + hstepB); PG8_STAGE_A(PG8_SA(1, 0), aC, 0, k3);
            PG8_WAIT_V(8); PG8_WAIT_L(0); PG8_BAR; PG8_MMA(1, 0, At, B0); PG8_MMA(1, 1, At, B1); PG8_BAR; PG8_SCHED;
        }
        if constexpr (ALIGN_EPI) { if (wr == 0) PG8_BAR; }
        { int fr_ = fr, fq_ = fq; asm volatile("" : "+v"(fr_), "+v"(fq_));
          E(acc, cur, wr, wc, fr_, fq_); }
        if (!has_next) break;
#pragma unroll
        for (int a = 0; a < 2; ++a)
#pragma unroll
            for (int b = 0; b < 2; ++b)
#pragma unroll
                for (int m = 0; m < 4; ++m)
#pragma unroll
                    for (int n = 0; n < 2; ++n) acc[a][b][m][n] = (f32x4){0.f, 0.f, 0.f, 0.f};
        cur = nxt; cB = nB; ++ui;
        if constexpr (ALIGN_EPI) { if (wr == 1) PG8_BAR; }
    }
    PG8_WAIT_V(0);
    if constexpr (!ALIGN_EPI) { if (wr == 0) PG8_BAR; }
    PG8_BAR;
#undef PG8_AOFF
#undef PG8_SA
#undef PG8_SB
#undef PG8_STAGE_A
#undef PG8_STAGE_B
#undef PG8_LDA
#undef PG8_LDB
#undef PG8_MMA
#undef PG8_WAIT_V
#undef PG8_WAIT_L
#undef PG8_BAR
#undef PG8_SCHED
}

struct DenseOrder {
    int nM, nN, nwg, G, c, rowbytes; const char* Bt;
    __device__ void init(int M, int N, int rowbytes_, const void* Bt_, int G_, int c_) { nM = M / BM; nN = N / BM; nwg = nM * nN; G = G_; c = c_; rowbytes = rowbytes_; Bt = (const char*)Bt_; }
    __device__ __forceinline__ bool next(int i, Unit& u) const {
        const long L = (long)i * G + c; if (L >= nwg) return false;
        int wgid = (int)L; { const int q = nwg / NXCD, r = nwg % NXCD, xcd = wgid % NXCD, off = wgid / NXCD; wgid = (xcd < r ? xcd * (q + 1) : r * (q + 1) + (xcd - r) * q) + off; }
        const int WGM = 8;
        const int nig = WGM * nN, gid = wgid / nig, fm = gid * WGM, gsz = (nM - fm) < WGM ? (nM - fm) : WGM;
        u.pm = fm + ((wgid % nig) % gsz); u.pn = (wgid % nig) / gsz; u.e = 0; u.li = i; u.kind = 0;
        u.bptr = Bt + (size_t)u.pn * BM * rowbytes;
        return true;
    }
    __device__ __forceinline__ unsigned a_off(const Unit& u, int r) const { return (unsigned)((u.pm * BM + r) * rowbytes); }
    __device__ __forceinline__ void ready(const Unit& u) const {}
};
}
struct Args { const float* in[25]; float* out; unsigned char* ws; int ph_lo, ph_hi; };
enum { I_X = 0, I_C, I_WADA, I_BADA, I_GMIX, I_WIN, I_CONVW, I_CONVB, I_WRGA, I_BRGA, I_WRGX, I_BRGX, I_LAM, I_SINKS, I_GATT, I_GLRU, I_WOUT, I_GFFN,
       I_WR, I_BR, I_WGU, I_BGU, I_WDN, I_BDN, I_GFIN };

struct Frame {
    LAS unsigned char* lds;
    int tid, lane, wave, G, bx, vcu;
    unsigned char* ws;
};

struct CvtItem { const float* src; unsigned char* dst; const float* ks; int N; int f8; };
__device__ __forceinline__ CvtItem p0_decode(const Args& a, unsigned char* ws, int it) {
    constexpr int I_IN = 8 * 56, I_OUT = 8 * 32, I_GU = 32 * 8 * 64;
    CvtItem d; int r = it; d.ks = nullptr; d.f8 = 0;
    if (r < I_IN) { const int kb = r / 56, nb = r % 56; d.N = 1792; d.src = a.in[I_WIN] + (size_t)kb * 128 * 1792 + nb * 32; d.dst = ws + WS_WIN + ((size_t)nb * 32 * 1024 + kb * 128) * 2; return d; } r -= I_IN;
    if (r < I_OUT) { const int kb = r / 32, nb = r % 32; d.N = 1024; d.src = a.in[I_WOUT] + (size_t)kb * 128 * 1024 + nb * 32; d.dst = ws + WS_WOUT + ((size_t)nb * 32 * 1024 + kb * 128) * 2;
        d.ks = ((kb < 4) ? a.in[I_GATT] : (a.in[I_GLRU] - 512)) + kb * 128; return d; } r -= I_OUT;
    if (r < I_GU) { const int e = r / 512, q = r % 512, kb = q / 64, nb = q % 64, n0 = nb * 32;
        const int drow = ((n0 & 1023) >> 7) * 256 + (n0 >> 10) * 128 + (n0 & 127);
        d.N = 2048; d.src = a.in[I_WGU] + (size_t)e * 1024 * 2048 + (size_t)kb * 128 * 2048 + n0; d.dst = ws + WS_WGU + ((size_t)e * 2048 + drow) * 1024 + kb * 128; d.f8 = 1; return d; } r -= I_GU;
    { const int e = r / 256, q = r % 256, kb = q / 32, nb = q % 32;
      d.N = 1024; d.src = a.in[I_WDN] + (size_t)e * 1024 * 1024 + (size_t)kb * 128 * 1024 + nb * 32; d.dst = ws + WS_WDN + ((size_t)e * 1024 + nb * 32) * 1024 + kb * 128; d.f8 = 1; return d; }
}
__device__ __forceinline__ void p0_load(const CvtItem& d, int lane, f32x4 (&v)[16]) {
    const float* p = d.src + (size_t)(16 * (lane >> 3)) * d.N + (lane & 7) * 4;
#pragma unroll
    for (int i = 0; i < 16; ++i) v[i] = __builtin_nontemporal_load((const f32x4*)(p + (size_t)i * d.N));
}

constexpr int P0_NITEMS = 8 * 56 + 8 * 32 + 32 * 8 * 32 + 32 * 8 * 64;
template <class ItemAt>
__device__ __forceinline__ void p0_convert(Frame& F, const Args& a, const ItemAt& item_at) {
    unsigned char* ws = F.ws; const int lane = F.lane, r8 = lane >> 3, l7 = lane & 7;
    int seq = 0;
    f32x4 v[16];
    int it = item_at(0);
    CvtItem d = p0_decode(a, ws, it < 0 ? 0 : it);
    if (it >= 0) p0_load(d, lane, v);
    while (it >= 0) {
        u32x4 o[4][2];
        if (d.f8) {
#pragma unroll
            for (int c = 0; c < 4; ++c) { unsigned w[4];
#pragma unroll
                for (int q = 0; q < 4; ++q) { unsigned x = 0u;
                    x = __builtin_amdgcn_cvt_pk_fp8_f32(v[4 * q + 0][c] * WSCALE, v[4 * q + 1][c] * WSCALE, x, false);
                    x = __builtin_amdgcn_cvt_pk_fp8_f32(v[4 * q + 2][c] * WSCALE, v[4 * q + 3][c] * WSCALE, x, true); w[q] = x; }
                o[c][0] = (u32x4){w[0], w[1], w[2], w[3]}; o[c][1] = o[c][0]; }
        } else {
            float ks[16];
#pragma unroll
            for (int i = 0; i < 16; ++i) ks[i] = d.ks ? d.ks[16 * r8 + i] : 1.0f;
#pragma unroll
            for (int c = 0; c < 4; ++c)
#pragma unroll
                for (int h = 0; h < 2; ++h) { u32x4 t;
                    t.x = pk2(v[8 * h + 0][c] * ks[8 * h + 0], v[8 * h + 1][c] * ks[8 * h + 1]); t.y = pk2(v[8 * h + 2][c] * ks[8 * h + 2], v[8 * h + 3][c] * ks[8 * h + 3]);
                    t.z = pk2(v[8 * h + 4][c] * ks[8 * h + 4], v[8 * h + 5][c] * ks[8 * h + 5]); t.w = pk2(v[8 * h + 6][c] * ks[8 * h + 6], v[8 * h + 7][c] * ks[8 * h + 7]);
                    o[c][h] = t; }
        }
        ++seq; const int itn = item_at(seq);
        const CvtItem dn = p0_decode(a, ws, itn < 0 ? 0 : itn);
        if (itn >= 0) p0_load(dn, lane, v);
        if (d.f8) {
#pragma unroll
            for (int c = 0; c < 4; ++c) __builtin_nontemporal_store(o[c][0], (GAS u32x4*)(d.dst + (size_t)(4 * l7 + c) * 1024 + 16 * r8));
        } else {
#pragma unroll
            for (int c = 0; c < 4; ++c) { GAS u32x4* q = (GAS u32x4*)(d.dst + ((size_t)(4 * l7 + c) * 1024 + 16 * r8) * 2); q[0] = o[c][0]; q[1] = o[c][1]; }
        }
        d = dn; it = itn;
    }
}

__device__ __forceinline__ void p0_store_f8(const CvtItem& d, int lane, const f32x4 (&v)[16]) {
    const int r8 = lane >> 3, l7 = lane & 7;
#pragma unroll
    for (int c = 0; c < 4; ++c) { unsigned w[4];
#pragma unroll
        for (int q = 0; q < 4; ++q) { unsigned x = 0u;
            x = __builtin_amdgcn_cvt_pk_fp8_f32(v[4 * q + 0][c] * WSCALE, v[4 * q + 1][c] * WSCALE, x, false);
            x = __builtin_amdgcn_cvt_pk_fp8_f32(v[4 * q + 2][c] * WSCALE, v[4 * q + 3][c] * WSCALE, x, true); w[q] = x; }
        __builtin_nontemporal_store((u32x4){w[0], w[1], w[2], w[3]}, (GAS u32x4*)(d.dst + (size_t)(4 * l7 + c) * 1024 + 16 * r8)); }
}
__device__ __forceinline__ void p0_load_half(const CvtItem& d, int h, int lane, f32x4 (&v)[8]) {
    const float* p = d.src + (size_t)(64 * h + 8 * (lane >> 3)) * d.N + (lane & 7) * 4;
#pragma unroll
    for (int i = 0; i < 8; ++i) v[i] = __builtin_nontemporal_load((const f32x4*)(p + (size_t)i * d.N));
}
__device__ __forceinline__ void p0_store_half_f8(const CvtItem& d, int h, int lane, const f32x4 (&v)[8]) {
    const int r8 = lane >> 3, l7 = lane & 7;
#pragma unroll
    for (int c = 0; c < 4; ++c) { unsigned w[2];
#pragma unroll
        for (int q = 0; q < 2; ++q) { unsigned x = 0u;
            x = __builtin_amdgcn_cvt_pk_fp8_f32(v[4 * q + 0][c] * WSCALE, v[4 * q + 1][c] * WSCALE, x, false);
            x = __builtin_amdgcn_cvt_pk_fp8_f32(v[4 * q + 2][c] * WSCALE, v[4 * q + 3][c] * WSCALE, x, true); w[q] = x; }
        __builtin_nontemporal_store((u32x2){w[0], w[1]}, (GAS u32x2*)(d.dst + (size_t)(4 * l7 + c) * 1024 + 64 * h + 8 * r8)); }
}
__device__ __forceinline__ void xcd_barrier_bg(const XcdBarrier& b, Frame& F, const Args& a, const int item) {
    asm volatile("s_waitcnt vmcnt(0)" ::: "memory");
    __syncthreads();
    const bool has = (item >= 0) && (F.wave != 0);
    const CvtItem d = p0_decode(a, F.ws, has ? item : 0); f32x4 v[16];
    if (has) p0_load(d, F.lane, v);
    if (threadIdx.x == 0) {
        unsigned* bar = b.bar;
        __builtin_amdgcn_s_waitcnt(0);
        unsigned nloc = b.st[0], nx = b.st[1];
        if (nloc == 0u) { xcd_barrier_complete(bar, b.x, nloc, nx); b.st[0] = nloc; b.st[1] = nx; }
        const unsigned old = xb_add(&bar[XB_XSUB(b.x)], 1u);
        const unsigned gen = old / nloc;
        if (old + 1u == (gen + 1u) * nloc) {
            __builtin_amdgcn_fence(__ATOMIC_RELEASE, "agent");
            asm volatile("s_waitcnt vmcnt(0)" ::: "memory");
            const unsigned og = xb_add(&bar[XB_TOP], 1u);
            const unsigned tg = og / nx;
            if (og + 1u == (tg + 1u) * nx) xb_add(&bar[XB_TOPGEN], 1u);
            else XB_SPIN(xb_ld(&bar[XB_TOPGEN]) == tg, bar);
            __builtin_amdgcn_fence(__ATOMIC_ACQUIRE, "agent");
            xb_add(&bar[XB_XGEN(b.x)], 1u);
            asm volatile("s_waitcnt vmcnt(0)" ::: "memory");
        } else {
            XB_SPIN(xb_ld(&bar[XB_XGEN(b.x)]) == gen, bar);
            __builtin_amdgcn_fence(__ATOMIC_ACQUIRE, "agent");
            asm volatile("s_waitcnt vmcnt(0)" ::: "memory");
        }
    }
    __syncthreads();
    if (has) p0_store_f8(d, F.lane, v);
}

__device__ __forceinline__ void p0_phase(Frame& F, const Args& a, const int nfg) {
    unsigned char* ws = F.ws;
    if (F.bx < 192) {
        LAS float* cs = (LAS float*)F.lds;
        LAS float* red = (LAS float*)(F.lds + 32768);
        const float* c = a.in[I_C];
#pragma unroll
        for (int i = 0; i < 4; ++i) ((LAS f32x4*)cs)[F.tid + NTHR * i] = ((const GAS f32x4*)c)[F.tid + NTHR * i];
        __syncthreads();
        const int j0 = F.bx * 32;
        { const int c4 = (F.tid & 7) * 4, kg = F.tid >> 3;
          const float* w = a.in[I_WADA] + j0 + c4;
          f32x4 acc[8];
#pragma unroll
          for (int b = 0; b < 8; ++b) acc[b] = (f32x4){0.f, 0.f, 0.f, 0.f};
#pragma unroll
          for (int i = 0; i < 16; ++i) { const int k = kg + 64 * i; const f32x4 wv = *(const GAS f32x4*)(w + (size_t)k * 6144);
#pragma unroll
              for (int b = 0; b < 8; ++b) acc[b] += wv * cs[b * 1024 + k]; }
          LAS float* red4 = (LAS float*)(F.lds + 32768);
#pragma unroll
          for (int b = 0; b < 8; ++b) *(LAS f32x4*)(red4 + (kg * 8 + b) * 32 + c4) = acc[b]; }
        __syncthreads();
        if (F.tid < 256) { const int b = F.tid >> 5, col = F.tid & 31; float s = a.in[I_BADA][j0 + col];
            const LAS float* red4 = (const LAS float*)(F.lds + 32768);
#pragma unroll 16
            for (int g = 0; g < 64; ++g) s += red4[(g * 8 + b) * 32 + col];
            ((float*)(ws + WS_MOD))[b * 6144 + j0 + col] = s; }
        asm volatile("s_waitcnt vmcnt(0)" ::: "memory");
        __syncthreads();
        if (F.tid == 0) { __builtin_amdgcn_fence(__ATOMIC_RELEASE, "agent"); asm volatile("s_waitcnt vmcnt(0)" ::: "memory");
            __hip_atomic_fetch_add((unsigned*)(ws + WS_CTL) + CW_MODCNT, 1u, RLX_AGENT); }
    }
    { u32x4* L = (u32x4*)(ws + WS_LIST); const int n4 = NE * LISTCAP / 4; const unsigned dv = (unsigned)DUMP;
      for (int i = F.bx * NTHR + F.tid; i < n4; i += F.G * NTHR) L[i] = (u32x4){dv, dv, dv, dv};
    }
    const int gw = F.bx * NWAVES + F.wave, NGW = F.G * NWAVES;
    const int NBASE = nfg / NGW;
    const int nstrided = NBASE * NGW;
    const int xw = gw - 128 * NWAVES, NXW = NGW - 128 * NWAVES;
    p0_convert(F, a, [&](int q) -> int { if (q < NBASE) return gw + NGW * q;
        if (xw < 0 || NXW <= 0) { const int it = nstrided + gw + NGW * (q - NBASE); return (NXW <= 0 && it < nfg) ? it : -1; }
        const int it = nstrided + xw + NXW * (q - NBASE); return it < nfg ? it : -1; });
}

__device__ __forceinline__ void router_operands(Frame& F, const Args& a, int bi, int nblk) {
    const float* mod = (const float*)(F.ws + WS_MOD);
    bf16_t* WRH = (bf16_t*)(F.ws + WS_WRP); bf16_t* WRL = WRH + NB * NE * 1024;
    for (int idx = bi * NTHR + F.tid; idx < NB * NE * 1024; idx += nblk * NTHR) { const int b = idx >> 15, e = (idx >> 10) & 31, k = idx & 1023;
        const float v = a.in[I_GFFN][k] * (1.0f + mod[b * 6144 + 4096 + k]) * a.in[I_WR][k * 32 + e];
        const unsigned h = f2bf(v); WRH[idx] = (bf16_t)h; WRL[idx] = (bf16_t)f2bf(v - bf2f((unsigned short)h)); }
    for (int o = bi * NWAVES + F.wave; o < NB * NE; o += nblk * NWAVES) { const int b = o >> 5, e = o & 31; float s = 0.f;
#pragma unroll
        for (int j = 0; j < 16; ++j) { const int k = F.lane + 64 * j; s += mod[b * 6144 + 3072 + k] * a.in[I_WR][k * 32 + e]; }
        s = wave_sum(s);
        if (F.lane == 0) ((float*)(F.ws + WS_CSTB))[o] = s + a.in[I_BR][e]; }
}

__device__ __forceinline__ void p1_phase(Frame& F, const Args& a) {
    const int nw = F.G;
    const int gw = F.bx * NWAVES + F.wave, NGW = nw * NWAVES;
    const int vw = F.vcu * NWAVES + F.wave;
    constexpr int RPW = T / (256 * NWAVES);
    const float* mod = (const float*)(F.ws + WS_MOD);
    if (F.tid == 0) { unsigned* mc = (unsigned*)(F.ws + WS_CTL) + CW_MODCNT; unsigned spins = 0;
        while (__hip_atomic_load(mc, RLX_AGENT) < 192u) { __builtin_amdgcn_s_sleep(4); if (++spins > (1u << 20)) break; }
        __builtin_amdgcn_fence(__ATOMIC_ACQUIRE, "agent"); asm volatile("s_waitcnt vmcnt(0)" ::: "memory"); }
    __syncthreads();
    const int wv = (nw % 8 == 0 && F.G % 8 == 0) ? ((F.bx % 8) * (nw / 8) + F.bx / 8) * NWAVES + F.wave : gw;
    const bool blocked = (F.G == 256 && nw == 256);
    const int m0 = blocked ? vw * RPW : (int)(((long)wv * T) / NGW), mstep = 1, mend = blocked ? (vw + 1) * RPW : (int)(((long)(wv + 1) * T) / NGW);
    f32x4 gm[2][2], sh[2][2]; int bcur = -1;
    for (int mb = m0; mb < mend; mb += 4 * mstep) {
        f32x4 v[4][2][2];
#pragma unroll
        for (int q = 0; q < 4; ++q) { const int m = mb + q * mstep;
            if (m < mend) {
#pragma unroll
                for (int j = 0; j < 2; ++j)
#pragma unroll
                    for (int h = 0; h < 2; ++h) v[q][j][h] = *((const GAS f32x4*)(a.in[I_X] + (size_t)m * D + 512 * j) + 2 * F.lane + h); } }
#pragma unroll
        for (int q = 0; q < 4; ++q) { const int m = mb + q * mstep;
            if (m < mend) {
                const int b = m / SEQ;
                if (b != bcur) { bcur = b;
#pragma unroll
                    for (int j = 0; j < 2; ++j)
#pragma unroll
                        for (int h = 0; h < 2; ++h) { const int c4 = 128 * j + 2 * F.lane + h;
                            gm[j][h] = ((const GAS f32x4*)a.in[I_GMIX])[c4] * (((const GAS f32x4*)(mod + b * 6144 + 1024))[c4] + 1.0f);
                            sh[j][h] = ((const GAS f32x4*)(mod + b * 6144))[c4]; } }
                float s = 0.f;
#pragma unroll
                for (int j = 0; j < 2; ++j)
#pragma unroll
                    for (int h = 0; h < 2; ++h) { const f32x4 t = v[q][j][h]; s += (t.x * t.x + t.y * t.y) + (t.z * t.z + t.w * t.w); }
                const float rs = rsqrtf(wave_sum(s) * (1.f / D) + EPS);
                GAS u32x4* o16 = (GAS u32x4*)((bf16_t*)(F.ws + WS_H) + (size_t)m * D) + F.lane;
#pragma unroll
                for (int j = 0; j < 2; ++j) { const f32x4 y0 = v[q][j][0] * rs * gm[j][0] + sh[j][0], y1 = v[q][j][1] * rs * gm[j][1] + sh[j][1];
                    u32x4 w; w.x = pk2(y0.x, y0.y); w.y = pk2(y0.z, y0.w); w.z = pk2(y1.x, y1.y); w.w = pk2(y1.z, y1.w); o16[64 * j] = w; } } }
    }
}

struct EpiBf16 {
    static constexpr bool PERM = true, MIDK = false;
    bf16_t* O; int ldc;
    __device__ __forceinline__ void operator()(const f32x4 (&acc)[2][2][4][2], const pg8::Unit& u, int wr, int wc, int fr, int fq) const {
        const int row0 = u.pm * 256 + wr * 64 + fr, col0 = u.pn * 256 + wc * 32 + 8 * fq;
#pragma unroll
        for (int ai = 0; ai < 2; ++ai)
#pragma unroll
            for (int m = 0; m < 4; ++m) { bf16_t* rowp = O + (size_t)(row0 + ai * 128 + m * 16) * ldc + col0;
#pragma unroll
                for (int bj = 0; bj < 2; ++bj) { const f32x4 v0 = acc[ai][bj][m][0], v1 = acc[ai][bj][m][1];
                    u32x4 w; w.x = cvt_pk_bf16(v0[0], v0[1]); w.y = cvt_pk_bf16(v0[2], v0[3]); w.z = cvt_pk_bf16(v1[0], v1[1]); w.w = cvt_pk_bf16(v1[2], v1[3]);
                    *(u32x4*)(rowp + bj * 128) = w; } }
    }
    __device__ __forceinline__ void mid(f32x4 (&acc)[2][2][4][2], const pg8::Unit& u, int wr, int wc, int fr, int fq) const {}
    __device__ __forceinline__ void prefetch(const pg8::Unit& u, int wid, int lane) const {}
};
__device__ __forceinline__ int crow(int r, int hi) { return (r & 3) + 8 * (r >> 2) + 4 * hi; }
__device__ __forceinline__ s16x4 vtr(const LAS unsigned char* p) {
    typedef short v4i16_t __attribute__((ext_vector_type(4)));
    return __builtin_bit_cast(s16x4, __builtin_amdgcn_ds_read_tr16_b64_v4i16((LAS v4i16_t*)p));
}

__device__ __forceinline__ void attn_item(Frame& F, const Args& a, int item, const int bgslot) {
    const int b = item >> 5, n = (item >> 1) & 15, j = item & 1;
    const bf16_t* P = (const bf16_t*)(F.ws + WS_P);
    LAS unsigned char* Kl = F.lds;
    LAS unsigned char* Vl = F.lds + 32768;
    LAS unsigned char* ost = F.lds + 65536 + F.wave * 4608;
    LAS float* wsf = (LAS float*)(ost + 4096);
    const int lane = F.lane, ql = lane & 31, hi = lane >> 5;
    const CvtItem bgd2 = p0_decode(a, F.ws, bgslot >= 0 ? P0_NITEMS - 1 - (bgslot + F.G * NWAVES + F.bx * NWAVES + F.wave) : 0); f32x4 bgv2[8];
    if (bgslot >= 0) p0_load_half(bgd2, 0, lane, bgv2);
    {
        const int row = F.tid >> 1, half = F.tid & 1;
        int tb = 128 * (n - 1) + row; if (tb < 0) tb += 128;
        const bf16_t* src = P + (size_t)(b * SEQ + tb) * NCOL + 64 * j;
#pragma unroll
        for (int i = 0; i < 4; ++i) { const int c = half * 4 + i;
            const u32x4 kv = *(const GAS u32x4*)(src + KOFF + 8 * c);
            const u32x4 vv = *(const GAS u32x4*)(src + VOFF + 8 * c);
            *(LAS u32x4*)(Kl + row * 128 + ((c ^ (row & 7)) * 16)) = kv;
            *(LAS u32x4*)(Vl + row * 128 + c * 16) = vv; }
    }
    __syncthreads();
    if (bgslot >= 0) p0_store_half_f8(bgd2, 0, lane, bgv2);
    const int g = F.wave >> 1, qh = F.wave & 1, h = 4 * j + g;
    const float sink = a.in[I_SINKS][h];
    constexpr float L2E = 1.4426950408889634f, C1 = 0.125f * 1.4426950408889634f;
    const bool has_bg = bgslot >= 0;
    const CvtItem bgd = p0_decode(a, F.ws, has_bg ? P0_NITEMS - 1 - (bgslot + F.bx * NWAVES + F.wave) : 0);
    for (int qb = 0; qb < 2; ++qb) {
        f32x4 bgv[8];
        if (has_bg) p0_load_half(bgd, qb, lane, bgv);
        const int o = 64 * qh + 32 * qb;
        const int tq0 = b * SEQ + 128 * n + o;
        bf16x8 qr[4];
#pragma unroll
        for (int d0 = 0; d0 < 4; ++d0) qr[d0] = *(const GAS bf16x8*)(P + (size_t)(tq0 + ql) * NCOL + QOFF + 64 * h + 16 * d0 + 8 * hi);
        f32x16 S[5];
#pragma unroll
        for (int kt = 0; kt < 5; ++kt) {
            const int key = o + 32 * kt + ql;
            f32x16 acc = {};
#pragma unroll
            for (int d0 = 0; d0 < 4; ++d0) { const int c = 2 * d0 + hi;
                const bf16x8 kf = *(const LAS bf16x8*)(Kl + key * 128 + ((c ^ (key & 7)) * 16));
                acc = __builtin_amdgcn_mfma_f32_32x32x16_bf16(kf, qr[d0], acc, 0, 0, 0); }
            S[kt] = acc;
        }
        constexpr float NEG = -1.0e30f;
#pragma unroll
        for (int r = 0; r < 16; ++r) { const int cr = crow(r, hi);
            if (!(cr > ql)) S[0][r] = NEG;
            if (!(cr <= ql)) S[4][r] = NEG; }
        if (n == 0) {
#pragma unroll
            for (int kt = 0; kt < 4; ++kt)
#pragma unroll
                for (int r = 0; r < 16; ++r) if (o + 32 * kt + crow(r, hi) < 128) S[kt][r] = NEG;
        }
        float mx = NEG;
#pragma unroll
        for (int kt = 0; kt < 5; ++kt)
#pragma unroll
            for (int r = 0; r < 16; ++r) mx = fmaxf(mx, S[kt][r]);
        mx = fmaxf(mx, xor32f(mx, hi));
        const float m = fmaxf(mx * 0.125f, sink);
        const float mb = m * L2E;
        float l = 0.f;
#pragma unroll
        for (int kt = 0; kt < 5; ++kt)
#pragma unroll
            for (int r = 0; r < 16; ++r) { const float p = __builtin_amdgcn_exp2f(S[kt][r] * C1 - mb); S[kt][r] = p; l += p; }
        l += xor32f(l, hi);
        l += __builtin_amdgcn_exp2f((sink - m) * L2E);
        if (hi == 0) wsf[ql] = 1.0f / l;
        f32x16 O0 = {}, O1 = {};
        const int gi = (lane >> 4) & 1, li = lane & 15;
        const LAS unsigned char* vb = Vl + (o + 4 * hi + (li >> 2)) * 128 + (16 * gi + 4 * (li & 3)) * 2;
#pragma unroll
        for (int kt = 0; kt < 5; ++kt)
#pragma unroll
            for (int s = 0; s < 2; ++s) {
                bf16x8 pa;
                { const f32x16& X = S[kt];
                  const unsigned w0 = cvt_pk_bf16(X[8 * s + 0], X[8 * s + 1]), w1 = cvt_pk_bf16(X[8 * s + 2], X[8 * s + 3]);
                  const unsigned w2 = cvt_pk_bf16(X[8 * s + 4], X[8 * s + 5]), w3 = cvt_pk_bf16(X[8 * s + 6], X[8 * s + 7]);
                  pa = __builtin_bit_cast(bf16x8, (u32x4){w0, w1, w2, w3}); }
                const LAS unsigned char* vp = vb + (32 * kt + 16 * s) * 128;
                const s16x4 lo0 = vtr(vp), hi0 = vtr(vp + 8 * 128);
                const s16x4 lo1 = vtr(vp + 64), hi1 = vtr(vp + 8 * 128 + 64);
                const bf16x8 v0 = (bf16x8){lo0[0], lo0[1], lo0[2], lo0[3], hi0[0], hi0[1], hi0[2], hi0[3]};
                const bf16x8 v1 = (bf16x8){lo1[0], lo1[1], lo1[2], lo1[3], hi1[0], hi1[1], hi1[2], hi1[3]};
                O0 = __builtin_amdgcn_mfma_f32_32x32x16_bf16(pa, v0, O0, 0, 0, 0);
                O1 = __builtin_amdgcn_mfma_f32_32x32x16_bf16(pa, v1, O1, 0, 0, 0);
            }
        LDS_WAIT(); asm volatile("" ::: "memory");
#pragma unroll
        for (int r = 0; r < 16; ++r) { const int q = crow(r, hi); const float il = wsf[q];
            *(LAS unsigned short*)(ost + q * 128 + ql * 2) = (unsigned short)f2bf(O0[r] * il);
            *(LAS unsigned short*)(ost + q * 128 + (32 + ql) * 2) = (unsigned short)f2bf(O1[r] * il); }
        LDS_WAIT(); asm volatile("" ::: "memory");
        bf16_t* MIXp = (bf16_t*)(F.ws + WS_MIX);
        float* SSQA = (float*)(F.ws + WS_SSQA);
#pragma unroll
        for (int i = 0; i < 4; ++i) { const int id = lane + 64 * i, row = id >> 3, ch = id & 7;
            const u32x4 w = *(const LAS u32x4*)(ost + row * 128 + ch * 16);
            *(GAS u32x4*)(MIXp + (size_t)(tq0 + row) * D + 64 * h + 8 * ch) = w;
            float ss = bflo(w.x) * bflo(w.x) + bfhi(w.x) * bfhi(w.x) + bflo(w.y) * bflo(w.y) + bfhi(w.y) * bfhi(w.y)
                     + bflo(w.z) * bflo(w.z) + bfhi(w.z) * bfhi(w.z) + bflo(w.w) * bflo(w.w) + bfhi(w.w) * bfhi(w.w);
            ss += __shfl_xor(ss, 1); ss += __shfl_xor(ss, 2); ss += __shfl_xor(ss, 4);
            if (ch == 0) SSQA[(size_t)(tq0 + row) * 8 + h] = ss; }
        LDS_WAIT(); asm volatile("" ::: "memory");
        if (has_bg) p0_store_half_f8(bgd, qb, lane, bgv);
    }
    __syncthreads();
}

struct LruPre { float ba, bx, cwf[4], cbf, lg8; };
constexpr int LRU_WB_OFF = 106496;
__device__ __forceinline__ LruPre lru_pre(Frame& F, const Args& a, int item) {
    const int hb = (item >> 2) & 7, qt = item & 3;
    const int c0 = hb * 64 + qt * 16;
    constexpr int XR_BYTES = 33280; constexpr int XGP = 264;
    const int tid = F.tid, lane = F.lane, w = F.wave;
    const int ch = lane & 15, kq = lane >> 4;
    LruPre pre;
    LAS u32x4* WB = (LAS u32x4*)(F.lds + LRU_WB_OFF);
    float ba, bx;
    {
      LAS float* WA = (LAS float*)(F.lds + XR_BYTES);
      LAS float* WX = WA + 4096;
      LAS float* CW = (LAS float*)(F.lds + 2 * XR_BYTES + 3 * 16 * XGP * 2 + 2 * 1024);
      { const GAS f32x4* ga = (const GAS f32x4*)(a.in[I_WRGA] + (size_t)hb * 4096); const GAS f32x4* gx = (const GAS f32x4*)(a.in[I_WRGX] + (size_t)hb * 4096);
#pragma unroll
        for (int i = 0; i < 2; ++i) { ((LAS f32x4*)WA)[tid + NTHR * i] = ga[tid + NTHR * i]; ((LAS f32x4*)WX)[tid + NTHR * i] = gx[tid + NTHR * i]; }
        if (tid < 320) CW[tid] = (tid < 256) ? a.in[I_CONVW][(tid >> 6) * 512 + hb * 64 + (tid & 63)] : a.in[I_CONVB][hb * 64 + (tid & 63)]; }
      __syncthreads();
      const int col = qt * 16 + ch;
      float sa = 0.f, sx = 0.f;
#pragma unroll 8
      for (int i = 0; i < 64; ++i) { const float cbv = CW[256 + i]; sa += cbv * WA[i * 64 + col]; sx += cbv * WX[i * 64 + col]; }
      ba = a.in[I_BRGA][c0 + ch] + sa; bx = a.in[I_BRGX][c0 + ch] + sx;
      if (w == 0) {
#pragma unroll 1
          for (int f = 0; f < 16; ++f) { const int k = f >> 2, mat = (f >> 1) & 1, ks = f & 1; const LAS float* Wm = mat ? WX : WA; unsigned pw[4];
#pragma unroll
              for (int jj = 0; jj < 4; ++jj) { const int i = 32 * ks + 8 * kq + 2 * jj;
                  pw[jj] = pk2(CW[k * 64 + i] * Wm[i * 64 + col], CW[k * 64 + i + 1] * Wm[(i + 1) * 64 + col]); }
              WB[f * 64 + lane] = (u32x4){pw[0], pw[1], pw[2], pw[3]}; } } }
    float cwf[4];
#pragma unroll
    for (int k = 0; k < 4; ++k) cwf[k] = a.in[I_CONVW][k * 512 + c0 + ch];
    const float cbf = a.in[I_CONVB][c0 + ch];
    const float lg8 = -8.0f * log1pf(expf(-a.in[I_LAM][c0 + ch]));
    pre.ba = ba; pre.bx = bx; pre.cbf = cbf; pre.lg8 = lg8;
#pragma unroll
    for (int k = 0; k < 4; ++k) pre.cwf[k] = cwf[k];
    __syncthreads();
    return pre;
}

__device__ __forceinline__ void lru_item(Frame& F, const Args& a, int item, const LruPre& pre) {
    const int b = item >> 5, hb = (item >> 2) & 7, qt = item & 3;
    const int c0 = hb * 64 + qt * 16;
    const bf16_t* P = (const bf16_t*)(F.ws + WS_P);
    constexpr int XR_BYTES = 33280;
    constexpr int XGP = 264;
    LAS unsigned char* XR0 = F.lds;
    LAS unsigned short* XG0 = (LAS unsigned short*)(F.lds + 2 * XR_BYTES);
    LAS float* AGG0 = (LAS float*)(F.lds + 2 * XR_BYTES + 3 * 16 * XGP * 2);
    LAS unsigned char* OST = F.lds + 2 * XR_BYTES + 3 * 16 * XGP * 2 + 2 * 1024 + F.wave * 1024;
    const int tid = F.tid, lane = F.lane, w = F.wave;
    const int ch = lane & 15, kq = lane >> 4;
    const int cg = tid & 7, tg = tid >> 3;
    u32x4 rin[4], rhalo, rxg;
#define LRU_LOAD_TILE(tile_) do { const int t0_ = (tile_) * 256; \
        _Pragma("unroll") for (int j = 0; j < 4; ++j) rin[j] = *(const GAS u32x4*)(P + ((size_t)b * SEQ + t0_ + 4 * tg + j) * NCOL + XROFF + hb * 64 + 8 * cg); \
        { const int hp_ = t0_ - 3 + ((tid >> 3) % 3); unsigned hm_ = hp_ >= 0 ? 0xffffffffu : 0u; asm volatile("" : "+v"(hm_));     \
            rhalo = *(const GAS u32x4*)(P + ((size_t)b * SEQ + (hp_ >= 0 ? hp_ : 0)) * NCOL + XROFF + hb * 64 + 8 * cg); \
            rhalo.x &= hm_; rhalo.y &= hm_; rhalo.z &= hm_; rhalo.w &= hm_; } \
        rxg = *(const GAS u32x4*)(P + ((size_t)b * SEQ + t0_ + (tid >> 1)) * NCOL + XGOFF + c0 + 8 * (tid & 1)); } while (0)
#define LRU_STAGE_TILE(tile_) do { LAS unsigned char* XR_ = XR0 + ((tile_) & 1) * XR_BYTES; LAS unsigned short* XG_ = XG0 + ((tile_) % 3) * (16 * XGP); \
        _Pragma("unroll") for (int j = 0; j < 4; ++j) { const int r_ = 3 + 4 * tg + j; *(LAS u32x4*)(XR_ + r_ * 128 + ((cg ^ (r_ & 7)) * 16)) = rin[j]; } \
        if (tid < 24) { const int r_ = tid >> 3; *(LAS u32x4*)(XR_ + r_ * 128 + ((cg ^ (r_ & 7)) * 16)) = rhalo; } \
        { const int tk_ = tid >> 1, hf_ = tid & 1; const unsigned xw_[4] = {rxg.x, rxg.y, rxg.z, rxg.w}; \
          _Pragma("unroll") for (int e = 0; e < 8; ++e) XG_[(hf_ * 8 + e) * XGP + tk_] = (unsigned short)((e & 1) ? (xw_[e >> 1] >> 16) : (xw_[e >> 1] & 0xffffu)); } } while (0)
    LRU_LOAD_TILE(0);
    LAS u32x4* WB = (LAS u32x4*)(F.lds + LRU_WB_OFF);
    const float ba = pre.ba, bx = pre.bx, cbf = pre.cbf, lg8 = pre.lg8;
    const float cwf[4] = {pre.cwf[0], pre.cwf[1], pre.cwf[2], pre.cwf[3]};
    float htile = 0.f;
    bf16_t* MIXp = (bf16_t*)(F.ws + WS_MIX);
    float* SSQL = (float*)(F.ws + WS_SSQL);
    LRU_STAGE_TILE(0);
    LRU_LOAD_TILE(1);
    __syncthreads();
    bf16x8 wbf[16];
#pragma unroll
    for (int f = 0; f < 16; ++f) wbf[f] = __builtin_bit_cast(bf16x8, WB[f * 64 + lane]);
    for (int tile = 0; tile < 8; ++tile) {
        const LAS unsigned char* XR = XR0 + (tile & 1) * XR_BYTES;
        const LAS unsigned short* XG = XG0 + (tile % 3) * (16 * XGP);
        LAS float* AGG = AGG0 + (tile & 1) * 256;
        const size_t tokbase = (size_t)b * SEQ + tile * 256;
        float hloc[2][4], pcum[2][4];
        float Aw = 1.f, Hw = 0.f;
#pragma unroll
        for (int mt = 0; mt < 2; ++mt) {
            const int R0 = 32 * w + 16 * mt;
            f32x4 accR = {0.f, 0.f, 0.f, 0.f}, accI = {0.f, 0.f, 0.f, 0.f};
#pragma unroll
            for (int k = 0; k < 4; ++k) { const int r = R0 + ch + k;
#pragma unroll
                for (int ks = 0; ks < 2; ++ks) { const int c = 4 * ks + kq;
                    const bf16x8 af = *(const LAS bf16x8*)(XR + r * 128 + ((c ^ (r & 7)) * 16));
                    accR = __builtin_amdgcn_mfma_f32_16x16x32_bf16(af, wbf[(k * 2 + 0) * 2 + ks], accR, 0, 0, 0);
                    accI = __builtin_amdgcn_mfma_f32_16x16x32_bf16(af, wbf[(k * 2 + 1) * 2 + ks], accI, 0, 0, 0); } }
            const int tl0 = R0 + 4 * kq;
            float xr7[7];
#pragma unroll
            for (int q = 0; q < 7; ++q) { const int r = tl0 + q; const int cc = (qt * 2 + (ch >> 3)) ^ (r & 7);
                xr7[q] = bf2f(*(const LAS unsigned short*)(XR + r * 128 + cc * 16 + (ch & 7) * 2)); }
            float av[4], uv[4];
#pragma unroll
            for (int r = 0; r < 4; ++r) {
                const float xc = cbf + cwf[0] * xr7[r] + cwf[1] * xr7[r + 1] + cwf[2] * xr7[r + 2] + cwf[3] * xr7[r + 3];
                const float rg = __builtin_amdgcn_rcpf(1.0f + __expf(-(accR[r] + ba)));
                const float ig = __builtin_amdgcn_rcpf(1.0f + __expf(-(accI[r] + bx)));
                const float aa = __expf(rg * lg8);
                av[r] = aa;
                uv[r] = __builtin_amdgcn_sqrtf(fmaxf(1.0f - aa * aa, 0.0f)) * (ig * xc);
            }
            float p = 1.f, h = 0.f, pl[4], hl[4];
#pragma unroll
            for (int r = 0; r < 4; ++r) { h = av[r] * h + uv[r]; p *= av[r]; pl[r] = p; hl[r] = h; }
            const int odd = kq & 1, hi2 = kq >> 1;
            const float pA = xor16f(p, odd), pH = xor16f(h, odd);
            const float loA = odd ? pA : p, loH = odd ? pH : h, upA = odd ? p : pA, upH = odd ? h : pH;
            const float TA = upA * loA, TH = upA * loH + upH;
            const float qA = xor32f(TA, hi2), qH = xor32f(TH, hi2);
            const float e1A = odd ? loA : 1.f, e1H = odd ? loH : 0.f;
            const float Ae = hi2 ? e1A * qA : e1A, He = hi2 ? e1A * qH + e1H : e1H;
            const float Apre = Ae * Aw, Hpre = Ae * Hw + He;
#pragma unroll
            for (int r = 0; r < 4; ++r) { hloc[mt][r] = pl[r] * Hpre + hl[r]; pcum[mt][r] = pl[r] * Apre; }
            const float At = hi2 ? TA * qA : qA * TA, Ht = hi2 ? TA * qH + TH : qA * TH + qH;
            Hw = At * Hw + Ht; Aw = At * Aw;
        }
        if (kq == 0) { AGG[(w * 16 + ch) * 2] = Aw; AGG[(w * 16 + ch) * 2 + 1] = Hw; }
        if (tile + 1 < 8) { LRU_STAGE_TILE(tile + 1); if (tile + 2 < 8) LRU_LOAD_TILE(tile + 2); }
        __syncthreads();
        float hin = htile, hrun = htile;
#pragma unroll
        for (int j = 0; j < 8; ++j) { const f32x2 ah = *(const LAS f32x2*)(AGG + (j * 16 + ch) * 2); if (j == w) hin = hrun; hrun = ah.x * hrun + ah.y; }
        htile = hrun;
#pragma unroll
        for (int mt = 0; mt < 2; ++mt) { const int tl0 = 32 * w + 16 * mt + 4 * kq;
            const u32x2 xgw = *(const LAS u32x2*)(XG + ch * XGP + tl0);
            const float gv[4] = {bflo(xgw.x), bfhi(xgw.x), bflo(xgw.y), bfhi(xgw.y)};
#pragma unroll
            for (int r = 0; r < 4; ++r) { const float hh = hloc[mt][r] + pcum[mt][r] * hin; const float x = gv[r];
                const float z2 = 1.5957691216057308f * (x + 0.044715f * x * x * x);
                const float y = hh * (x * __builtin_amdgcn_rcpf(1.0f + __expf(-z2)));
                *(LAS unsigned short*)(OST + (16 * mt + 4 * kq + r) * 32 + ch * 2) = (unsigned short)f2bf(y); } }
        LDS_WAIT(); asm volatile("" ::: "memory");
        { const int tk = lane >> 1, hf = lane & 1;
          const u32x4 o = *(const LAS u32x4*)(OST + tk * 32 + hf * 16);
          *(GAS u32x4*)(MIXp + (tokbase + 32 * w + tk) * D + 512 + c0 + 8 * hf) = o;
          float ss = bflo(o.x) * bflo(o.x) + bfhi(o.x) * bfhi(o.x) + bflo(o.y) * bflo(o.y) + bfhi(o.y) * bfhi(o.y)
                   + bflo(o.z) * bflo(o.z) + bfhi(o.z) * bfhi(o.z) + bflo(o.w) * bflo(o.w) + bfhi(o.w) * bfhi(o.w);
          ss += __shfl_xor(ss, 1);
          if (hf == 0) SSQL[(tokbase + 32 * w + tk) * 32 + hb * 4 + qt] = ss; }
        LDS_WAIT(); asm volatile("" ::: "memory");
    }
#undef LRU_LOAD_TILE
#undef LRU_STAGE_TILE
    __syncthreads();
}

struct EpiX1 {
    static constexpr bool PERM = false, MIDK = true;
    const float* x; const float* mod; bf16_t* X1; float* SSQ1; const LAS f32x2* RS;
    __device__ __forceinline__ void mid(f32x4 (&acc)[2][2][4][2], const pg8::Unit& u, int wr, int wc, int fr, int fq) const {
#pragma unroll
        for (int ai = 0; ai < 2; ++ai)
#pragma unroll
            for (int m = 0; m < 4; ++m) { const float f = RS[ai * 128 + wr * 64 + m * 16 + fr].x;
#pragma unroll
                for (int bj = 0; bj < 2; ++bj)
#pragma unroll
                    for (int n = 0; n < 2; ++n) acc[ai][bj][m][n] = acc[ai][bj][m][n] * f; }
    }
    __device__ __forceinline__ void prefetch(const pg8::Unit& u, int wid, int lane) const {}
    __device__ __forceinline__ void operator()(const f32x4 (&acc)[2][2][4][2], const pg8::Unit& u, int wr, int wc, int fr, int fq) const {
        const int col0 = u.pn * 256 + wc * 32 + 4 * fq;
        const int b = (u.pm * 256) / SEQ;
        const int odd = fq & 1;
        f32x4 gt[2][2];
#pragma unroll
        for (int bj = 0; bj < 2; ++bj)
#pragma unroll
            for (int n = 0; n < 2; ++n) gt[bj][n] = *(const f32x4*)(mod + b * 6144 + 2048 + col0 + bj * 128 + n * 16);
#pragma unroll
        for (int ai = 0; ai < 2; ++ai) {
            f32x4 xv[4][2][2];
#pragma unroll
            for (int m = 0; m < 4; ++m) { const size_t off = (size_t)(u.pm * 256 + ai * 128 + wr * 64 + m * 16 + fr) * D + col0;
#pragma unroll
                for (int bj = 0; bj < 2; ++bj)
#pragma unroll
                    for (int n = 0; n < 2; ++n) xv[m][bj][n] = *(const f32x4*)(x + off + bj * 128 + n * 16); }
#pragma unroll
            for (int m0 = 0; m0 < 4; m0 += 2) { u32x2 wv[2][2][2];
#pragma unroll
                for (int mm = 0; mm < 2; ++mm) { const int m = m0 + mm; const int r = ai * 128 + wr * 64 + m * 16 + fr; const float f = RS[r].y; float ss = 0.f;
#pragma unroll
                    for (int bj = 0; bj < 2; ++bj)
#pragma unroll
                        for (int n = 0; n < 2; ++n) {
                            const f32x4 o = xv[m][bj][n] + gt[bj][n] * (acc[ai][bj][m][n] * f);
                            wv[mm][bj][n] = (u32x2){cvt_pk_bf16(o[0], o[1]), cvt_pk_bf16(o[2], o[3])};
                            ss += (o[0] * o[0] + o[1] * o[1]) + (o[2] * o[2] + o[3] * o[3]); }
                    ss += __shfl_xor(ss, 16); ss += __shfl_xor(ss, 32);
                    if (fq == 0) SSQ1[(size_t)(u.pm * 256 + r) * 16 + u.pn * 4 + wc] = ss; }
                const int rs_ = ai * 128 + wr * 64 + (m0 + odd) * 16 + fr;
                bf16_t* rowp = X1 + (size_t)(u.pm * 256 + rs_) * D + u.pn * 256 + wc * 32 + 8 * (fq >> 1);
#pragma unroll
                for (int bj = 0; bj < 2; ++bj)
#pragma unroll
                    for (int n = 0; n < 2; ++n) {
                        const u32x2 snd = odd ? wv[0][bj][n] : wv[1][bj][n];
                        u32x2 rcv; rcv.x = xor16(snd.x, odd); rcv.y = xor16(snd.y, odd);
                        const u32x4 out = odd ? (u32x4){rcv.x, rcv.y, wv[1][bj][n].x, wv[1][bj][n].y} : (u32x4){wv[0][bj][n].x, wv[0][bj][n].y, rcv.x, rcv.y};
                        *(u32x4*)(rowp + bj * 128 + n * 16) = out; } } }
    }
};
__device__ __forceinline__ void p5_phase(Frame& F, const Args& a, const int bgslot0) {
    unsigned char* ws = F.ws;
    const bf16_t* X1 = (const bf16_t*)(ws + WS_X1);
    const float* mod = (const float*)(ws + WS_MOD);
    LAS unsigned char* XH = F.lds;
    LAS unsigned char* WH = F.lds + 65536;
    LAS unsigned char* WL = F.lds + 81920;
    LAS float* PARTB = (LAS float*)F.lds;
    LAS float* TAB = (LAS float*)(F.lds + TAB_OFF);
    LAS float* CST = TAB;
    LAS float* RSQ = TAB + 32;
    LAS int* LCNT = (LAS int*)(TAB + 96);
    LAS int* LBASE = (LAS int*)(TAB + 128);
    LAS float* LG = TAB + 160;
    const int tid = F.tid, lane = F.lane, w = F.wave;
    for (int tile = F.vcu; tile < T / 64; tile += F.G) {
        const int tok0 = tile * 64, b = tok0 / SEQ;
        const float* sh2 = mod + b * 6144 + 3072; const float* sc2 = mod + b * 6144 + 4096;
        const bf16_t* WRH = (const bf16_t*)(ws + WS_WRP) + (size_t)b * NE * 1024; const bf16_t* WRL = WRH + NB * NE * 1024;
        if (tid < 64) { const GAS f32x4* sp = (const GAS f32x4*)((const float*)(ws + WS_SSQ1) + (size_t)(tok0 + tid) * 16); const f32x4 t = (sp[0] + sp[1]) + (sp[2] + sp[3]);
            RSQ[tid] = rsqrtf(((t.x + t.y) + (t.z + t.w)) * (1.0f / D) + EPS); }
        if (tid < 32) { LCNT[tid] = 0; CST[tid] = ((const float*)(ws + WS_CSTB))[b * 32 + tid]; }
        u32x4 xall[4][4]; u32x4 wq[2][2]; const int l5 = lane & 31, lh = lane >> 5;
        LAS float* GGS = (LAS float*)(F.lds + 32768); LAS float* H0S = (LAS float*)(F.lds + 36864);
#define P5_LOADX(c_) do { _Pragma("unroll") for (int i = 0; i < 4; ++i) xall[c_][i] = *((const GAS u32x4*)(X1 + (size_t)(tok0 + w + 8 * (2 * i + lh)) * D + 256 * (c_)) + l5); } while (0)
#define P5_LOADW(c_) do { _Pragma("unroll") for (int j = 0; j < 2; ++j) { const int off_ = (tid >> 4) * 1024 + 256 * (c_) + 8 * ((tid & 15) + 16 * j); \
            wq[0][j] = *(const GAS u32x4*)(WRH + off_); wq[1][j] = *(const GAS u32x4*)(WRL + off_); } } while (0)
        P5_LOADX(0); P5_LOADW(0);
        { const f32x2 g = *((const GAS f32x2*)a.in[I_GFFN] + tid), sc = *((const GAS f32x2*)sc2 + tid), sh = *((const GAS f32x2*)sh2 + tid);
          P5_LOADX(1); P5_LOADX(2); P5_LOADX(3);
          *(LAS f32x2*)(GGS + 2 * tid) = g * (sc + 1.0f); *(LAS f32x2*)(H0S + 2 * tid) = sh; }
        __syncthreads();
        f32x16 acc = {};
#pragma unroll
        for (int c = 0; c < 4; ++c) {
            { const LAS f32x4* gp = (const LAS f32x4*)(GGS + 256 * c) + 2 * l5; const LAS f32x4* hp = (const LAS f32x4*)(H0S + 256 * c) + 2 * l5;
              const f32x4 gg0 = gp[0], gg1 = gp[1], h0 = hp[0], h1 = hp[1];
#pragma unroll
              for (int i = 0; i < 4; ++i) { const int tk = w + 8 * (2 * i + lh); const float rs = RSQ[tk]; const u32x4 x = xall[c][i];
                  const f32x4 xa = (f32x4){bflo(x.x), bfhi(x.x), bflo(x.y), bfhi(x.y)}, xb = (f32x4){bflo(x.z), bfhi(x.z), bflo(x.w), bfhi(x.w)};
                  const f32x4 ya = xa * rs * gg0 + h0, yb = xb * rs * gg1 + h1;
                  u32x2 o; o.x = 0u; o.y = 0u;
                  o.x = __builtin_amdgcn_cvt_pk_fp8_f32(ya.x, ya.y, o.x, false); o.x = __builtin_amdgcn_cvt_pk_fp8_f32(ya.z, ya.w, o.x, true);
                  o.y = __builtin_amdgcn_cvt_pk_fp8_f32(yb.x, yb.y, o.y, false); o.y = __builtin_amdgcn_cvt_pk_fp8_f32(yb.z, yb.w, o.y, true);
                  *(LAS u32x2*)(F.lds + 98304 + tk * 256 + (((l5 >> 1) ^ (tk & 15)) * 16) + (l5 & 1) * 8) = o;
                  *(LAS u32x4*)(XH + tk * 512 + ((l5 ^ (tk & 15)) * 16)) = x; }
#pragma unroll
              for (int j = 0; j < 2; ++j) { const int e = tid >> 4, ci = (tid & 15) + 16 * j; const int lo_ = e * 512 + ((ci ^ (e & 15)) * 16);
                  *(LAS u32x4*)(WH + lo_) = wq[0][j]; *(LAS u32x4*)(WL + lo_) = wq[1][j]; } }
            if (c + 1 < 4) P5_LOADW(c + 1);
            __syncthreads();
#pragma unroll
            for (int j = 0; j < 2; ++j) { const int tk = (tid >> 4) + 32 * j, ci = tid & 15;
                *(GAS u32x4*)(ws + WS_H + (size_t)(tok0 + tk) * D + 256 * c + 16 * ci) = *(const LAS u32x4*)(F.lds + 98304 + tk * 256 + ((ci ^ (tk & 15)) * 16)); }
            { const int tw = w >> 2, kq = w & 3, i = lane & 31, hf = lane >> 5;
              const int rowx = 32 * tw + i;
#pragma unroll
              for (int st = 0; st < 4; ++st) { const int ci = (64 * kq + 16 * st + 8 * hf) >> 3;
                  const bf16x8 xh = *(const LAS bf16x8*)(XH + rowx * 512 + ((ci ^ (rowx & 15)) * 16));
                  const bf16x8 wh = *(const LAS bf16x8*)(WH + i * 512 + ((ci ^ (i & 15)) * 16)), wl = *(const LAS bf16x8*)(WL + i * 512 + ((ci ^ (i & 15)) * 16));
                  acc = __builtin_amdgcn_mfma_f32_32x32x16_bf16(xh, wh, acc, 0, 0, 0);
                  acc = __builtin_amdgcn_mfma_f32_32x32x16_bf16(xh, wl, acc, 0, 0, 0); } }
            __syncthreads();
        }
#undef P5_LOADX
#undef P5_LOADW
        const bool has_bg = bgslot0 >= 0 && tile == F.vcu;
        const CvtItem bgd = p0_decode(a, ws, has_bg ? P0_NITEMS - 1 - (bgslot0 + F.bx * NWAVES + F.wave) : 0); f32x4 bgv[8];
        if (has_bg) p0_load_half(bgd, 1, lane, bgv);
        if (F.bx == 0 && tid < 64) ((GAS u32x4*)(ws + WS_H + (size_t)T * D))[tid] = (u32x4){0u, 0u, 0u, 0u};
        {
          LAS float* PART = PARTB + w * (32 * 33); const int e = lane & 31, hi = lane >> 5;
#pragma unroll
          for (int r = 0; r < 16; ++r) PART[crow(r, hi) * 33 + e] = acc[r]; }
        __syncthreads();
        {
          const int tk = tid >> 3, e0 = (tid & 7) * 4, tw = tk >> 5, tl = tk & 31; const float rs = RSQ[tk];
#pragma unroll
          for (int j = 0; j < 4; ++j) { float s = 0.f;
#pragma unroll
              for (int q = 0; q < 4; ++q) s += PARTB[(tw * 4 + q) * (32 * 33) + tl * 33 + e0 + j];
              LG[tk * 33 + e0 + j] = rs * s + CST[e0 + j]; } }
        __syncthreads();
        int eidx[4] = {0, 0, 0, 0}; int lpos[4] = {0, 0, 0, 0};
        if (tid < 64) {
            float val[4]; unsigned used = 0u;
#pragma unroll
            for (int k = 0; k < 4; ++k) { float best = -3.0e38f; int bi = 0;
#pragma unroll 8
                for (int j = 0; j < 32; ++j) { const float v = LG[tid * 33 + j]; if (!((used >> j) & 1u) && v > best) { best = v; bi = j; } }
                used |= 1u << bi; eidx[k] = bi; val[k] = best; }
            float ex[4], den = 0.f;
#pragma unroll
            for (int k = 0; k < 4; ++k) { ex[k] = __expf(val[k] - val[0]); den += ex[k]; }
            const float inv = 1.0f / den;
            *(f32x4*)((float*)(ws + WS_TOPG) + (size_t)(tok0 + tid) * 4) = (f32x4){ex[0] * inv, ex[1] * inv, ex[2] * inv, ex[3] * inv};
#pragma unroll
            for (int k = 0; k < 4; ++k) lpos[k] = __hip_atomic_fetch_add(LCNT + eidx[k], 1, __ATOMIC_RELAXED, __HIP_MEMORY_SCOPE_WORKGROUP);
        }
        __syncthreads();
        if (tid < 32) { const int c = LCNT[tid]; LBASE[tid] = c > 0 ? (int)__hip_atomic_fetch_add((unsigned*)(ws + WS_CTL) + CW_CNT + tid, (unsigned)c, RLX_AGENT) : 0; }
        __syncthreads();
        if (tid < 64) {
#pragma unroll
            for (int k = 0; k < 4; ++k) ((int*)(ws + WS_LIST))[eidx[k] * LISTCAP + LBASE[eidx[k]] + lpos[k]] = (tok0 + tid) * 4 + k;
        }
        if (has_bg) p0_store_half_f8(bgd, 1, lane, bgv);
        __syncthreads();
    }
}

struct GroupedOrder {
    const LAS int* TP; const LAS unsigned* TABR;
    const LAS int* UT;
    int ntiles, ntA, mixed, G, c, rowbytes; const char* Wgu; const char* Wdn; unsigned offH, offACT; const unsigned* rdy;
    __device__ __forceinline__ void set_b(pg8::Unit& u) const {
        u.bptr = (u.kind == 1) ? Wgu + (size_t)u.e * (2048 * 1024) + (size_t)u.pn * 256 * 1024 : Wdn + (size_t)u.e * (1024 * 1024) + (size_t)u.pn * 256 * 1024; }
    __device__ __forceinline__ void grp(int L, int nt_, int npn, pg8::Unit& u) const {
        const int nun = nt_ * npn; int wgid = L; { const int q = nun / 8, r = nun % 8, xcd = wgid % 8, off = wgid / 8; wgid = (xcd < r ? xcd * (q + 1) : r * (q + 1) + (xcd - r) * q) + off; }
        const int WGM = 8;
        const int nig = WGM * npn, gid = wgid / nig, fm = gid * WGM, gsz = (nt_ - fm) < WGM ? (nt_ - fm) : WGM;
        u.pm = fm + ((wgid % nig) % gsz); u.pn = (wgid % nig) / gsz; }
    __device__ __forceinline__ bool next(int i, pg8::Unit& u) const {
        if (UT) { if (i >= 10) return false; const int pm_ = __builtin_amdgcn_readfirstlane(UT[8 * i]), pn_ = __builtin_amdgcn_readfirstlane(UT[8 * i + 1]), e_ = __builtin_amdgcn_readfirstlane(UT[8 * i + 2]), ok_ = __builtin_amdgcn_readfirstlane(UT[8 * i + 3]);
            if (!ok_) return false; u.pm = pm_; u.pn = pn_; u.e = e_; u.li = i; u.kind = __builtin_amdgcn_readfirstlane(UT[8 * i + 4]); set_b(u); return true; }
        const long Ll = (long)i * G + c; const int R = ntiles - ntA;
        if (!mixed) { if (Ll >= (long)ntA * 8) return false; grp((int)Ll, ntA, 8, u); u.kind = 1; }
        else if (Ll < 8 * R) { u.pm = ntA + (int)Ll / 8; u.pn = (int)Ll % 8; u.kind = 1; }
        else if (Ll < 8 * R + 4 * (long)ntA) { grp((int)Ll - 8 * R, ntA, 4, u); u.kind = 2; }
        else if (Ll < 8 * R + 4 * (long)ntA + 4 * R) { const int L3 = (int)Ll - 8 * R - 4 * ntA; u.pm = ntA + L3 / 4; u.pn = L3 % 4; u.kind = 3; }
        else return false;
        u.li = i;
        int e = 0;
        for (int j = 1; j < NE; ++j) e += (TP[j] <= u.pm) ? 1 : 0;
        u.e = __builtin_amdgcn_readfirstlane(e);
        set_b(u);
        return true;
    }
    __device__ __forceinline__ unsigned a_off(const pg8::Unit& u, int r) const {
        if (u.kind == 1) return offH + TABR[u.li * 256 + r];
        return offACT + (unsigned)((u.pm * 256 + r) * rowbytes);
    }
    __device__ __forceinline__ void ready(const pg8::Unit& u) const {
        if (u.kind == 3) { const unsigned* p = rdy + (u.pm - ntA); unsigned spins = 0;
            while (__hip_atomic_load(p, RLX_AGENT) < 8u) { __builtin_amdgcn_s_sleep(2); if (++spins > (1u << 22)) break; }
            __builtin_amdgcn_fence(__ATOMIC_ACQUIRE, "agent"); asm volatile("s_waitcnt vmcnt(0)" ::: "memory"); }
    }
};

struct EpiSwiglu {
    static constexpr bool PERM = true, MIDK = false;
    unsigned char* ACT; const float* b_gu; LAS float* BIAS;
    __device__ __forceinline__ void mid(f32x4 (&acc)[2][2][4][2], const pg8::Unit& u, int wr, int wc, int fr, int fq) const {}
    __device__ __forceinline__ void prefetch(const pg8::Unit& u, int wid, int lane) const {
        if (wid == 0) { const float* g = b_gu + u.e * 2048 + u.pn * 128 + (lane & 31) * 4 + (lane >> 5) * 1024;
            __builtin_amdgcn_global_load_lds((const unsigned*)g, (LAS unsigned*)(BIAS + (u.li & 1) * 256), 16, 0, 0); }
    }
    __device__ __forceinline__ void operator()(const f32x4 (&acc)[2][2][4][2], const pg8::Unit& u, int wr, int wc, int fr, int fq) const {
        const int c0 = u.pn * 128 + wc * 32 + 8 * fq;
        const LAS float* bg = BIAS + (u.li & 1) * 256 + wc * 32 + 8 * fq;
        f32x2 bgate[2][2], bup1[2][2];
#pragma unroll
        for (int n = 0; n < 2; ++n) { const f32x4 g4 = *(const LAS f32x4*)(bg + 4 * n), u4 = *(const LAS f32x4*)(bg + 128 + 4 * n);
            bgate[n][0] = (f32x2){g4.x, g4.y}; bgate[n][1] = (f32x2){g4.z, g4.w}; bup1[n][0] = (f32x2){u4.x + 1.0f, u4.y + 1.0f}; bup1[n][1] = (f32x2){u4.z + 1.0f, u4.w + 1.0f}; }
        const int odd = fq & 1;
#pragma unroll
        for (int ai = 0; ai < 2; ++ai)
#pragma unroll
            for (int m0 = 0; m0 < 4; m0 += 2) {
                u32x2 wv[2];
#pragma unroll
                for (int mm = 0; mm < 2; ++mm) { const int m = m0 + mm; float o[8];
#pragma unroll
                    for (int n = 0; n < 2; ++n)
#pragma unroll
                        for (int h = 0; h < 2; ++h) {
                            const f32x2 ag = (f32x2){acc[ai][0][m][n][2 * h], acc[ai][0][m][n][2 * h + 1]}, au = (f32x2){acc[ai][1][m][n][2 * h], acc[ai][1][m][n][2 * h + 1]};
                            f32x2 gate = ag * WUNSCALE + bgate[n][h]; gate.x = fminf(gate.x, 7.0f); gate.y = fminf(gate.y, 7.0f);
                            f32x2 up1 = au * WUNSCALE + bup1[n][h]; up1.x = __builtin_amdgcn_fmed3f(up1.x, -6.0f, 8.0f); up1.y = __builtin_amdgcn_fmed3f(up1.y, -6.0f, 8.0f);
                            const f32x2 z = gate * (-1.702f * 1.4426950408889634f);
                            const f32x2 den = (f32x2){__builtin_amdgcn_exp2f(z.x), __builtin_amdgcn_exp2f(z.y)} + 1.0f;
                            const f32x2 r = (f32x2){__builtin_amdgcn_rcpf(den.x), __builtin_amdgcn_rcpf(den.y)};
                            const f32x2 ov = up1 * (gate * r);
                            o[4 * n + 2 * h] = ov.x; o[4 * n + 2 * h + 1] = ov.y; }
                    u32x2 w; w.x = 0u; w.y = 0u;
                    w.x = __builtin_amdgcn_cvt_pk_fp8_f32(o[0], o[1], w.x, false); w.x = __builtin_amdgcn_cvt_pk_fp8_f32(o[2], o[3], w.x, true);
                    w.y = __builtin_amdgcn_cvt_pk_fp8_f32(o[4], o[5], w.y, false); w.y = __builtin_amdgcn_cvt_pk_fp8_f32(o[6], o[7], w.y, true);
                    wv[mm] = w; }
                const u32x2 snd = odd ? wv[0] : wv[1];
                u32x2 rcv; rcv.x = xor16(snd.x, odd); rcv.y = xor16(snd.y, odd);
                const u32x4 out = odd ? (u32x4){rcv.x, rcv.y, wv[1].x, wv[1].y} : (u32x4){wv[0].x, wv[0].y, rcv.x, rcv.y};
                const int r = ai * 128 + wr * 64 + (m0 + odd) * 16 + fr;
                *(u32x4*)(ACT + (size_t)(u.pm * 256 + r) * 1024 + u.pn * 128 + wc * 32 + 16 * (fq >> 1)) = out; }
    }
};
struct EpiDown {
    static constexpr bool PERM = true, MIDK = false;
    unsigned char* YB; const float* b_dn; const LAS int* SLOT; LAS float* BIAS;
    __device__ __forceinline__ void mid(f32x4 (&acc)[2][2][4][2], const pg8::Unit& u, int wr, int wc, int fr, int fq) const {}
    __device__ __forceinline__ void prefetch(const pg8::Unit& u, int wid, int lane) const {
        if (wid == 0) { const float* g = b_dn + u.e * 1024 + u.pn * 256 + lane * 4;
            __builtin_amdgcn_global_load_lds((const unsigned*)g, (LAS unsigned*)(BIAS + (u.li & 1) * 256), 16, 0, 0); }
    }
    __device__ __forceinline__ void operator()(const f32x4 (&acc)[2][2][4][2], const pg8::Unit& u, int wr, int wc, int fr, int fq) const {
        const int col0 = u.pn * 256 + wc * 32 + 8 * fq;
        const LAS float* bd = BIAS + (u.li & 1) * 256 + wc * 32 + 8 * fq;
        f32x4 bv[2][2];
#pragma unroll
        for (int bj = 0; bj < 2; ++bj)
#pragma unroll
            for (int n = 0; n < 2; ++n) bv[bj][n] = *(const LAS f32x4*)(bd + bj * 128 + 4 * n);
        const int odd = fq & 1;
#pragma unroll
        for (int ai = 0; ai < 2; ++ai)
#pragma unroll
            for (int m0 = 0; m0 < 4; m0 += 2) {
                const int r = ai * 128 + wr * 64 + (m0 + odd) * 16 + fr;
                const int slot = SLOT[u.li * 256 + r];
                unsigned char* rowp = YB + (size_t)slot * 1024 + u.pn * 256 + wc * 32 + 16 * (fq >> 1);
#pragma unroll
                for (int bj = 0; bj < 2; ++bj) { u32x2 wv[2];
#pragma unroll
                    for (int mm = 0; mm < 2; ++mm) { const int m = m0 + mm;
                        const f32x4 v0 = acc[ai][bj][m][0] * WUNSCALE + bv[bj][0], v1 = acc[ai][bj][m][1] * WUNSCALE + bv[bj][1];
                        u32x2 w; w.x = 0u; w.y = 0u;
                        w.x = __builtin_amdgcn_cvt_pk_fp8_f32(v0[0], v0[1], w.x, false); w.x = __builtin_amdgcn_cvt_pk_fp8_f32(v0[2], v0[3], w.x, true);
                        w.y = __builtin_amdgcn_cvt_pk_fp8_f32(v1[0], v1[1], w.y, false); w.y = __builtin_amdgcn_cvt_pk_fp8_f32(v1[2], v1[3], w.y, true);
                        wv[mm] = w; }
                    const u32x2 snd = odd ? wv[0] : wv[1];
                    u32x2 rcv; rcv.x = xor16(snd.x, odd); rcv.y = xor16(snd.y, odd);
                    const u32x4 out = odd ? (u32x4){rcv.x, rcv.y, wv[1].x, wv[1].y} : (u32x4){wv[0].x, wv[0].y, rcv.x, rcv.y};
                    *(u32x4*)(rowp + bj * 128) = out; } }
    }
};

struct EpiMixed {
    static constexpr bool PERM = true, MIDK = false;
    EpiSwiglu e1; EpiDown e2; unsigned* rdy; int ntA;
    __device__ __forceinline__ void mid(f32x4 (&acc)[2][2][4][2], const pg8::Unit& u, int wr, int wc, int fr, int fq) const {}
    __device__ __forceinline__ void prefetch(const pg8::Unit& u, int wid, int lane) const { if (u.kind == 1) e1.prefetch(u, wid, lane); else e2.prefetch(u, wid, lane); }
    __device__ __forceinline__ void operator()(const f32x4 (&acc)[2][2][4][2], const pg8::Unit& u, int wr, int wc, int fr, int fq) const {
        if (u.kind == 1) {
            e1(acc, u, wr, wc, fr, fq);
            asm volatile("s_waitcnt vmcnt(0)" ::: "memory");
            __builtin_amdgcn_s_barrier();
            if (threadIdx.x == 0) { __builtin_amdgcn_fence(__ATOMIC_RELEASE, "agent"); asm volatile("s_waitcnt vmcnt(0)" ::: "memory");
                __hip_atomic_fetch_add(rdy + (u.pm - ntA), 1u, RLX_AGENT); }
        } else e2(acc, u, wr, wc, fr, fq);
    }
};

__device__ __forceinline__ void grouped_fill(Frame& F, GroupedOrder& S, int mode, int tabbase, unsigned offH, unsigned offACT) {
    LAS int* TP = (LAS int*)(F.lds + TAB_OFF);
    S.TP = TP; S.TABR = (const LAS unsigned*)(F.lds + TAB_OFF + tabbase); S.UT = nullptr;
    S.ntiles = __builtin_amdgcn_readfirstlane(TP[NE]);
    S.ntA = (F.G == 256 && S.ntiles >= 32) ? (S.ntiles & ~31) : S.ntiles;
    S.mixed = (mode == 2); S.G = F.G; S.c = F.bx; S.rowbytes = 1024;
    S.Wgu = (const char*)(F.ws + WS_WGU); S.Wdn = (const char*)(F.ws + WS_WDN); S.offH = offH; S.offACT = offACT;
    S.rdy = (const unsigned*)(F.ws + WS_CTL) + CW_RDY;
}
template <int MODE>
__device__ __forceinline__ void grouped_setup(Frame& F, GroupedOrder& S, int tabbase, bool have_tp, unsigned offH, unsigned offACT) {
    LAS int* TP = (LAS int*)(F.lds + TAB_OFF);
    LAS unsigned* TABR = (LAS unsigned*)(F.lds + TAB_OFF + tabbase);
    const unsigned* cnt = (const unsigned*)(F.ws + WS_CTL) + CW_CNT;
    if (!have_tp) {
        if (F.tid < 64) {
            const int c = (F.tid < NE) ? (int)__hip_atomic_load(cnt + (F.tid & 31), RLX_AGENT) : 0;
            const int nt_ = (c + 255) >> 8; int incl = nt_;
#pragma unroll
            for (int off = 1; off < 32; off <<= 1) { const int v = __shfl_up(incl, off); if ((F.tid & 63) >= off) incl += v; }
            if (F.tid < NE) TP[F.tid] = incl - nt_;
            if (F.tid == NE - 1) TP[NE] = incl; }
        __syncthreads();
    }
    grouped_fill(F, S, MODE, tabbase, offH, offACT);
    LAS int* UT = (LAS int*)(F.lds + TAB_OFF + tabbase + 10 * 1024);
    const int* LIST = (const int*)(F.ws + WS_LIST);
    { pg8::Unit u; int sl[10]; int kd[10];
#pragma unroll
      for (int li = 0; li < 10; ++li) { sl[li] = DUMP; kd[li] = 0;
          const bool ok = S.next(li, u);
          if (F.tid == 0) { UT[8 * li] = ok ? u.pm : 0; UT[8 * li + 1] = ok ? u.pn : 0; UT[8 * li + 2] = ok ? u.e : 0; UT[8 * li + 3] = ok ? 1 : 0; UT[8 * li + 4] = ok ? u.kind : 0; }
          if (ok) kd[li] = u.kind;
          if (ok && F.tid < 256) sl[li] = LIST[u.e * LISTCAP + (u.pm - TP[u.e]) * 256 + F.tid]; }
#pragma unroll
      for (int li = 0; li < 10; ++li) if (F.tid < 256) TABR[li * 256 + F.tid] = (kd[li] == 1) ? (unsigned)(sl[li] >> 2) * 1024u : (unsigned)sl[li]; }
    __syncthreads();
    S.UT = UT;
}
__device__ __forceinline__ void grouped_attach(Frame& F, GroupedOrder& S, int mode, int tabbase, unsigned offH, unsigned offACT) {
    grouped_fill(F, S, mode, tabbase, offH, offACT);
    S.UT = (const LAS int*)(F.lds + TAB_OFF + tabbase + 10 * 1024);
}

__device__ __forceinline__ void p8_phase(Frame& F, const Args& a) {
    const int gw0 = F.bx * NWAVES + F.wave, NGW0 = F.G * NWAVES, lane = F.lane;
    const bool blocked = (F.G == 256); constexpr int RPW = T / (256 * NWAVES);
    const int vw = F.vcu * NWAVES + F.wave;
    const int gw = blocked ? vw * RPW : gw0, NGW = blocked ? 1 : NGW0, mend = blocked ? (vw + 1) * RPW : T;
    const bf16_t* X1 = (const bf16_t*)(F.ws + WS_X1); const float* mod = (const float*)(F.ws + WS_MOD);
    const unsigned char* YB = F.ws + WS_YB; const float* TOPG = (const float*)(F.ws + WS_TOPG);
    LAS float* ROW = (LAS float*)(F.lds + F.wave * 4352);
    f32x4 gf[4], g2[4]; int bcur = -1;
#pragma unroll
    for (int j = 0; j < 4; ++j) gf[j] = *((const GAS f32x4*)a.in[I_GFIN] + lane + 64 * j);
    u32x2 xv[4], xn[4], xn2[4]; f32x4 gk = {0.f, 0.f, 0.f, 0.f}, gkn = {0.f, 0.f, 0.f, 0.f}, gkn2 = {0.f, 0.f, 0.f, 0.f}; u32x4 yv[4], yn[4], yn2[4];
#define P8_LOAD(m_, X, Y, G_) do { G_ = *(const f32x4*)(TOPG + (size_t)(m_) * 4); \
        _Pragma("unroll") for (int j = 0; j < 4; ++j) X[j] = *((const GAS u32x2*)(X1 + (size_t)(m_) * D) + lane + 64 * j); \
        _Pragma("unroll") for (int k = 0; k < 4; ++k) Y[k] = *((const GAS u32x4*)(YB + (size_t)((m_) * 4 + k) * D) + lane); } while (0)
    if (gw < mend) P8_LOAD(gw, xv, yv, gk);
    if (gw + NGW < mend) P8_LOAD(gw + NGW, xn, yn, gkn);
    for (int m = gw; m < mend; m += NGW) {
        const int b = m / SEQ, mn2 = m + 2 * NGW;
        if (mn2 < mend) P8_LOAD(mn2, xn2, yn2, gkn2);
        if (b != bcur) { bcur = b;
#pragma unroll
            for (int j = 0; j < 4; ++j) g2[j] = *((const GAS f32x4*)(mod + b * 6144 + 5120) + lane + 64 * j); }
        float s[16];
#pragma unroll
        for (int q = 0; q < 16; ++q) s[q] = 0.f;
#pragma unroll
        for (int k = 0; k < 4; ++k) { const unsigned yw[4] = {yv[k].x, yv[k].y, yv[k].z, yv[k].w};
#pragma unroll
            for (int q = 0; q < 4; ++q) { const f32x2 lo = __builtin_amdgcn_cvt_pk_f32_fp8(yw[q], false), hi = __builtin_amdgcn_cvt_pk_f32_fp8(yw[q], true);
                s[4 * q + 0] += gk[k] * lo.x; s[4 * q + 1] += gk[k] * lo.y; s[4 * q + 2] += gk[k] * hi.x; s[4 * q + 3] += gk[k] * hi.y; } }
#pragma unroll
        for (int q = 0; q < 16; ++q) ROW[lane * 17 + q] = s[q];
        LDS_WAIT(); asm volatile("" ::: "memory");
        f32x4 v[4]; float ss = 0.f;
#pragma unroll
        for (int j = 0; j < 4; ++j) { const int c = 4 * (lane + 64 * j); const LAS float* rp = ROW + (c >> 4) * 17 + (c & 15);
            const f32x4 sv = (f32x4){rp[0], rp[1], rp[2], rp[3]};
            v[j] = (f32x4){bflo(xv[j].x), bfhi(xv[j].x), bflo(xv[j].y), bfhi(xv[j].y)} + g2[j] * sv;
            ss += (v[j].x * v[j].x + v[j].y * v[j].y) + (v[j].z * v[j].z + v[j].w * v[j].w); }
        const float rs = rsqrtf(wave_sum(ss) * (1.f / D) + EPS);
        GAS f32x4* o = (GAS f32x4*)(a.out + (size_t)m * D) + lane;
#pragma unroll
        for (int j = 0; j < 4; ++j) __builtin_nontemporal_store(v[j] * rs * gf[j], o + 64 * j);
        LDS_WAIT(); asm volatile("" ::: "memory");
        gk = gkn; gkn = gkn2;
#pragma unroll
        for (int j = 0; j < 4; ++j) { xv[j] = xn[j]; yv[j] = yn[j]; xn[j] = xn2[j]; yn[j] = yn2[j]; }
    }
#undef P8_LOAD
}
__global__ void __launch_bounds__(NTHR, 2) mega_fwd(Args args) {
    extern __shared__ __attribute__((aligned(16))) unsigned char lds_raw[];
    Frame F;
    F.lds = (LAS unsigned char*)lds_raw;
    F.tid = threadIdx.x; F.lane = F.tid & 63; F.wave = __builtin_amdgcn_readfirstlane(F.tid >> 6);
    F.G = gridDim.x; F.bx = blockIdx.x; F.ws = args.ws;
    F.vcu = (F.G % 8 == 0) ? (F.bx % 8) * (F.G / 8) + F.bx / 8 : F.bx;
    volatile LAS unsigned* MISC = (volatile LAS unsigned*)(F.lds + LDSCTL_OFF);
    for (int u = F.tid; u < 128; u += NTHR) MISC[u] = 0u;
    __syncthreads();
    unsigned* ctl = (unsigned*)(args.ws + WS_CTL);
    XcdBarrier bar = xcd_barrier_post(ctl + CW_BAR, MISC + 8);
    const int lo = args.ph_lo, hi = args.ph_hi;
#define IN(k) (lo <= (k) && (k) < hi)
    constexpr int NBGB = 5;
    const bool bgbar = (lo == 0 && hi == 9) && (NBGB * 7 * F.G <= 32 * 8 * 32 + 7 * F.G);
    const bool attbg = bgbar && F.G == 256;
    const int nfg = bgbar ? P0_NITEMS - NBGB * 7 * F.G - (attbg ? 2 * NWAVES * F.G : 0) : P0_NITEMS;
#define SEAM(k) do { if (IN(k) && IN((k) + 1)) { if (bgbar && (k) <= NBGB) xcd_barrier_bg(bar, F, args, P0_NITEMS - 1 - ((NBGB - (k)) * 7 * F.G + F.bx * 7 + (F.wave - 1))); else xcd_barrier(bar); } } while (0)
    if (IN(0)) { p0_phase(F, args, nfg); }
    if (IN(1)) { p1_phase(F, args); } SEAM(1);
    if (IN(2)) {
        pg8::DenseOrder S; S.init(T, NCOL, D * 2, args.ws + WS_WIN, F.G, F.bx);
        EpiBf16 E{(bf16_t*)(args.ws + WS_P), NCOL};
        pg8::gemm_phase<EpiBf16, pg8::DenseOrder, true, false>(F.lds, (const char*)(args.ws + WS_H), D * 2, S, E);
        { pg8::Unit u1;
          const int nidle = 2 * F.G - S.nwg;
          if (nidle <= 0 || nidle > F.G) router_operands(F, args, F.bx, F.G);
          else if (!S.next(1, u1)) router_operands(F, args, F.bx - (F.G - nidle), nidle); }
    }
    LruPre lpre{}; bool have_lpre = false;
    if (IN(2) && IN(3) && F.vcu < 256) { __syncthreads(); lpre = lru_pre(F, args, F.vcu); have_lpre = true; }
    SEAM(2);
    if (IN(3)) {
        for (int it = F.vcu; it < 256; it += F.G) attn_item(F, args, it, (attbg && it == F.vcu) ? NBGB * 7 * F.G : -1);
        for (int it = F.vcu; it < 256; it += F.G) { if (!(have_lpre && it == F.vcu)) lpre = lru_pre(F, args, it); lru_item(F, args, it, lpre); }
    } SEAM(3);
    if (IN(4)) {
        pg8::DenseOrder S; S.init(T, D, D * 2, args.ws + WS_WOUT, F.G, F.bx);
        LAS f32x2* RS = (LAS f32x2*)(F.lds + TAB_OFF);
        pg8::Unit u0;
        if (S.next(0, u0)) {
            if (F.tid < 256) { const size_t tok = (size_t)u0.pm * 256 + F.tid;
                const GAS f32x4* sa = (const GAS f32x4*)((const float*)(args.ws + WS_SSQA) + tok * 8); const GAS f32x4* sl = (const GAS f32x4*)((const float*)(args.ws + WS_SSQL) + tok * 32);
                f32x4 va = sa[0] + sa[1], vl = sl[0];
#pragma unroll
                for (int i = 1; i < 8; ++i) vl += sl[i];
                const float ssa = (va.x + va.y) + (va.z + va.w), ssl = (vl.x + vl.y) + (vl.z + vl.w);
                const float ra = rsqrtf(ssa * (1.0f / 512) + EPS), rl = rsqrtf(ssl * (1.0f / 512) + EPS);
                RS[F.tid] = (f32x2){ra / rl, rl}; }
        }
        __syncthreads();
        EpiX1 E{args.in[I_X], (const float*)(args.ws + WS_MOD), (bf16_t*)(args.ws + WS_X1), (float*)(args.ws + WS_SSQ1), RS};
        pg8::gemm_phase<EpiX1, pg8::DenseOrder, false, false>(F.lds, (const char*)(args.ws + WS_MIX), D * 2, S, E);
    } SEAM(4);
    if (IN(5)) { p5_phase(F, args, attbg ? NBGB * 7 * F.G + NWAVES * F.G : -1); } SEAM(5);
    constexpr int TB1 = 256, TB2 = 256 + 17 * 1024;
    if (IN(6)) {
        GroupedOrder S; grouped_setup<1>(F, S, TB1, false, 0u, 0u);
        EpiSwiglu E{args.ws + WS_ACT, args.in[I_BGU], (LAS float*)(F.lds + BIAS_OFF)};
        pg8::gemm_phase<EpiSwiglu, GroupedOrder, true, true>(F.lds, (const char*)(args.ws + WS_H), D, S, E);
        if (IN(7)) { GroupedOrder S2; grouped_setup<2>(F, S2, TB2, true, (unsigned)WS_H, (unsigned)WS_ACT); }
    } SEAM(6);
    if (IN(7)) {
        GroupedOrder S;
        if (IN(6)) grouped_attach(F, S, 2, TB2, (unsigned)WS_H, (unsigned)WS_ACT);
        else grouped_setup<2>(F, S, TB2, false, (unsigned)WS_H, (unsigned)WS_ACT);
        EpiMixed E{EpiSwiglu{args.ws + WS_ACT, args.in[I_BGU], (LAS float*)(F.lds + BIAS_OFF)},
                   EpiDown{args.ws + WS_YB, args.in[I_BDN], (const LAS int*)(F.lds + TAB_OFF + TB2), (LAS float*)(F.lds + BIAS_OFF)}, ctl + CW_RDY, S.ntA};
        pg8::gemm_phase<EpiMixed, GroupedOrder, true, true>(F.lds, (const char*)args.ws, D, S, E);
    } SEAM(7);
    if (IN(8)) { p8_phase(F, args); }
#undef IN
#undef SEAM
}
}
extern "C" void kernel_launch(void* const* d_in, const int* in_sizes, int n_in, void* d_out, int out_size, void* d_ws, size_t ws_size,
                              hipStream_t stream) {
    static int grid = 0;
    if (grid == 0) {
        if (n_in != 25 || out_size != mk::T * mk::D || ws_size < mk::WS_END) { fprintf(stderr, "kernel_launch: unexpected problem shape (n_in %d out %d ws %zu)\n", n_in, out_size, ws_size); grid = -1; return; }
        int dev = 0, cus = 0, per_cu = 0;
        if (hipGetDevice(&dev) != hipSuccess || hipDeviceGetAttribute(&cus, hipDeviceAttributeMultiprocessorCount, dev) != hipSuccess) { grid = -1; return; }
        if (hipFuncSetAttribute((const void*)mk::mega_fwd, hipFuncAttributeMaxDynamicSharedMemorySize, mk::LDS_BYTES) != hipSuccess) { fprintf(stderr, "kernel_launch: hipFuncSetAttribute failed\n"); grid = -1; return; }
        if (hipOccupancyMaxActiveBlocksPerMultiprocessor(&per_cu, (const void*)mk::mega_fwd, mk::NTHR, mk::LDS_BYTES) != hipSuccess || per_cu < 1) { fprintf(stderr, "kernel_launch: occupancy query says %d workgroups per CU\n", per_cu); grid = -1; return; }
        grid = cus;
    }
    if (grid < 0) return;
    if (hipMemsetAsync((char*)d_ws + mk::WS_CTL, 0, mk::CTL_ZERO_BYTES, stream) != hipSuccess) return;
    mk::Args a{};
    for (int i = 0; i < 25; ++i) a.in[i] = (const float*)d_in[i];
    a.out = (float*)d_out; a.ws = (unsigned char*)d_ws; a.ph_lo = 0; a.ph_hi = 9;
    void* kargs[] = {&a};
    hipError_t le = hipLaunchCooperativeKernel((const void*)mk::mega_fwd, dim3(grid), dim3(mk::NTHR), kargs, mk::LDS_BYTES, stream);
    if (le != hipSuccess) fprintf(stderr, "kernel_launch: cooperative launch failed: %s (grid %d)\n", hipGetErrorString(le), grid);
}
```

```cpp
#include <hip/hip_runtime.h>
#include <stdint.h>
#include <stdio.h>
namespace mk {
#define LAS __attribute__((address_space(3)))
#define GAS __attribute__((address_space(1)))
typedef unsigned short bf16_t;
typedef short bf16x8 __attribute__((ext_vector_type(8)));
typedef short s16x4 __attribute__((ext_vector_type(4)));
typedef float f32x2 __attribute__((ext_vector_type(2)));
typedef float f32x4 __attribute__((ext_vector_type(4)));
typedef float f32x16 __attribute__((ext_vector_type(16)));
typedef unsigned u32x2 __attribute__((ext_vector_type(2)));
typedef unsigned u32x4 __attribute__((ext_vector_type(4)));

constexpr int NWAVES = 8, NTHR = 512;
constexpr int NB = 8, SEQ = 2048, D = 1024, T = NB * SEQ, NCOL = 1792, NE = 32;
constexpr int QOFF = 0, KOFF = 512, VOFF = 640, XROFF = 768, XGOFF = 1280;
constexpr int LISTCAP = 16384, DUMP = 65536, MAXTILES = 288;
constexpr float EPS = 1e-6f;
constexpr float WSCALE = 32.0f, WUNSCALE = 1.0f / 32.0f;

constexpr size_t MiB = 1u << 20;
constexpr size_t WS_CTL = 0, CTL_ZERO_BYTES = 64 * 1024;
constexpr int CW_CNT = 64;
constexpr int CW_RDY = 128;
constexpr int CW_MODCNT = 56;
constexpr int CW_BAR = 4096;
constexpr size_t WS_MOD = 1 * MiB;
constexpr size_t WS_CSTB = 1 * MiB + 256 * 1024;
constexpr size_t WS_TOPG = 2 * MiB;
constexpr size_t WS_WRP = 3 * MiB;
constexpr size_t WS_LIST = 4 * MiB;
constexpr size_t WS_SSQA = 6 * MiB;
constexpr size_t WS_SSQL = 7 * MiB;
constexpr size_t WS_SSQ1 = 9 * MiB;
constexpr size_t WS_WIN = 10 * MiB;
constexpr size_t WS_WOUT = 14 * MiB;
constexpr size_t WS_WGU = 16 * MiB;
constexpr size_t WS_WDN = 144 * MiB;
constexpr size_t WS_H = 208 * MiB;
constexpr size_t WS_P = 242 * MiB;
constexpr size_t WS_MIX = 298 * MiB;
constexpr size_t WS_X1 = 330 * MiB;
constexpr size_t WS_ACT = 394 * MiB;
constexpr size_t WS_YB = 538 * MiB;
constexpr size_t WS_END = 668 * MiB;

constexpr int RING_BYTES = 131072;
constexpr int LDSCTL_OFF = RING_BYTES;
constexpr int TAB_OFF = RING_BYTES + 512;
constexpr int BIAS_OFF = TAB_OFF + 256 + 14 * 1024;
constexpr int LDS_BYTES = 163840;

#define RLX_AGENT __ATOMIC_RELAXED, __HIP_MEMORY_SCOPE_AGENT
#define LDS_WAIT() asm volatile("s_waitcnt lgkmcnt(0)" ::: "memory")
#define VM_WAIT() asm volatile("s_waitcnt vmcnt(0)" ::: "memory")
__device__ __forceinline__ unsigned f2bf(float f) { unsigned u = __builtin_bit_cast(unsigned, f); return (u + 0x7fffu + ((u >> 16) & 1u)) >> 16; }
__device__ __forceinline__ unsigned pk2(float lo, float hi) { return f2bf(lo) | (f2bf(hi) << 16); }
__device__ __forceinline__ float bf2f(unsigned short h) { return __builtin_bit_cast(float, (unsigned)h << 16); }
__device__ __forceinline__ float bflo(unsigned w) { return __builtin_bit_cast(float, w << 16); }
__device__ __forceinline__ float bfhi(unsigned w) { return __builtin_bit_cast(float, w & 0xffff0000u); }
__device__ __forceinline__ unsigned cvt_pk_bf16(float lo, float hi) { unsigned r; asm volatile("v_cvt_pk_bf16_f32 %0, %1, %2" : "=v"(r) : "v"(lo), "v"(hi)); return r; }
__device__ __forceinline__ unsigned xor16(unsigned v, int odd_row) { const auto r = __builtin_amdgcn_permlane16_swap(v, v, false, false); return odd_row ? r[0] : r[1]; }
__device__ __forceinline__ unsigned xor32(unsigned v, int hi_half) { const auto r = __builtin_amdgcn_permlane32_swap(v, v, false, false); return hi_half ? r[0] : r[1]; }
__device__ __forceinline__ float xor16f(float v, int odd_row) { return __builtin_bit_cast(float, xor16(__builtin_bit_cast(unsigned, v), odd_row)); }
__device__ __forceinline__ float xor32f(float v, int hi_half) { return __builtin_bit_cast(float, xor32(__builtin_bit_cast(unsigned, v), hi_half)); }
__device__ __forceinline__ float wave_sum(float v) {
#pragma unroll
    for (int o = 1; o < 16; o <<= 1) v += __shfl_xor(v, o);
    const int l_ = (int)(threadIdx.x & 63);
    v += xor16f(v, (l_ >> 4) & 1); v += xor32f(v, l_ >> 5);
    return v;
}

#define XB_TMO      128
#define XB_XCNT(j)  (256  + 64 * (j))
#define XB_XSUB(j)  (1280 + 64 * (j))
#define XB_XGEN(j)  (2304 + 64 * (j))
#define XB_TOP      3328
#define XB_TOPGEN   3392
#define XCD_BAR_WORDS 3456
#define XB_SPIN_CAP (1u << 20)
__device__ __forceinline__ unsigned xb_ld(unsigned* p)              { return __hip_atomic_load(p, __ATOMIC_RELAXED, __HIP_MEMORY_SCOPE_AGENT); }
__device__ __forceinline__ unsigned xb_add(unsigned* p, unsigned v) { return __hip_atomic_fetch_add(p, v, __ATOMIC_RELAXED, __HIP_MEMORY_SCOPE_AGENT); }
__device__ __forceinline__ unsigned xb_xcc_id() { return (unsigned)__builtin_amdgcn_s_getreg((3 << 11) | 20) & 0xFu; }
#define XB_SPIN(cond, bar) do { unsigned _sp = 0; while (cond) { __builtin_amdgcn_s_sleep(1); \
    if ((++_sp & 255u) == 0u) { if (xb_ld(&(bar)[XB_TMO])) break; if (_sp > XB_SPIN_CAP) { atomicAdd(&(bar)[XB_TMO], 1u); break; } } } } while (0)
struct XcdBarrier { unsigned* bar; unsigned x; volatile LAS unsigned* st; };
__device__ __forceinline__ XcdBarrier xcd_barrier_post(unsigned* bar, volatile LAS unsigned* st) {
    XcdBarrier b; b.bar = bar; b.x = xb_xcc_id(); b.st = st;
    if (threadIdx.x == 0) (void)xb_add(&bar[XB_XCNT(b.x)], 1u);
    return b;
}
__device__ __forceinline__ void xcd_barrier_complete(unsigned* bar, unsigned x, unsigned& nloc, unsigned& nx) {
    const unsigned G = gridDim.x * gridDim.y * gridDim.z;
    unsigned sum, cnt, mine, sp = 0u;
    for (;;) {
        sum = 0u; cnt = 0u; mine = 0u;
#pragma unroll
        for (unsigned j = 0; j < 16; ++j) { const unsigned c = xb_ld(&bar[XB_XCNT(j)]); sum += c; cnt += (c > 0u) ? 1u : 0u; mine = (j == x) ? c : mine; }
        if (sum == G) break;
        __builtin_amdgcn_s_sleep(1);
        if ((++sp & 255u) == 0u) { if (xb_ld(&bar[XB_TMO])) break; if (sp > XB_SPIN_CAP) { atomicAdd(&bar[XB_TMO], 1u); break; } }
    }
    nloc = mine > 0u ? mine : 1u; nx = cnt > 0u ? cnt : 1u;
}
__device__ __forceinline__ void xcd_barrier(const XcdBarrier& b) {
    asm volatile("s_waitcnt vmcnt(0)" ::: "memory");
    __syncthreads();
    if (threadIdx.x == 0) {
        unsigned* bar = b.bar;
        __builtin_amdgcn_s_waitcnt(0);
        unsigned nloc = b.st[0], nx = b.st[1];
        if (nloc == 0u) { xcd_barrier_complete(bar, b.x, nloc, nx); b.st[0] = nloc; b.st[1] = nx; }
        const unsigned old = xb_add(&bar[XB_XSUB(b.x)], 1u);
        const unsigned gen = old / nloc;
        if (old + 1u == (gen + 1u) * nloc) {
            __builtin_amdgcn_fence(__ATOMIC_RELEASE, "agent");
            asm volatile("s_waitcnt vmcnt(0)" ::: "memory");
            const unsigned og = xb_add(&bar[XB_TOP], 1u);
            const unsigned tg = og / nx;
            if (og + 1u == (tg + 1u) * nx) xb_add(&bar[XB_TOPGEN], 1u);
            else XB_SPIN(xb_ld(&bar[XB_TOPGEN]) == tg, bar);
            __builtin_amdgcn_fence(__ATOMIC_ACQUIRE, "agent");
            xb_add(&bar[XB_XGEN(b.x)], 1u);
            asm volatile("s_waitcnt vmcnt(0)" ::: "memory");
        } else {
            XB_SPIN(xb_ld(&bar[XB_XGEN(b.x)]) == gen, bar);
            __builtin_amdgcn_fence(__ATOMIC_ACQUIRE, "agent");
            asm volatile("s_waitcnt vmcnt(0)" ::: "memory");
        }
    }
    __syncthreads();
}

namespace pg8 {
constexpr int BM = 256, BK = 64, HALF = 128, HTB = HALF * BK * 2, STAGE_BYTES = 8 * HTB, NXCD = 8;
__device__ __forceinline__ int lds_byte(int r, int c) { const int st = (r >> 4) * 2 + (c >> 5), rr = r & 15, cc = c & 31, ob = rr * 64 + cc * 2; return st * 1024 + (ob ^ (((ob >> 9) & 1) << 5)); }
__device__ __forceinline__ void stage_rc(int b, int& R, int& C) { const int st = b / 1024, sb = b % 1024, swz = sb ^ (((sb >> 9) & 1) << 5); R = (st >> 1) * 16 + swz / 64; C = (st & 1) * 32 + (swz % 64) / 2; }
__device__ __forceinline__ int perm32(int rho) { const int n = rho >> 4, i = rho & 15; return 8 * (i >> 2) + 4 * n + (i & 3); }

struct Unit { int pm, pn, e, li, kind; const char* bptr; };
typedef int v8i_t __attribute__((ext_vector_type(8)));
typedef int v4i_t __attribute__((ext_vector_type(4)));
__device__ __forceinline__ const char* uniform_ptr(const char* p) { const unsigned long long v = (unsigned long long)p;
    const unsigned lo = __builtin_amdgcn_readfirstlane((unsigned)v), hi = __builtin_amdgcn_readfirstlane((unsigned)(v >> 32)); return (const char*)(((unsigned long long)hi << 32) | lo); }
__device__ __forceinline__ v8i_t cat8(bf16x8 lo, bf16x8 hi) { const v4i_t a = __builtin_bit_cast(v4i_t, lo), b = __builtin_bit_cast(v4i_t, hi); return __builtin_shufflevector(a, b, 0, 1, 2, 3, 4, 5, 6, 7); }

template <class Epi, class Sched, bool ALIGN_EPI, bool F8>
__device__ __forceinline__ void gemm_phase(LAS unsigned char* lds, const char* Abase, const int rowbytes, const Sched& S, const Epi& E) {
    const int tid = threadIdx.x, wid = __builtin_amdgcn_readfirstlane(tid >> 6), lane = tid & 63, wr = wid >> 2, wc = wid & 3, fr = lane & 15, fq = lane >> 4;
    const int nt = rowbytes / 128;
    unsigned voffB[2];
#pragma unroll
    for (int i = 0; i < 2; ++i) { int R, C; stage_rc(tid * 16 + i * 8192, R, C); const int Rb = Epi::PERM ? ((R & ~31) + perm32(R & 31)) : R;
        voffB[i] = (unsigned)(Rb * rowbytes + C * 2); }
#define PG8_AOFF(dst, unit) do { _Pragma("unroll") for (int _i = 0; _i < 2; ++_i) { int R, C; stage_rc(tid * 16 + _i * 8192, R, C); \
        dst[0][_i] = S.a_off(unit, R) + (unsigned)(C * 2); dst[1][_i] = S.a_off(unit, HALF + R) + (unsigned)(C * 2); } } while (0)
    const size_t kstep = (size_t)(BK * 2);
    const size_t hstepB = (size_t)HALF * rowbytes;
    const unsigned ldsw = (unsigned)wid * 1024u;
    const int aoff = lds_byte(wr * 64 + fr, fq * 8), boff = lds_byte(wc * 32 + fr, fq * 8);
#define PG8_SA(b, h) (((b) * 2 + (h)) * HTB)
#define PG8_SB(b, h) ((4 + (b) * 2 + (h)) * HTB)
#define PG8_STAGE_B(bufoff, gbase) do { const char* _gb = (const char*)(gbase); asm volatile("" : "+s"(_gb)); _Pragma("unroll") for (int _i = 0; _i < 2; ++_i) { \
        unsigned _o = voffB[_i]; asm volatile("" : "+v"(_o)); \
        __builtin_amdgcn_global_load_lds((const unsigned*)(_gb + _o), (LAS unsigned*)(lds + (bufoff) + ldsw + _i * 8192), 16, 0, 0); } } while (0)
#define PG8_STAGE_A(bufoff, OFF, h, kb) do { const char* _ab = Abase + (size_t)(kb); asm volatile("" : "+s"(_ab)); _Pragma("unroll") for (int _i = 0; _i < 2; ++_i) { \
        unsigned _o = (OFF)[h][_i]; asm volatile("" : "+v"(_o)); \
        __builtin_amdgcn_global_load_lds((const unsigned*)(_ab + _o), (LAS unsigned*)(lds + (bufoff) + ldsw + _i * 8192), 16, 0, 0); } } while (0)
#define PG8_LDA(dst, b, h) do { _Pragma("unroll") for (int m = 0; m < 4; ++m) _Pragma("unroll") for (int k = 0; k < 2; ++k) dst[m][k] = *(const LAS bf16x8*)(lds + PG8_SA(b, h) + aoff + m * 2048 + k * 1024); } while (0)
#define PG8_LDB(dst, b, h) do { _Pragma("unroll") for (int n = 0; n < 2; ++n) _Pragma("unroll") for (int k = 0; k < 2; ++k) dst[n][k] = *(const LAS bf16x8*)(lds + PG8_SB(b, h) + boff + n * 2048 + k * 1024); } while (0)
#define PG8_MMA(ai, bj, At, Bt) do { __builtin_amdgcn_s_setprio(1); _Pragma("unroll") for (int m = 0; m < 4; ++m) _Pragma("unroll") for (int n = 0; n < 2; ++n) { \
        if constexpr (F8) { acc[ai][bj][m][n] = __builtin_amdgcn_mfma_scale_f32_16x16x128_f8f6f4(cat8(Bt[n][0], Bt[n][1]), cat8(At[m][0], At[m][1]), acc[ai][bj][m][n], 0, 0, 0, 0x7f7f7f7f, 0, 0x7f7f7f7f); } \
        else { _Pragma("unroll") for (int k = 0; k < 2; ++k) acc[ai][bj][m][n] = __builtin_amdgcn_mfma_f32_16x16x32_bf16(Bt[n][k], At[m][k], acc[ai][bj][m][n], 0, 0, 0); } } \
        __builtin_amdgcn_s_setprio(0); } while (0)
#define PG8_WAIT_V(n) asm volatile("s_waitcnt vmcnt(" #n ")" ::: "memory")
#define PG8_WAIT_L(n) asm volatile("s_waitcnt lgkmcnt(" #n ")" ::: "memory")
#define PG8_BAR __builtin_amdgcn_s_barrier()
#define PG8_SCHED __builtin_amdgcn_sched_barrier(0)
    Unit cur, nxt; int ui = 0;
    if (!S.next(0, cur)) return;
    S.ready(cur);
    f32x4 acc[2][2][4][2];
#pragma unroll
    for (int a = 0; a < 2; ++a)
#pragma unroll
        for (int b = 0; b < 2; ++b)
#pragma unroll
            for (int m = 0; m < 4; ++m)
#pragma unroll
                for (int n = 0; n < 2; ++n) acc[a][b][m][n] = (f32x4){0.f, 0.f, 0.f, 0.f};
    bf16x8 At[4][2], B0[2][2], B1[2][2];
    unsigned aC[2][2];
    PG8_AOFF(aC, cur);
    const char* cB = uniform_ptr(cur.bptr);
    E.prefetch(cur, wid, lane);
    PG8_STAGE_B(PG8_SB(0, 0), cB); PG8_STAGE_B(PG8_SB(0, 1), cB + hstepB); PG8_STAGE_A(PG8_SA(0, 0), aC, 0, 0); PG8_STAGE_A(PG8_SA(0, 1), aC, 1, 0);
    if (wr == 1) PG8_BAR;
    PG8_WAIT_V(2); PG8_BAR;
    PG8_STAGE_B(PG8_SB(1, 0), cB + kstep); PG8_STAGE_A(PG8_SA(1, 0), aC, 0, kstep); PG8_STAGE_B(PG8_SB(1, 1), cB + hstepB + kstep);
    PG8_WAIT_V(6); PG8_BAR;
    for (;;) {
        bool has_next = false; const char* nB = cB;
#pragma unroll 1
        for (int t = 0; t < nt; t += 2) {
            const bool last = (t == nt - 2);
            const size_t k1 = (size_t)(t + 1) * kstep;
            const size_t k2 = last ? 0 : (size_t)(t + 2) * kstep, k3 = k2 + kstep;
            if constexpr (Epi::MIDK) { if (t == nt / 2) { int fr_ = fr; asm volatile("" : "+v"(fr_)); E.mid(acc, cur, wr, wc, fr_, fq); } }
            PG8_LDB(B0, 0, 0); PG8_LDB(B1, 0, 1); PG8_SCHED; PG8_LDA(At, 0, 0); PG8_STAGE_A(PG8_SA(1, 1), aC, 1, k1);
            if (last) {
                has_next = S.next(ui + 1, nxt);
                if (has_next) { S.ready(nxt); nB = uniform_ptr(nxt.bptr); PG8_AOFF(aC, nxt); E.prefetch(nxt, wid, lane); }
            }
            const char* b2 = last ? nB : cB + (size_t)(t + 2) * kstep; const char* b3 = b2 + kstep;
            PG8_WAIT_V(8); PG8_WAIT_L(0); PG8_BAR; PG8_MMA(0, 0, At, B0); PG8_MMA(0, 1, At, B1); PG8_BAR; PG8_SCHED;
            PG8_LDA(At, 0, 1); PG8_STAGE_B(PG8_SB(0, 0), b2); PG8_STAGE_B(PG8_SB(0, 1), b2 + hstepB); PG8_STAGE_A(PG8_SA(0, 0), aC, 0, k2);
            PG8_WAIT_V(8); PG8_WAIT_L(0); PG8_BAR; PG8_MMA(1, 0, At, B0); PG8_MMA(1, 1, At, B1); PG8_BAR; PG8_SCHED;
            PG8_LDB(B0, 1, 0); PG8_LDB(B1, 1, 1); PG8_SCHED; PG8_LDA(At, 1, 0); PG8_STAGE_A(PG8_SA(0, 1), aC, 1, k2);
            PG8_WAIT_V(8); PG8_WAIT_L(0); PG8_BAR; PG8_MMA(0, 0, At, B0); PG8_MMA(0, 1, At, B1); PG8_BAR; PG8_SCHED;
            PG8_LDA(At, 1, 1); PG8_STAGE_B(PG8_SB(1, 0), b3); PG8_STAGE_B(PG8_SB(1, 1), b3 + hstepB); PG8_STAGE_A(PG8_SA(1, 0), aC, 0, k3);
            PG8_WAIT_V(8); PG8_WAIT_L(0); PG8_BAR; PG8_MMA(1, 0, At, B0); PG8_MMA(1, 1, At, B1); PG8_BAR; PG8_SCHED;
        }
        if constexpr (ALIGN_EPI) { if (wr == 0) PG8_BAR; }
        { int fr_ = fr, fq_ = fq; asm volatile("" : "+v"(fr_), "+v"(fq_));
          E(acc, cur, wr, wc, fr_, fq_); }
        if (!has_next) break;
#pragma unroll
        for (int a = 0; a < 2; ++a)
#pragma unroll
            for (int b = 0; b < 2; ++b)
#pragma unroll
                for (int m = 0; m < 4; ++m)
#pragma unroll
                    for (int n = 0; n < 2; ++n) acc[a][b][m][n] = (f32x4){0.f, 0.f, 0.f, 0.f};
        cur = nxt; cB = nB; ++ui;
        if constexpr (ALIGN_EPI) { if (wr == 1) PG8_BAR; }
    }
    PG8_WAIT_V(0);
    if constexpr (!ALIGN_EPI) { if (wr == 0) PG8_BAR; }
    PG8_BAR;
#undef PG8_AOFF
#undef PG8_SA
#undef PG8_SB
#undef PG8_STAGE_A
#undef PG8_STAGE_B
#undef PG8_LDA
#undef PG8_LDB
#undef PG8_MMA
#undef PG8_WAIT_V
#undef PG8_WAIT_L
#undef PG8_BAR
#undef PG8_SCHED
}

struct DenseOrder {
    int nM, nN, nwg, G, c, rowbytes; const char* Bt;
    __device__ void init(int M, int N, int rowbytes_, const void* Bt_, int G_, int c_) { nM = M / BM; nN = N / BM; nwg = nM * nN; G = G_; c = c_; rowbytes = rowbytes_; Bt = (const char*)Bt_; }
    __device__ __forceinline__ bool next(int i, Unit& u) const {
        const long L = (long)i * G + c; if (L >= nwg) return false;
        int wgid = (int)L; { const int q = nwg / NXCD, r = nwg % NXCD, xcd = wgid % NXCD, off = wgid / NXCD; wgid = (xcd < r ? xcd * (q + 1) : r * (q + 1) + (xcd - r) * q) + off; }
        const int WGM = 8;
        const int nig = WGM * nN, gid = wgid / nig, fm = gid * WGM, gsz = (nM - fm) < WGM ? (nM - fm) : WGM;
        u.pm = fm + ((wgid % nig) % gsz); u.pn = (wgid % nig) / gsz; u.e = 0; u.li = i; u.kind = 0;
        u.bptr = Bt + (size_t)u.pn * BM * rowbytes;
        return true;
    }
    __device__ __forceinline__ unsigned a_off(const Unit& u, int r) const { return (unsigned)((u.pm * BM + r) * rowbytes); }
    __device__ __forceinline__ void ready(const Unit& u) const {}
};
}
struct Args { const float* in[25]; float* out; unsigned char* ws; int ph_lo, ph_hi; };
enum { I_X = 0, I_C, I_WADA, I_BADA, I_GMIX, I_WIN, I_CONVW, I_CONVB, I_WRGA, I_BRGA, I_WRGX, I_BRGX, I_LAM, I_SINKS, I_GATT, I_GLRU, I_WOUT, I_GFFN,
       I_WR, I_BR, I_WGU, I_BGU, I_WDN, I_BDN, I_GFIN };

struct Frame {
    LAS unsigned char* lds;
    int tid, lane, wave, G, bx, vcu;
    unsigned char* ws;
};

struct CvtItem { const float* src; unsigned char* dst; const float* ks; int N; int f8; };
__device__ __forceinline__ CvtItem p0_decode(const Args& a, unsigned char* ws, int it) {
    constexpr int I_IN = 8 * 56, I_OUT = 8 * 32, I_GU = 32 * 8 * 64;
    CvtItem d; int r = it; d.ks = nullptr; d.f8 = 0;
    if (r < I_IN) { const int kb = r / 56, nb = r % 56; d.N = 1792; d.src = a.in[I_WIN] + (size_t)kb * 128 * 1792 + nb * 32; d.dst = ws + WS_WIN + ((size_t)nb * 32 * 1024 + kb * 128) * 2; return d; } r -= I_IN;
    if (r < I_OUT) { const int kb = r / 32, nb = r % 32; d.N = 1024; d.src = a.in[I_WOUT] + (size_t)kb * 128 * 1024 + nb * 32; d.dst = ws + WS_WOUT + ((size_t)nb * 32 * 1024 + kb * 128) * 2;
        d.ks = ((kb < 4) ? a.in[I_GATT] : (a.in[I_GLRU] - 512)) + kb * 128; return d; } r -= I_OUT;
    if (r < I_GU) { const int e = r / 512, q = r % 512, kb = q / 64, nb = q % 64, n0 = nb * 32;
        const int drow = ((n0 & 1023) >> 7) * 256 + (n0 >> 10) * 128 + (n0 & 127);
        d.N = 2048; d.src = a.in[I_WGU] + (size_t)e * 1024 * 2048 + (size_t)kb * 128 * 2048 + n0; d.dst = ws + WS_WGU + ((size_t)e * 2048 + drow) * 1024 + kb * 128; d.f8 = 1; return d; } r -= I_GU;
    { const int e = r / 256, q = r % 256, kb = q / 32, nb = q % 32;
      d.N = 1024; d.src = a.in[I_WDN] + (size_t)e * 1024 * 1024 + (size_t)kb * 128 * 1024 + nb * 32; d.dst = ws + WS_WDN + ((size_t)e * 1024 + nb * 32) * 1024 + kb * 128; d.f8 = 1; return d; }
}
__device__ __forceinline__ void p0_load(const CvtItem& d, int lane, f32x4 (&v)[16]) {
    const float* p = d.src + (size_t)(16 * (lane >> 3)) * d.N + (lane & 7) * 4;
#pragma unroll
    for (int i = 0; i < 16; ++i) v[i] = __builtin_nontemporal_load((const f32x4*)(p + (size_t)i * d.N));
}

constexpr int P0_NITEMS = 8 * 56 + 8 * 32 + 32 * 8 * 32 + 32 * 8 * 64;
template <class ItemAt>
__device__ __forceinline__ void p0_convert(Frame& F, const Args& a, const ItemAt& item_at) {
    unsigned char* ws = F.ws; const int lane = F.lane, r8 = lane >> 3, l7 = lane & 7;
    int seq = 0;
    f32x4 v[16];
    int it = item_at(0);
    CvtItem d = p0_decode(a, ws, it < 0 ? 0 : it);
    if (it >= 0) p0_load(d, lane, v);
    while (it >= 0) {
        u32x4 o[4][2];
        if (d.f8) {
#pragma unroll
            for (int c = 0; c < 4; ++c) { unsigned w[4];
#pragma unroll
                for (int q = 0; q < 4; ++q) { unsigned x = 0u;
                    x = __builtin_amdgcn_cvt_pk_fp8_f32(v[4 * q + 0][c] * WSCALE, v[4 * q + 1][c] * WSCALE, x, false);
                    x = __builtin_amdgcn_cvt_pk_fp8_f32(v[4 * q + 2][c] * WSCALE, v[4 * q + 3][c] * WSCALE, x, true); w[q] = x; }
                o[c][0] = (u32x4){w[0], w[1], w[2], w[3]}; o[c][1] = o[c][0]; }
        } else {
            float ks[16];
#pragma unroll
            for (int i = 0; i < 16; ++i) ks[i] = d.ks ? d.ks[16 * r8 + i] : 1.0f;
#pragma unroll
            for (int c = 0; c < 4; ++c)
#pragma unroll
                for (int h = 0; h < 2; ++h) { u32x4 t;
                    t.x = pk2(v[8 * h + 0][c] * ks[8 * h + 0], v[8 * h + 1][c] * ks[8 * h + 1]); t.y = pk2(v[8 * h + 2][c] * ks[8 * h + 2], v[8 * h + 3][c] * ks[8 * h + 3]);
                    t.z = pk2(v[8 * h + 4][c] * ks[8 * h + 4], v[8 * h + 5][c] * ks[8 * h + 5]); t.w = pk2(v[8 * h + 6][c] * ks[8 * h + 6], v[8 * h + 7][c] * ks[8 * h + 7]);
                    o[c][h] = t; }
        }
        ++seq; const int itn = item_at(seq);
        const CvtItem dn = p0_decode(a, ws, itn < 0 ? 0 : itn);
        if (itn >= 0) p0_load(dn, lane, v);
        if (d.f8) {
#pragma unroll
            for (int c = 0; c < 4; ++c) __builtin_nontemporal_store(o[c][0], (GAS u32x4*)(d.dst + (size_t)(4 * l7 + c) * 1024 + 16 * r8));
        } else {
#pragma unroll
            for (int c = 0; c < 4; ++c) { GAS u32x4* q = (GAS u32x4*)(d.dst + ((size_t)(4 * l7 + c) * 1024 + 16 * r8) * 2); q[0] = o[c][0]; q[1] = o[c][1]; }
        }
        d = dn; it = itn;
    }
}

__device__ __forceinline__ void p0_store_f8(const CvtItem& d, int lane, const f32x4 (&v)[16]) {
    const int r8 = lane >> 3, l7 = lane & 7;
#pragma unroll
    for (int c = 0; c < 4; ++c) { unsigned w[4];
#pragma unroll
        for (int q = 0; q < 4; ++q) { unsigned x = 0u;
            x = __builtin_amdgcn_cvt_pk_fp8_f32(v[4 * q + 0][c] * WSCALE, v[4 * q + 1][c] * WSCALE, x, false);
            x = __builtin_amdgcn_cvt_pk_fp8_f32(v[4 * q + 2][c] * WSCALE, v[4 * q + 3][c] * WSCALE, x, true); w[q] = x; }
        __builtin_nontemporal_store((u32x4){w[0], w[1], w[2], w[3]}, (GAS u32x4*)(d.dst + (size_t)(4 * l7 + c) * 1024 + 16 * r8)); }
}
__device__ __forceinline__ void p0_load_half(const CvtItem& d, int h, int lane, f32x4 (&v)[8]) {
    const float* p = d.src + (size_t)(64 * h + 8 * (lane >> 3)) * d.N + (lane & 7) * 4;
#pragma unroll
    for (int i = 0; i < 8; ++i) v[i] = __builtin_nontemporal_load((const f32x4*)(p + (size_t)i * d.N));
}
__device__ __forceinline__ void p0_store_half_f8(const CvtItem& d, int h, int lane, const f32x4 (&v)[8]) {
    const int r8 = lane >> 3, l7 = lane & 7;
#pragma unroll
    for (int c = 0; c < 4; ++c) { unsigned w[2];
#pragma unroll
        for (int q = 0; q < 2; ++q) { unsigned x = 0u;
            x = __builtin_amdgcn_cvt_pk_fp8_f32(v[4 * q + 0][c] * WSCALE, v[4 * q + 1][c] * WSCALE, x, false);
            x = __builtin_amdgcn_cvt_pk_fp8_f32(v[4 * q + 2][c] * WSCALE, v[4 * q + 3][c] * WSCALE, x, true); w[q] = x; }
        __builtin_nontemporal_store((u32x2){w[0], w[1]}, (GAS u32x2*)(d.dst + (size_t)(4 * l7 + c) * 1024 + 64 * h + 8 * r8)); }
}
__device__ __forceinline__ void xcd_barrier_bg(const XcdBarrier& b, Frame& F, const Args& a, const int item) {
    asm volatile("s_waitcnt vmcnt(0)" ::: "memory");
    __syncthreads();
    const bool has = (item >= 0) && (F.wave != 0);
    const CvtItem d = p0_decode(a, F.ws, has ? item : 0); f32x4 v[16];
    if (has) p0_load(d, F.lane, v);
    if (threadIdx.x == 0) {
        unsigned* bar = b.bar;
        __builtin_amdgcn_s_waitcnt(0);
        unsigned nloc = b.st[0], nx = b.st[1];
        if (nloc == 0u) { xcd_barrier_complete(bar, b.x, nloc, nx); b.st[0] = nloc; b.st[1] = nx; }
        const unsigned old = xb_add(&bar[XB_XSUB(b.x)], 1u);
        const unsigned gen = old / nloc;
        if (old + 1u == (gen + 1u) * nloc) {
            __builtin_amdgcn_fence(__ATOMIC_RELEASE, "agent");
            asm volatile("s_waitcnt vmcnt(0)" ::: "memory");
            const unsigned og = xb_add(&bar[XB_TOP], 1u);
            const unsigned tg = og / nx;
            if (og + 1u == (tg + 1u) * nx) xb_add(&bar[XB_TOPGEN], 1u);
            else XB_SPIN(xb_ld(&bar[XB_TOPGEN]) == tg, bar);
            __builtin_amdgcn_fence(__ATOMIC_ACQUIRE, "agent");
            xb_add(&bar[XB_XGEN(b.x)], 1u);
            asm volatile("s_waitcnt vmcnt(0)" ::: "memory");
        } else {
            XB_SPIN(xb_ld(&bar[XB_XGEN(b.x)]) == gen, bar);
            __builtin_amdgcn_fence(__ATOMIC_ACQUIRE, "agent");
            asm volatile("s_waitcnt vmcnt(0)" ::: "memory");
        }
    }
    __syncthreads();
    if (has) p0_store_f8(d, F.lane, v);
}

__device__ __forceinline__ void p0_phase(Frame& F, const Args& a, const int nfg) {
    unsigned char* ws = F.ws;
    if (F.bx < 192) {
        LAS float* cs = (LAS float*)F.lds;
        LAS float* red = (LAS float*)(F.lds + 32768);
        const float* c = a.in[I_C];
#pragma unroll
        for (int i = 0; i < 4; ++i) ((LAS f32x4*)cs)[F.tid + NTHR * i] = ((const GAS f32x4*)c)[F.tid + NTHR * i];
        __syncthreads();
        const int j0 = F.bx * 32;
        { const int c4 = (F.tid & 7) * 4, kg = F.tid >> 3;
          const float* w = a.in[I_WADA] + j0 + c4;
          f32x4 acc[8];
#pragma unroll
          for (int b = 0; b < 8; ++b) acc[b] = (f32x4){0.f, 0.f, 0.f, 0.f};
#pragma unroll
          for (int i = 0; i < 16; ++i) { const int k = kg + 64 * i; const f32x4 wv = *(const GAS f32x4*)(w + (size_t)k * 6144);
#pragma unroll
              for (int b = 0; b < 8; ++b) acc[b] += wv * cs[b * 1024 + k]; }
          LAS float* red4 = (LAS float*)(F.lds + 32768);
#pragma unroll
          for (int b = 0; b < 8; ++b) *(LAS f32x4*)(red4 + (kg * 8 + b) * 32 + c4) = acc[b]; }
        __syncthreads();
        if (F.tid < 256) { const int b = F.tid >> 5, col = F.tid & 31; float s = a.in[I_BADA][j0 + col];
            const LAS float* red4 = (const LAS float*)(F.lds + 32768);
#pragma unroll 16
            for (int g = 0; g < 64; ++g) s += red4[(g * 8 + b) * 32 + col];
            ((float*)(ws + WS_MOD))[b * 6144 + j0 + col] = s; }
        asm volatile("s_waitcnt vmcnt(0)" ::: "memory");
        __syncthreads();
        if (F.tid == 0) { __builtin_amdgcn_fence(__ATOMIC_RELEASE, "agent"); asm volatile("s_waitcnt vmcnt(0)" ::: "memory");
            __hip_atomic_fetch_add((unsigned*)(ws + WS_CTL) + CW_MODCNT, 1u, RLX_AGENT); }
    }
    { u32x4* L = (u32x4*)(ws + WS_LIST); const int n4 = NE * LISTCAP / 4; const unsigned dv = (unsigned)DUMP;
      for (int i = F.bx * NTHR + F.tid; i < n4; i += F.G * NTHR) L[i] = (u32x4){dv, dv, dv, dv};
    }
    const int gw = F.bx * NWAVES + F.wave, NGW = F.G * NWAVES;
    const int NBASE = nfg / NGW;
    const int nstrided = NBASE * NGW;
    const int xw = gw - 128 * NWAVES, NXW = NGW - 128 * NWAVES;
    p0_convert(F, a, [&](int q) -> int { if (q < NBASE) return gw + NGW * q;
        if (xw < 0 || NXW <= 0) { const int it = nstrided + gw + NGW * (q - NBASE); return (NXW <= 0 && it < nfg) ? it : -1; }
        const int it = nstrided + xw + NXW * (q - NBASE); return it < nfg ? it : -1; });
}

__device__ __forceinline__ void router_operands(Frame& F, const Args& a, int bi, int nblk) {
    const float* mod = (const float*)(F.ws + WS_MOD);
    bf16_t* WRH = (bf16_t*)(F.ws + WS_WRP); bf16_t* WRL = WRH + NB * NE * 1024;
    for (int idx = bi * NTHR + F.tid; idx < NB * NE * 1024; idx += nblk * NTHR) { const int b = idx >> 15, e = (idx >> 10) & 31, k = idx & 1023;
        const float v = a.in[I_GFFN][k] * (1.0f + mod[b * 6144 + 4096 + k]) * a.in[I_WR][k * 32 + e];
        const unsigned h = f2bf(v); WRH[idx] = (bf16_t)h; WRL[idx] = (bf16_t)f2bf(v - bf2f((unsigned short)h)); }
    for (int o = bi * NWAVES + F.wave; o < NB * NE; o += nblk * NWAVES) { const int b = o >> 5, e = o & 31; float s = 0.f;
#pragma unroll
        for (int j = 0; j < 16; ++j) { const int k = F.lane + 64 * j; s += mod[b * 6144 + 3072 + k] * a.in[I_WR][k * 32 + e]; }
        s = wave_sum(s);
        if (F.lane == 0) ((float*)(F.ws + WS_CSTB))[o] = s + a.in[I_BR][e]; }
}

__device__ __forceinline__ void p1_phase(Frame& F, const Args& a) {
    const int nw = F.G;
    const int gw = F.bx * NWAVES + F.wave, NGW = nw * NWAVES;
    const int vw = F.vcu * NWAVES + F.wave;
    constexpr int RPW = T / (256 * NWAVES);
    const float* mod = (const float*)(F.ws + WS_MOD);
    if (F.tid == 0) { unsigned* mc = (unsigned*)(F.ws + WS_CTL) + CW_MODCNT; unsigned spins = 0;
        while (__hip_atomic_load(mc, RLX_AGENT) < 192u) { __builtin_amdgcn_s_sleep(4); if (++spins > (1u << 20)) break; }
        __builtin_amdgcn_fence(__ATOMIC_ACQUIRE, "agent"); asm volatile("s_waitcnt vmcnt(0)" ::: "memory"); }
    __syncthreads();
    const int wv = (nw % 8 == 0 && F.G % 8 == 0) ? ((F.bx % 8) * (nw / 8) + F.bx / 8) * NWAVES + F.wave : gw;
    const bool blocked = (F.G == 256 && nw == 256);
    const int m0 = blocked ? vw * RPW : (int)(((long)wv * T) / NGW), mstep = 1, mend = blocked ? (vw + 1) * RPW : (int)(((long)(wv + 1) * T) / NGW);
    f32x4 gm[2][2], sh[2][2]; int bcur = -1;
    for (int mb = m0; mb < mend; mb += 4 * mstep) {
        f32x4 v[4][2][2];
#pragma unroll
        for (int q = 0; q < 4; ++q) { const int m = mb + q * mstep;
            if (m < mend) {
#pragma unroll
                for (int j = 0; j < 2; ++j)
#pragma unroll
                    for (int h = 0; h < 2; ++h) v[q][j][h] = *((const GAS f32x4*)(a.in[I_X] + (size_t)m * D + 512 * j) + 2 * F.lane + h); } }
#pragma unroll
        for (int q = 0; q < 4; ++q) { const int m = mb + q * mstep;
            if (m < mend) {
                const int b = m / SEQ;
                if (b != bcur) { bcur = b;
#pragma unroll
                    for (int j = 0; j < 2; ++j)
#pragma unroll
                        for (int h = 0; h < 2; ++h) { const int c4 = 128 * j + 2 * F.lane + h;
                            gm[j][h] = ((const GAS f32x4*)a.in[I_GMIX])[c4] * (((const GAS f32x4*)(mod + b * 6144 + 1024))[c4] + 1.0f);
                            sh[j][h] = ((const GAS f32x4*)(mod + b * 6144))[c4]; } }
                float s = 0.f;
#pragma unroll
                for (int j = 0; j < 2; ++j)
#pragma unroll
                    for (int h = 0; h < 2; ++h) { const f32x4 t = v[q][j][h]; s += (t.x * t.x + t.y * t.y) + (t.z * t.z + t.w * t.w); }
                const float rs = rsqrtf(wave_sum(s) * (1.f / D) + EPS);
                GAS u32x4* o16 = (GAS u32x4*)((bf16_t*)(F.ws + WS_H) + (size_t)m * D) + F.lane;
#pragma unroll
                for (int j = 0; j < 2; ++j) { const f32x4 y0 = v[q][j][0] * rs * gm[j][0] + sh[j][0], y1 = v[q][j][1] * rs * gm[j][1] + sh[j][1];
                    u32x4 w; w.x = pk2(y0.x, y0.y); w.y = pk2(y0.z, y0.w); w.z = pk2(y1.x, y1.y); w.w = pk2(y1.z, y1.w); o16[64 * j] = w; } } }
    }
}

struct EpiBf16 {
    static constexpr bool PERM = true, MIDK = false;
    bf16_t* O; int ldc;
    __device__ __forceinline__ void operator()(const f32x4 (&acc)[2][2][4][2], const pg8::Unit& u, int wr, int wc, int fr, int fq) const {
        const int row0 = u.pm * 256 + wr * 64 + fr, col0 = u.pn * 256 + wc * 32 + 8 * fq;
#pragma unroll
        for (int ai = 0; ai < 2; ++ai)
#pragma unroll
            for (int m = 0; m < 4; ++m) { bf16_t* rowp = O + (size_t)(row0 + ai * 128 + m * 16) * ldc + col0;
#pragma unroll
                for (int bj = 0; bj < 2; ++bj) { const f32x4 v0 = acc[ai][bj][m][0], v1 = acc[ai][bj][m][1];
                    u32x4 w; w.x = cvt_pk_bf16(v0[0], v0[1]); w.y = cvt_pk_bf16(v0[2], v0[3]); w.z = cvt_pk_bf16(v1[0], v1[1]); w.w = cvt_pk_bf16(v1[2], v1[3]);
                    *(u32x4*)(rowp + bj * 128) = w; } }
    }
    __device__ __forceinline__ void mid(f32x4 (&acc)[2][2][4][2], const pg8::Unit& u, int wr, int wc, int fr, int fq) const {}
    __device__ __forceinline__ void prefetch(const pg8::Unit& u, int wid, int lane) const {}
};
__device__ __forceinline__ int crow(int r, int hi) { return (r & 3) + 8 * (r >> 2) + 4 * hi; }
__device__ __forceinline__ s16x4 vtr(const LAS unsigned char* p) {
    typedef short v4i16_t __attribute__((ext_vector_type(4)));
    return __builtin_bit_cast(s16x4, __builtin_amdgcn_ds_read_tr16_b64_v4i16((LAS v4i16_t*)p));
}

__device__ __forceinline__ void attn_item(Frame& F, const Args& a, int item, const int bgslot) {
    const int b = item >> 5, n = (item >> 1) & 15, j = item & 1;
    const bf16_t* P = (const bf16_t*)(F.ws + WS_P);
    LAS unsigned char* Kl = F.lds;
    LAS unsigned char* Vl = F.lds + 32768;
    LAS unsigned char* ost = F.lds + 65536 + F.wave * 4608;
    LAS float* wsf = (LAS float*)(ost + 4096);
    const int lane = F.lane, ql = lane & 31, hi = lane >> 5;
    const CvtItem bgd2 = p0_decode(a, F.ws, bgslot >= 0 ? P0_NITEMS - 1 - (bgslot + F.G * NWAVES + F.bx * NWAVES + F.wave) : 0); f32x4 bgv2[8];
    if (bgslot >= 0) p0_load_half(bgd2, 0, lane, bgv2);
    {
        const int row = F.tid >> 1, half = F.tid & 1;
        int tb = 128 * (n - 1) + row; if (tb < 0) tb += 128;
        const bf16_t* src = P + (size_t)(b * SEQ + tb) * NCOL + 64 * j;
#pragma unroll
        for (int i = 0; i < 4; ++i) { const int c = half * 4 + i;
            const u32x4 kv = *(const GAS u32x4*)(src + KOFF + 8 * c);
            const u32x4 vv = *(const GAS u32x4*)(src + VOFF + 8 * c);
            *(LAS u32x4*)(Kl + row * 128 + ((c ^ (row & 7)) * 16)) = kv;
            *(LAS u32x4*)(Vl + row * 128 + c * 16) = vv; }
    }
    __syncthreads();
    if (bgslot >= 0) p0_store_half_f8(bgd2, 0, lane, bgv2);
    const int g = F.wave >> 1, qh = F.wave & 1, h = 4 * j + g;
    const float sink = a.in[I_SINKS][h];
    constexpr float L2E = 1.4426950408889634f, C1 = 0.125f * 1.4426950408889634f;
    const bool has_bg = bgslot >= 0;
    const CvtItem bgd = p0_decode(a, F.ws, has_bg ? P0_NITEMS - 1 - (bgslot + F.bx * NWAVES + F.wave) : 0);
    for (int qb = 0; qb < 2; ++qb) {
        f32x4 bgv[8];
        if (has_bg) p0_load_half(bgd, qb, lane, bgv);
        const int o = 64 * qh + 32 * qb;
        const int tq0 = b * SEQ + 128 * n + o;
        bf16x8 qr[4];
#pragma unroll
        for (int d0 = 0; d0 < 4; ++d0) qr[d0] = *(const GAS bf16x8*)(P + (size_t)(tq0 + ql) * NCOL + QOFF + 64 * h + 16 * d0 + 8 * hi);
        f32x16 S[5];
#pragma unroll
        for (int kt = 0; kt < 5; ++kt) {
            const int key = o + 32 * kt + ql;
            f32x16 acc = {};
#pragma unroll
            for (int d0 = 0; d0 < 4; ++d0) { const int c = 2 * d0 + hi;
                const bf16x8 kf = *(const LAS bf16x8*)(Kl + key * 128 + ((c ^ (key & 7)) * 16));
                acc = __builtin_amdgcn_mfma_f32_32x32x16_bf16(kf, qr[d0], acc, 0, 0, 0); }
            S[kt] = acc;
        }
        constexpr float NEG = -1.0e30f;
#pragma unroll
        for (int r = 0; r < 16; ++r) { const int cr = crow(r, hi);
            if (!(cr > ql)) S[0][r] = NEG;
            if (!(cr <= ql)) S[4][r] = NEG; }
        if (n == 0) {
#pragma unroll
            for (int kt = 0; kt < 4; ++kt)
#pragma unroll
                for (int r = 0; r < 16; ++r) if (o + 32 * kt + crow(r, hi) < 128) S[kt][r] = NEG;
        }
        float mx = NEG;
#pragma unroll
        for (int kt = 0; kt < 5; ++kt)
#pragma unroll
            for (int r = 0; r < 16; ++r) mx = fmaxf(mx, S[kt][r]);
        mx = fmaxf(mx, xor32f(mx, hi));
        const float m = fmaxf(mx * 0.125f, sink);
        const float mb = m * L2E;
        float l = 0.f;
#pragma unroll
        for (int kt = 0; kt < 5; ++kt)
#pragma unroll
            for (int r = 0; r < 16; ++r) { const float p = __builtin_amdgcn_exp2f(S[kt][r] * C1 - mb); S[kt][r] = p; l += p; }
        l += xor32f(l, hi);
        l += __builtin_amdgcn_exp2f((sink - m) * L2E);
        if (hi == 0) wsf[ql] = 1.0f / l;
        f32x16 O0 = {}, O1 = {};
        const int gi = (lane >> 4) & 1, li = lane & 15;
        const LAS unsigned char* vb = Vl + (o + 4 * hi + (li >> 2)) * 128 + (16 * gi + 4 * (li & 3)) * 2;
#pragma unroll
        for (int kt = 0; kt < 5; ++kt)
#pragma unroll
            for (int s = 0; s < 2; ++s) {
                bf16x8 pa;
                { const f32x16& X = S[kt];
                  const unsigned w0 = cvt_pk_bf16(X[8 * s + 0], X[8 * s + 1]), w1 = cvt_pk_bf16(X[8 * s + 2], X[8 * s + 3]);
                  const unsigned w2 = cvt_pk_bf16(X[8 * s + 4], X[8 * s + 5]), w3 = cvt_pk_bf16(X[8 * s + 6], X[8 * s + 7]);
                  pa = __builtin_bit_cast(bf16x8, (u32x4){w0, w1, w2, w3}); }
                const LAS unsigned char* vp = vb + (32 * kt + 16 * s) * 128;
                const s16x4 lo0 = vtr(vp), hi0 = vtr(vp + 8 * 128);
                const s16x4 lo1 = vtr(vp + 64), hi1 = vtr(vp + 8 * 128 + 64);
                const bf16x8 v0 = (bf16x8){lo0[0], lo0[1], lo0[2], lo0[3], hi0[0], hi0[1], hi0[2], hi0[3]};
                const bf16x8 v1 = (bf16x8){lo1[0], lo1[1], lo1[2], lo1[3], hi1[0], hi1[1], hi1[2], hi1[3]};
                O0 = __builtin_amdgcn_mfma_f32_32x32x16_bf16(pa, v0, O0, 0, 0, 0);
                O1 = __builtin_amdgcn_mfma_f32_32x32x16_bf16(pa, v1, O1, 0, 0, 0);
            }
        LDS_WAIT(); asm volatile("" ::: "memory");
#pragma unroll
        for (int r = 0; r < 16; ++r) { const int q = crow(r, hi); const float il = wsf[q];
            *(LAS unsigned short*)(ost + q * 128 + ql * 2) = (unsigned short)f2bf(O0[r] * il);
            *(LAS unsigned short*)(ost + q * 128 + (32 + ql) * 2) = (unsigned short)f2bf(O1[r] * il); }
        LDS_WAIT(); asm volatile("" ::: "memory");
        bf16_t* MIXp = (bf16_t*)(F.ws + WS_MIX);
        float* SSQA = (float*)(F.ws + WS_SSQA);
#pragma unroll
        for (int i = 0; i < 4; ++i) { const int id = lane + 64 * i, row = id >> 3, ch = id & 7;
            const u32x4 w = *(const LAS u32x4*)(ost + row * 128 + ch * 16);
            *(GAS u32x4*)(MIXp + (size_t)(tq0 + row) * D + 64 * h + 8 * ch) = w;
            float ss = bflo(w.x) * bflo(w.x) + bfhi(w.x) * bfhi(w.x) + bflo(w.y) * bflo(w.y) + bfhi(w.y) * bfhi(w.y)
                     + bflo(w.z) * bflo(w.z) + bfhi(w.z) * bfhi(w.z) + bflo(w.w) * bflo(w.w) + bfhi(w.w) * bfhi(w.w);
            ss += __shfl_xor(ss, 1); ss += __shfl_xor(ss, 2); ss += __shfl_xor(ss, 4);
            if (ch == 0) SSQA[(size_t)(tq0 + row) * 8 + h] = ss; }
        LDS_WAIT(); asm volatile("" ::: "memory");
        if (has_bg) p0_store_half_f8(bgd, qb, lane, bgv);
    }
    __syncthreads();
}

struct LruPre { float ba, bx, cwf[4], cbf, lg8; };
constexpr int LRU_WB_OFF = 106496;
__device__ __forceinline__ LruPre lru_pre(Frame& F, const Args& a, int item) {
    const int hb = (item >> 2) & 7, qt = item & 3;
    const int c0 = hb * 64 + qt * 16;
    constexpr int XR_BYTES = 33280; constexpr int XGP = 264;
    const int tid = F.tid, lane = F.lane, w = F.wave;
    const int ch = lane & 15, kq = lane >> 4;
    LruPre pre;
    LAS u32x4* WB = (LAS u32x4*)(F.lds + LRU_WB_OFF);
    float ba, bx;
    {
      LAS float* WA = (LAS float*)(F.lds + XR_BYTES);
      LAS float* WX = WA + 4096;
      LAS float* CW = (LAS float*)(F.lds + 2 * XR_BYTES + 3 * 16 * XGP * 2 + 2 * 1024);
      { const GAS f32x4* ga = (const GAS f32x4*)(a.in[I_WRGA] + (size_t)hb * 4096); const GAS f32x4* gx = (const GAS f32x4*)(a.in[I_WRGX] + (size_t)hb * 4096);
#pragma unroll
        for (int i = 0; i < 2; ++i) { ((LAS f32x4*)WA)[tid + NTHR * i] = ga[tid + NTHR * i]; ((LAS f32x4*)WX)[tid + NTHR * i] = gx[tid + NTHR * i]; }
        if (tid < 320) CW[tid] = (tid < 256) ? a.in[I_CONVW][(tid >> 6) * 512 + hb * 64 + (tid & 63)] : a.in[I_CONVB][hb * 64 + (tid & 63)]; }
      __syncthreads();
      const int col = qt * 16 + ch;
      float sa = 0.f, sx = 0.f;
#pragma unroll 8
      for (int i = 0; i < 64; ++i) { const float cbv = CW[256 + i]; sa += cbv * WA[i * 64 + col]; sx += cbv * WX[i * 64 + col]; }
      ba = a.in[I_BRGA][c0 + ch] + sa; bx = a.in[I_BRGX][c0 + ch] + sx;
      if (w == 0) {
#pragma unroll 1
          for (int f = 0; f < 16; ++f) { const int k = f >> 2, mat = (f >> 1) & 1, ks = f & 1; const LAS float* Wm = mat ? WX : WA; unsigned pw[4];
#pragma unroll
              for (int jj = 0; jj < 4; ++jj) { const int i = 32 * ks + 8 * kq + 2 * jj;
                  pw[jj] = pk2(CW[k * 64 + i] * Wm[i * 64 + col], CW[k * 64 + i + 1] * Wm[(i + 1) * 64 + col]); }
              WB[f * 64 + lane] = (u32x4){pw[0], pw[1], pw[2], pw[3]}; } } }
    float cwf[4];
#pragma unroll
    for (int k = 0; k < 4; ++k) cwf[k] = a.in[I_CONVW][k * 512 + c0 + ch];
    const float cbf = a.in[I_CONVB][c0 + ch];
    const float lg8 = -8.0f * log1pf(expf(-a.in[I_LAM][c0 + ch]));
    pre.ba = ba; pre.bx = bx; pre.cbf = cbf; pre.lg8 = lg8;
#pragma unroll
    for (int k = 0; k < 4; ++k) pre.cwf[k] = cwf[k];
    __syncthreads();
    return pre;
}

__device__ __forceinline__ void lru_item(Frame& F, const Args& a, int item, const LruPre& pre, const int bgslot0, const int bgtiles) {
    const int b = item >> 5, hb = (item >> 2) & 7, qt = item & 3;
    const int c0 = hb * 64 + qt * 16;
    const bf16_t* P = (const bf16_t*)(F.ws + WS_P);
    constexpr int XR_BYTES = 33280;
    constexpr int XGP = 264;
    LAS unsigned char* XR0 = F.lds;
    LAS unsigned short* XG0 = (LAS unsigned short*)(F.lds + 2 * XR_BYTES);
    LAS float* AGG0 = (LAS float*)(F.lds + 2 * XR_BYTES + 3 * 16 * XGP * 2);
    LAS unsigned char* OST = F.lds + 2 * XR_BYTES + 3 * 16 * XGP * 2 + 2 * 1024 + F.wave * 1024;
    const int tid = F.tid, lane = F.lane, w = F.wave;
    const int ch = lane & 15, kq = lane >> 4;
    const int cg = tid & 7, tg = tid >> 3;
    u32x4 rin[4], rhalo, rxg;
#define LRU_LOAD_TILE(tile_) do { const int t0_ = (tile_) * 256; \
        _Pragma("unroll") for (int j = 0; j < 4; ++j) rin[j] = *(const GAS u32x4*)(P + ((size_t)b * SEQ + t0_ + 4 * tg + j) * NCOL + XROFF + hb * 64 + 8 * cg); \
        { const int hp_ = t0_ - 3 + ((tid >> 3) % 3); unsigned hm_ = hp_ >= 0 ? 0xffffffffu : 0u; asm volatile("" : "+v"(hm_));     \
            rhalo = *(const GAS u32x4*)(P + ((size_t)b * SEQ + (hp_ >= 0 ? hp_ : 0)) * NCOL + XROFF + hb * 64 + 8 * cg); \
            rhalo.x &= hm_; rhalo.y &= hm_; rhalo.z &= hm_; rhalo.w &= hm_; } \
        rxg = *(const GAS u32x4*)(P + ((size_t)b * SEQ + t0_ + (tid >> 1)) * NCOL + XGOFF + c0 + 8 * (tid & 1)); } while (0)
#define LRU_STAGE_TILE(tile_) do { LAS unsigned char* XR_ = XR0 + ((tile_) & 1) * XR_BYTES; LAS unsigned short* XG_ = XG0 + ((tile_) % 3) * (16 * XGP); \
        _Pragma("unroll") for (int j = 0; j < 4; ++j) { const int r_ = 3 + 4 * tg + j; *(LAS u32x4*)(XR_ + r_ * 128 + ((cg ^ (r_ & 7)) * 16)) = rin[j]; } \
        if (tid < 24) { const int r_ = tid >> 3; *(LAS u32x4*)(XR_ + r_ * 128 + ((cg ^ (r_ & 7)) * 16)) = rhalo; } \
        { const int tk_ = tid >> 1, hf_ = tid & 1; const unsigned xw_[4] = {rxg.x, rxg.y, rxg.z, rxg.w}; \
          _Pragma("unroll") for (int e = 0; e < 8; ++e) XG_[(hf_ * 8 + e) * XGP + tk_] = (unsigned short)((e & 1) ? (xw_[e >> 1] >> 16) : (xw_[e >> 1] & 0xffffu)); } } while (0)
    LRU_LOAD_TILE(0);
    LAS u32x4* WB = (LAS u32x4*)(F.lds + LRU_WB_OFF);
    const float ba = pre.ba, bx = pre.bx, cbf = pre.cbf, lg8 = pre.lg8;
    const float cwf[4] = {pre.cwf[0], pre.cwf[1], pre.cwf[2], pre.cwf[3]};
    float htile = 0.f;
    bf16_t* MIXp = (bf16_t*)(F.ws + WS_MIX);
    float* SSQL = (float*)(F.ws + WS_SSQL);
    LRU_STAGE_TILE(0);
    LRU_LOAD_TILE(1);
    __syncthreads();
#define LRU_WBF(f_) __builtin_bit_cast(bf16x8, *(const LAS u32x4*)(F.lds + wbo + (f_) * 1024))
    for (int tile = 0; tile < 8; ++tile) {
        const bool has_bg = tile < bgtiles;
        const CvtItem bgd = p0_decode(a, F.ws, has_bg ? P0_NITEMS - 1 - (bgslot0 + (tile >> 1) * (F.G * NWAVES) + F.bx * NWAVES + F.wave) : 0); f32x4 bgv[8];
        if (has_bg) p0_load_half(bgd, tile & 1, lane, bgv);
        const LAS unsigned char* XR = XR0 + (tile & 1) * XR_BYTES;
        const LAS unsigned short* XG = XG0 + (tile % 3) * (16 * XGP);
        LAS float* AGG = AGG0 + (tile & 1) * 256;
        const size_t tokbase = (size_t)b * SEQ + tile * 256;
        float hloc[2][4], pcum[2][4];
        float Aw = 1.f, Hw = 0.f;
#pragma unroll
        for (int mt = 0; mt < 2; ++mt) {
            const int R0 = 32 * w + 16 * mt;
            f32x4 accR = {0.f, 0.f, 0.f, 0.f}, accI = {0.f, 0.f, 0.f, 0.f};
            unsigned wbo = LRU_WB_OFF + lane * 16; asm volatile("" : "+v"(wbo));
#pragma unroll
            for (int k = 0; k < 4; ++k) { const int r = R0 + ch + k;
#pragma unroll
                for (int ks = 0; ks < 2; ++ks) { const int c = 4 * ks + kq;
                    const bf16x8 af = *(const LAS bf16x8*)(XR + r * 128 + ((c ^ (r & 7)) * 16));
                    accR = __builtin_amdgcn_mfma_f32_16x16x32_bf16(af, LRU_WBF((k * 2 + 0) * 2 + ks), accR, 0, 0, 0);
                    accI = __builtin_amdgcn_mfma_f32_16x16x32_bf16(af, LRU_WBF((k * 2 + 1) * 2 + ks), accI, 0, 0, 0); } }
            const int tl0 = R0 + 4 * kq;
            float xr7[7];
#pragma unroll
            for (int q = 0; q < 7; ++q) { const int r = tl0 + q; const int cc = (qt * 2 + (ch >> 3)) ^ (r & 7);
                xr7[q] = bf2f(*(const LAS unsigned short*)(XR + r * 128 + cc * 16 + (ch & 7) * 2)); }
            float av[4], uv[4];
#pragma unroll
            for (int r = 0; r < 4; ++r) {
                const float xc = cbf + cwf[0] * xr7[r] + cwf[1] * xr7[r + 1] + cwf[2] * xr7[r + 2] + cwf[3] * xr7[r + 3];
                const float rg = __builtin_amdgcn_rcpf(1.0f + __expf(-(accR[r] + ba)));
                const float ig = __builtin_amdgcn_rcpf(1.0f + __expf(-(accI[r] + bx)));
                const float aa = __expf(rg * lg8);
                av[r] = aa;
                uv[r] = __builtin_amdgcn_sqrtf(fmaxf(1.0f - aa * aa, 0.0f)) * (ig * xc);
            }
            float p = 1.f, h = 0.f, pl[4], hl[4];
#pragma unroll
            for (int r = 0; r < 4; ++r) { h = av[r] * h + uv[r]; p *= av[r]; pl[r] = p; hl[r] = h; }
            const int odd = kq & 1, hi2 = kq >> 1;
            const float pA = xor16f(p, odd), pH = xor16f(h, odd);
            const float loA = odd ? pA : p, loH = odd ? pH : h, upA = odd ? p : pA, upH = odd ? h : pH;
            const float TA = upA * loA, TH = upA * loH + upH;
            const float qA = xor32f(TA, hi2), qH = xor32f(TH, hi2);
            const float e1A = odd ? loA : 1.f, e1H = odd ? loH : 0.f;
            const float Ae = hi2 ? e1A * qA : e1A, He = hi2 ? e1A * qH + e1H : e1H;
            const float Apre = Ae * Aw, Hpre = Ae * Hw + He;
#pragma unroll
            for (int r = 0; r < 4; ++r) { hloc[mt][r] = pl[r] * Hpre + hl[r]; pcum[mt][r] = pl[r] * Apre; }
            const float At = hi2 ? TA * qA : qA * TA, Ht = hi2 ? TA * qH + TH : qA * TH + qH;
            Hw = At * Hw + Ht; Aw = At * Aw;
        }
        if (kq == 0) { AGG[(w * 16 + ch) * 2] = Aw; AGG[(w * 16 + ch) * 2 + 1] = Hw; }
        if (tile + 1 < 8) { LRU_STAGE_TILE(tile + 1); if (tile + 2 < 8) LRU_LOAD_TILE(tile + 2); }
        __syncthreads();
        float hin = htile, hrun = htile;
#pragma unroll
        for (int j = 0; j < 8; ++j) { const f32x2 ah = *(const LAS f32x2*)(AGG + (j * 16 + ch) * 2); if (j == w) hin = hrun; hrun = ah.x * hrun + ah.y; }
        htile = hrun;
#pragma unroll
        for (int mt = 0; mt < 2; ++mt) { const int tl0 = 32 * w + 16 * mt + 4 * kq;
            const u32x2 xgw = *(const LAS u32x2*)(XG + ch * XGP + tl0);
            const float gv[4] = {bflo(xgw.x), bfhi(xgw.x), bflo(xgw.y), bfhi(xgw.y)};
#pragma unroll
            for (int r = 0; r < 4; ++r) { const float hh = hloc[mt][r] + pcum[mt][r] * hin; const float x = gv[r];
                const float z2 = 1.5957691216057308f * (x + 0.044715f * x * x * x);
                const float y = hh * (x * __builtin_amdgcn_rcpf(1.0f + __expf(-z2)));
                *(LAS unsigned short*)(OST + (16 * mt + 4 * kq + r) * 32 + ch * 2) = (unsigned short)f2bf(y); } }
        LDS_WAIT(); asm volatile("" ::: "memory");
        { const int tk = lane >> 1, hf = lane & 1;
          const u32x4 o = *(const LAS u32x4*)(OST + tk * 32 + hf * 16);
          *(GAS u32x4*)(MIXp + (tokbase + 32 * w + tk) * D + 512 + c0 + 8 * hf) = o;
          float ss = bflo(o.x) * bflo(o.x) + bfhi(o.x) * bfhi(o.x) + bflo(o.y) * bflo(o.y) + bfhi(o.y) * bfhi(o.y)
                   + bflo(o.z) * bflo(o.z) + bfhi(o.z) * bfhi(o.z) + bflo(o.w) * bflo(o.w) + bfhi(o.w) * bfhi(o.w);
          ss += __shfl_xor(ss, 1);
          if (hf == 0) SSQL[(tokbase + 32 * w + tk) * 32 + hb * 4 + qt] = ss; }
        LDS_WAIT(); asm volatile("" ::: "memory");
        if (has_bg) p0_store_half_f8(bgd, tile & 1, lane, bgv);
    }
#undef LRU_WBF
#undef LRU_LOAD_TILE
#undef LRU_STAGE_TILE
    __syncthreads();
}

struct EpiX1 {
    static constexpr bool PERM = false, MIDK = true;
    const float* x; const float* mod; bf16_t* X1; float* SSQ1; const LAS f32x2* RS;
    __device__ __forceinline__ void mid(f32x4 (&acc)[2][2][4][2], const pg8::Unit& u, int wr, int wc, int fr, int fq) const {
#pragma unroll
        for (int ai = 0; ai < 2; ++ai)
#pragma unroll
            for (int m = 0; m < 4; ++m) { const float f = RS[ai * 128 + wr * 64 + m * 16 + fr].x;
#pragma unroll
                for (int bj = 0; bj < 2; ++bj)
#pragma unroll
                    for (int n = 0; n < 2; ++n) acc[ai][bj][m][n] = acc[ai][bj][m][n] * f; }
    }
    __device__ __forceinline__ void prefetch(const pg8::Unit& u, int wid, int lane) const {}
    __device__ __forceinline__ void operator()(const f32x4 (&acc)[2][2][4][2], const pg8::Unit& u, int wr, int wc, int fr, int fq) const {
        const int col0 = u.pn * 256 + wc * 32 + 4 * fq;
        const int b = (u.pm * 256) / SEQ;
        const int odd = fq & 1;
        f32x4 gt[2][2];
#pragma unroll
        for (int bj = 0; bj < 2; ++bj)
#pragma unroll
            for (int n = 0; n < 2; ++n) gt[bj][n] = *(const f32x4*)(mod + b * 6144 + 2048 + col0 + bj * 128 + n * 16);
#pragma unroll
        for (int ai = 0; ai < 2; ++ai) {
            f32x4 xv[4][2][2];
#pragma unroll
            for (int m = 0; m < 4; ++m) { const size_t off = (size_t)(u.pm * 256 + ai * 128 + wr * 64 + m * 16 + fr) * D + col0;
#pragma unroll
                for (int bj = 0; bj < 2; ++bj)
#pragma unroll
                    for (int n = 0; n < 2; ++n) xv[m][bj][n] = *(const f32x4*)(x + off + bj * 128 + n * 16); }
#pragma unroll
            for (int m0 = 0; m0 < 4; m0 += 2) { u32x2 wv[2][2][2];
#pragma unroll
                for (int mm = 0; mm < 2; ++mm) { const int m = m0 + mm; const int r = ai * 128 + wr * 64 + m * 16 + fr; const float f = RS[r].y; float ss = 0.f;
#pragma unroll
                    for (int bj = 0; bj < 2; ++bj)
#pragma unroll
                        for (int n = 0; n < 2; ++n) {
                            const f32x4 o = xv[m][bj][n] + gt[bj][n] * (acc[ai][bj][m][n] * f);
                            wv[mm][bj][n] = (u32x2){cvt_pk_bf16(o[0], o[1]), cvt_pk_bf16(o[2], o[3])};
                            ss += (o[0] * o[0] + o[1] * o[1]) + (o[2] * o[2] + o[3] * o[3]); }
                    ss += __shfl_xor(ss, 16); ss += __shfl_xor(ss, 32);
                    if (fq == 0) SSQ1[(size_t)(u.pm * 256 + r) * 16 + u.pn * 4 + wc] = ss; }
                const int rs_ = ai * 128 + wr * 64 + (m0 + odd) * 16 + fr;
                bf16_t* rowp = X1 + (size_t)(u.pm * 256 + rs_) * D + u.pn * 256 + wc * 32 + 8 * (fq >> 1);
#pragma unroll
                for (int bj = 0; bj < 2; ++bj)
#pragma unroll
                    for (int n = 0; n < 2; ++n) {
                        const u32x2 snd = odd ? wv[0][bj][n] : wv[1][bj][n];
                        u32x2 rcv; rcv.x = xor16(snd.x, odd); rcv.y = xor16(snd.y, odd);
                        const u32x4 out = odd ? (u32x4){rcv.x, rcv.y, wv[1][bj][n].x, wv[1][bj][n].y} : (u32x4){wv[0][bj][n].x, wv[0][bj][n].y, rcv.x, rcv.y};
                        *(u32x4*)(rowp + bj * 128 + n * 16) = out; } } }
    }
};
__device__ __forceinline__ void p5_phase(Frame& F, const Args& a, const int bgslot0) {
    unsigned char* ws = F.ws;
    const bf16_t* X1 = (const bf16_t*)(ws + WS_X1);
    const float* mod = (const float*)(ws + WS_MOD);
    LAS unsigned char* XH = F.lds;
    LAS unsigned char* WH = F.lds + 65536;
    LAS unsigned char* WL = F.lds + 81920;
    LAS float* PARTB = (LAS float*)F.lds;
    LAS float* TAB = (LAS float*)(F.lds + TAB_OFF);
    LAS float* CST = TAB;
    LAS float* RSQ = TAB + 32;
    LAS int* LCNT = (LAS int*)(TAB + 96);
    LAS int* LBASE = (LAS int*)(TAB + 128);
    LAS float* LG = TAB + 160;
    const int tid = F.tid, lane = F.lane, w = F.wave;
    for (int tile = F.vcu; tile < T / 64; tile += F.G) {
        const int tok0 = tile * 64, b = tok0 / SEQ;
        const float* sh2 = mod + b * 6144 + 3072; const float* sc2 = mod + b * 6144 + 4096;
        const bf16_t* WRH = (const bf16_t*)(ws + WS_WRP) + (size_t)b * NE * 1024; const bf16_t* WRL = WRH + NB * NE * 1024;
        if (tid < 64) { const GAS f32x4* sp = (const GAS f32x4*)((const float*)(ws + WS_SSQ1) + (size_t)(tok0 + tid) * 16); const f32x4 t = (sp[0] + sp[1]) + (sp[2] + sp[3]);
            RSQ[tid] = rsqrtf(((t.x + t.y) + (t.z + t.w)) * (1.0f / D) + EPS); }
        if (tid < 32) { LCNT[tid] = 0; CST[tid] = ((const float*)(ws + WS_CSTB))[b * 32 + tid]; }
        u32x4 xall[4][4]; u32x4 wq[2][2]; const int l5 = lane & 31, lh = lane >> 5;
        LAS float* GGS = (LAS float*)(F.lds + 32768); LAS float* H0S = (LAS float*)(F.lds + 36864);
#define P5_LOADX(c_) do { _Pragma("unroll") for (int i = 0; i < 4; ++i) xall[c_][i] = *((const GAS u32x4*)(X1 + (size_t)(tok0 + w + 8 * (2 * i + lh)) * D + 256 * (c_)) + l5); } while (0)
#define P5_LOADW(c_) do { _Pragma("unroll") for (int j = 0; j < 2; ++j) { const int off_ = (tid >> 4) * 1024 + 256 * (c_) + 8 * ((tid & 15) + 16 * j); \
            wq[0][j] = *(const GAS u32x4*)(WRH + off_); wq[1][j] = *(const GAS u32x4*)(WRL + off_); } } while (0)
        P5_LOADX(0); P5_LOADW(0);
        { const f32x2 g = *((const GAS f32x2*)a.in[I_GFFN] + tid), sc = *((const GAS f32x2*)sc2 + tid), sh = *((const GAS f32x2*)sh2 + tid);
          P5_LOADX(1); P5_LOADX(2); P5_LOADX(3);
          *(LAS f32x2*)(GGS + 2 * tid) = g * (sc + 1.0f); *(LAS f32x2*)(H0S + 2 * tid) = sh; }
        __syncthreads();
        f32x16 acc = {};
#pragma unroll
        for (int c = 0; c < 4; ++c) {
            { const LAS f32x4* gp = (const LAS f32x4*)(GGS + 256 * c) + 2 * l5; const LAS f32x4* hp = (const LAS f32x4*)(H0S + 256 * c) + 2 * l5;
              const f32x4 gg0 = gp[0], gg1 = gp[1], h0 = hp[0], h1 = hp[1];
#pragma unroll
              for (int i = 0; i < 4; ++i) { const int tk = w + 8 * (2 * i + lh); const float rs = RSQ[tk]; const u32x4 x = xall[c][i];
                  const f32x4 xa = (f32x4){bflo(x.x), bfhi(x.x), bflo(x.y), bfhi(x.y)}, xb = (f32x4){bflo(x.z), bfhi(x.z), bflo(x.w), bfhi(x.w)};
                  const f32x4 ya = xa * rs * gg0 + h0, yb = xb * rs * gg1 + h1;
                  u32x2 o; o.x = 0u; o.y = 0u;
                  o.x = __builtin_amdgcn_cvt_pk_fp8_f32(ya.x, ya.y, o.x, false); o.x = __builtin_amdgcn_cvt_pk_fp8_f32(ya.z, ya.w, o.x, true);
                  o.y = __builtin_amdgcn_cvt_pk_fp8_f32(yb.x, yb.y, o.y, false); o.y = __builtin_amdgcn_cvt_pk_fp8_f32(yb.z, yb.w, o.y, true);
                  *(LAS u32x2*)(F.lds + 98304 + tk * 256 + (((l5 >> 1) ^ (tk & 15)) * 16) + (l5 & 1) * 8) = o;
                  *(LAS u32x4*)(XH + tk * 512 + ((l5 ^ (tk & 15)) * 16)) = x; }
#pragma unroll
              for (int j = 0; j < 2; ++j) { const int e = tid >> 4, ci = (tid & 15) + 16 * j; const int lo_ = e * 512 + ((ci ^ (e & 15)) * 16);
                  *(LAS u32x4*)(WH + lo_) = wq[0][j]; *(LAS u32x4*)(WL + lo_) = wq[1][j]; } }
            if (c + 1 < 4) P5_LOADW(c + 1);
            __syncthreads();
#pragma unroll
            for (int j = 0; j < 2; ++j) { const int tk = (tid >> 4) + 32 * j, ci = tid & 15;
                *(GAS u32x4*)(ws + WS_H + (size_t)(tok0 + tk) * D + 256 * c + 16 * ci) = *(const LAS u32x4*)(F.lds + 98304 + tk * 256 + ((ci ^ (tk & 15)) * 16)); }
            { const int tw = w >> 2, kq = w & 3, i = lane & 31, hf = lane >> 5;
              const int rowx = 32 * tw + i;
#pragma unroll
              for (int st = 0; st < 4; ++st) { const int ci = (64 * kq + 16 * st + 8 * hf) >> 3;
                  const bf16x8 xh = *(const LAS bf16x8*)(XH + rowx * 512 + ((ci ^ (rowx & 15)) * 16));
                  const bf16x8 wh = *(const LAS bf16x8*)(WH + i * 512 + ((ci ^ (i & 15)) * 16)), wl = *(const LAS bf16x8*)(WL + i * 512 + ((ci ^ (i & 15)) * 16));
                  acc = __builtin_amdgcn_mfma_f32_32x32x16_bf16(xh, wh, acc, 0, 0, 0);
                  acc = __builtin_amdgcn_mfma_f32_32x32x16_bf16(xh, wl, acc, 0, 0, 0); } }
            __syncthreads();
        }
#undef P5_LOADX
#undef P5_LOADW
        const bool has_bg = bgslot0 >= 0 && tile == F.vcu;
        const CvtItem bgd = p0_decode(a, ws, has_bg ? P0_NITEMS - 1 - (bgslot0 + F.bx * NWAVES + F.wave) : 0); f32x4 bgv[8];
        if (has_bg) p0_load_half(bgd, 1, lane, bgv);
        if (F.bx == 0 && tid < 64) ((GAS u32x4*)(ws + WS_H + (size_t)T * D))[tid] = (u32x4){0u, 0u, 0u, 0u};
        {
          LAS float* PART = PARTB + w * (32 * 33); const int e = lane & 31, hi = lane >> 5;
#pragma unroll
          for (int r = 0; r < 16; ++r) PART[crow(r, hi) * 33 + e] = acc[r]; }
        __syncthreads();
        {
          const int tk = tid >> 3, e0 = (tid & 7) * 4, tw = tk >> 5, tl = tk & 31; const float rs = RSQ[tk];
#pragma unroll
          for (int j = 0; j < 4; ++j) { float s = 0.f;
#pragma unroll
              for (int q = 0; q < 4; ++q) s += PARTB[(tw * 4 + q) * (32 * 33) + tl * 33 + e0 + j];
              LG[tk * 33 + e0 + j] = rs * s + CST[e0 + j]; } }
        __syncthreads();
        int eidx[4] = {0, 0, 0, 0}; int lpos[4] = {0, 0, 0, 0};
        if (tid < 64) {
            float val[4]; unsigned used = 0u;
#pragma unroll
            for (int k = 0; k < 4; ++k) { float best = -3.0e38f; int bi = 0;
#pragma unroll 8
                for (int j = 0; j < 32; ++j) { const float v = LG[tid * 33 + j]; if (!((used >> j) & 1u) && v > best) { best = v; bi = j; } }
                used |= 1u << bi; eidx[k] = bi; val[k] = best; }
            float ex[4], den = 0.f;
#pragma unroll
            for (int k = 0; k < 4; ++k) { ex[k] = __expf(val[k] - val[0]); den += ex[k]; }
            const float inv = 1.0f / den;
            *(f32x4*)((float*)(ws + WS_TOPG) + (size_t)(tok0 + tid) * 4) = (f32x4){ex[0] * inv, ex[1] * inv, ex[2] * inv, ex[3] * inv};
#pragma unroll
            for (int k = 0; k < 4; ++k) lpos[k] = __hip_atomic_fetch_add(LCNT + eidx[k], 1, __ATOMIC_RELAXED, __HIP_MEMORY_SCOPE_WORKGROUP);
        }
        __syncthreads();
        if (tid < 32) { const int c = LCNT[tid]; LBASE[tid] = c > 0 ? (int)__hip_atomic_fetch_add((unsigned*)(ws + WS_CTL) + CW_CNT + tid, (unsigned)c, RLX_AGENT) : 0; }
        __syncthreads();
        if (tid < 64) {
#pragma unroll
            for (int k = 0; k < 4; ++k) ((int*)(ws + WS_LIST))[eidx[k] * LISTCAP + LBASE[eidx[k]] + lpos[k]] = (tok0 + tid) * 4 + k;
        }
        if (has_bg) p0_store_half_f8(bgd, 1, lane, bgv);
        __syncthreads();
    }
}

struct GroupedOrder {
    const LAS int* TP; const LAS unsigned* TABR;
    const LAS int* UT;
    int ntiles, ntA, mixed, G, c, rowbytes; const char* Wgu; const char* Wdn; unsigned offH, offACT; const unsigned* rdy;
    __device__ __forceinline__ void set_b(pg8::Unit& u) const {
        u.bptr = (u.kind == 1) ? Wgu + (size_t)u.e * (2048 * 1024) + (size_t)u.pn * 256 * 1024 : Wdn + (size_t)u.e * (1024 * 1024) + (size_t)u.pn * 256 * 1024; }
    __device__ __forceinline__ void grp(int L, int nt_, int npn, pg8::Unit& u) const {
        const int nun = nt_ * npn; int wgid = L; { const int q = nun / 8, r = nun % 8, xcd = wgid % 8, off = wgid / 8; wgid = (xcd < r ? xcd * (q + 1) : r * (q + 1) + (xcd - r) * q) + off; }
        const int WGM = 8;
        const int nig = WGM * npn, gid = wgid / nig, fm = gid * WGM, gsz = (nt_ - fm) < WGM ? (nt_ - fm) : WGM;
        u.pm = fm + ((wgid % nig) % gsz); u.pn = (wgid % nig) / gsz; }
    __device__ __forceinline__ bool next(int i, pg8::Unit& u) const {
        if (UT) { if (i >= 10) return false; const int pm_ = __builtin_amdgcn_readfirstlane(UT[8 * i]), pn_ = __builtin_amdgcn_readfirstlane(UT[8 * i + 1]), e_ = __builtin_amdgcn_readfirstlane(UT[8 * i + 2]), ok_ = __builtin_amdgcn_readfirstlane(UT[8 * i + 3]);
            if (!ok_) return false; u.pm = pm_; u.pn = pn_; u.e = e_; u.li = i; u.kind = __builtin_amdgcn_readfirstlane(UT[8 * i + 4]); set_b(u); return true; }
        const long Ll = (long)i * G + c; const int R = ntiles - ntA;
        if (!mixed) { if (Ll >= (long)ntA * 8) return false; grp((int)Ll, ntA, 8, u); u.kind = 1; }
        else if (Ll < 8 * R) { u.pm = ntA + (int)Ll / 8; u.pn = (int)Ll % 8; u.kind = 1; }
        else if (Ll < 8 * R + 4 * (long)ntA) { grp((int)Ll - 8 * R, ntA, 4, u); u.kind = 2; }
        else if (Ll < 8 * R + 4 * (long)ntA + 4 * R) { const int L3 = (int)Ll - 8 * R - 4 * ntA; u.pm = ntA + L3 / 4; u.pn = L3 % 4; u.kind = 3; }
        else return false;
        u.li = i;
        int e = 0;
        for (int j = 1; j < NE; ++j) e += (TP[j] <= u.pm) ? 1 : 0;
        u.e = __builtin_amdgcn_readfirstlane(e);
        set_b(u);
        return true;
    }
    __device__ __forceinline__ unsigned a_off(const pg8::Unit& u, int r) const {
        if (u.kind == 1) return offH + TABR[u.li * 256 + r];
        return offACT + (unsigned)((u.pm * 256 + r) * rowbytes);
    }
    __device__ __forceinline__ void ready(const pg8::Unit& u) const {
        if (u.kind == 3) { const unsigned* p = rdy + (u.pm - ntA); unsigned spins = 0;
            while (__hip_atomic_load(p, RLX_AGENT) < 8u) { __builtin_amdgcn_s_sleep(2); if (++spins > (1u << 22)) break; }
            __builtin_amdgcn_fence(__ATOMIC_ACQUIRE, "agent"); asm volatile("s_waitcnt vmcnt(0)" ::: "memory"); }
    }
};

struct EpiSwiglu {
    static constexpr bool PERM = true, MIDK = false;
    unsigned char* ACT; const float* b_gu; LAS float* BIAS;
    __device__ __forceinline__ void mid(f32x4 (&acc)[2][2][4][2], const pg8::Unit& u, int wr, int wc, int fr, int fq) const {}
    __device__ __forceinline__ void prefetch(const pg8::Unit& u, int wid, int lane) const {
        if (wid == 0) { const float* g = b_gu + u.e * 2048 + u.pn * 128 + (lane & 31) * 4 + (lane >> 5) * 1024;
            __builtin_amdgcn_global_load_lds((const unsigned*)g, (LAS unsigned*)(BIAS + (u.li & 1) * 256), 16, 0, 0); }
    }
    __device__ __forceinline__ void operator()(const f32x4 (&acc)[2][2][4][2], const pg8::Unit& u, int wr, int wc, int fr, int fq) const {
        const int c0 = u.pn * 128 + wc * 32 + 8 * fq;
        const LAS float* bg = BIAS + (u.li & 1) * 256 + wc * 32 + 8 * fq;
        f32x2 bgate[2][2], bup1[2][2];
#pragma unroll
        for (int n = 0; n < 2; ++n) { const f32x4 g4 = *(const LAS f32x4*)(bg + 4 * n), u4 = *(const LAS f32x4*)(bg + 128 + 4 * n);
            bgate[n][0] = (f32x2){g4.x, g4.y}; bgate[n][1] = (f32x2){g4.z, g4.w}; bup1[n][0] = (f32x2){u4.x + 1.0f, u4.y + 1.0f}; bup1[n][1] = (f32x2){u4.z + 1.0f, u4.w + 1.0f}; }
        const int odd = fq & 1;
#pragma unroll
        for (int ai = 0; ai < 2; ++ai)
#pragma unroll
            for (int m0 = 0; m0 < 4; m0 += 2) {
                u32x2 wv[2];
#pragma unroll
                for (int mm = 0; mm < 2; ++mm) { const int m = m0 + mm; float o[8];
#pragma unroll
                    for (int n = 0; n < 2; ++n)
#pragma unroll
                        for (int h = 0; h < 2; ++h) {
                            const f32x2 ag = (f32x2){acc[ai][0][m][n][2 * h], acc[ai][0][m][n][2 * h + 1]}, au = (f32x2){acc[ai][1][m][n][2 * h], acc[ai][1][m][n][2 * h + 1]};
                            f32x2 gate = ag * WUNSCALE + bgate[n][h]; gate.x = fminf(gate.x, 7.0f); gate.y = fminf(gate.y, 7.0f);
                            f32x2 up1 = au * WUNSCALE + bup1[n][h]; up1.x = __builtin_amdgcn_fmed3f(up1.x, -6.0f, 8.0f); up1.y = __builtin_amdgcn_fmed3f(up1.y, -6.0f, 8.0f);
                            const f32x2 z = gate * (-1.702f * 1.4426950408889634f);
                            const f32x2 den = (f32x2){__builtin_amdgcn_exp2f(z.x), __builtin_amdgcn_exp2f(z.y)} + 1.0f;
                            const f32x2 r = (f32x2){__builtin_amdgcn_rcpf(den.x), __builtin_amdgcn_rcpf(den.y)};
                            const f32x2 ov = up1 * (gate * r);
                            o[4 * n + 2 * h] = ov.x; o[4 * n + 2 * h + 1] = ov.y; }
                    u32x2 w; w.x = 0u; w.y = 0u;
                    w.x = __builtin_amdgcn_cvt_pk_fp8_f32(o[0], o[1], w.x, false); w.x = __builtin_amdgcn_cvt_pk_fp8_f32(o[2], o[3], w.x, true);
                    w.y = __builtin_amdgcn_cvt_pk_fp8_f32(o[4], o[5], w.y, false); w.y = __builtin_amdgcn_cvt_pk_fp8_f32(o[6], o[7], w.y, true);
                    wv[mm] = w; }
                const u32x2 snd = odd ? wv[0] : wv[1];
                u32x2 rcv; rcv.x = xor16(snd.x, odd); rcv.y = xor16(snd.y, odd);
                const u32x4 out = odd ? (u32x4){rcv.x, rcv.y, wv[1].x, wv[1].y} : (u32x4){wv[0].x, wv[0].y, rcv.x, rcv.y};
                const int r = ai * 128 + wr * 64 + (m0 + odd) * 16 + fr;
                *(u32x4*)(ACT + (size_t)(u.pm * 256 + r) * 1024 + u.pn * 128 + wc * 32 + 16 * (fq >> 1)) = out; }
    }
};
struct EpiDown {
    static constexpr bool PERM = true, MIDK = false;
    unsigned char* YB; const float* b_dn; const LAS int* SLOT; LAS float* BIAS;
    __device__ __forceinline__ void mid(f32x4 (&acc)[2][2][4][2], const pg8::Unit& u, int wr, int wc, int fr, int fq) const {}
    __device__ __forceinline__ void prefetch(const pg8::Unit& u, int wid, int lane) const {
        if (wid == 0) { const float* g = b_dn + u.e * 1024 + u.pn * 256 + lane * 4;
            __builtin_amdgcn_global_load_lds((const unsigned*)g, (LAS unsigned*)(BIAS + (u.li & 1) * 256), 16, 0, 0); }
    }
    __device__ __forceinline__ void operator()(const f32x4 (&acc)[2][2][4][2], const pg8::Unit& u, int wr, int wc, int fr, int fq) const {
        const int col0 = u.pn * 256 + wc * 32 + 8 * fq;
        const LAS float* bd = BIAS + (u.li & 1) * 256 + wc * 32 + 8 * fq;
        f32x4 bv[2][2];
#pragma unroll
        for (int bj = 0; bj < 2; ++bj)
#pragma unroll
            for (int n = 0; n < 2; ++n) bv[bj][n] = *(const LAS f32x4*)(bd + bj * 128 + 4 * n);
        const int odd = fq & 1;
#pragma unroll
        for (int ai = 0; ai < 2; ++ai)
#pragma unroll
            for (int m0 = 0; m0 < 4; m0 += 2) {
                const int r = ai * 128 + wr * 64 + (m0 + odd) * 16 + fr;
                const int slot = SLOT[u.li * 256 + r];
                unsigned char* rowp = YB + (size_t)slot * 1024 + u.pn * 256 + wc * 32 + 16 * (fq >> 1);
#pragma unroll
                for (int bj = 0; bj < 2; ++bj) { u32x2 wv[2];
#pragma unroll
                    for (int mm = 0; mm < 2; ++mm) { const int m = m0 + mm;
                        const f32x4 v0 = acc[ai][bj][m][0] * WUNSCALE + bv[bj][0], v1 = acc[ai][bj][m][1] * WUNSCALE + bv[bj][1];
                        u32x2 w; w.x = 0u; w.y = 0u;
                        w.x = __builtin_amdgcn_cvt_pk_fp8_f32(v0[0], v0[1], w.x, false); w.x = __builtin_amdgcn_cvt_pk_fp8_f32(v0[2], v0[3], w.x, true);
                        w.y = __builtin_amdgcn_cvt_pk_fp8_f32(v1[0], v1[1], w.y, false); w.y = __builtin_amdgcn_cvt_pk_fp8_f32(v1[2], v1[3], w.y, true);
                        wv[mm] = w; }
                    const u32x2 snd = odd ? wv[0] : wv[1];
                    u32x2 rcv; rcv.x = xor16(snd.x, odd); rcv.y = xor16(snd.y, odd);
                    const u32x4 out = odd ? (u32x4){rcv.x, rcv.y, wv[1].x, wv[1].y} : (u32x4){wv[0].x, wv[0].y, rcv.x, rcv.y};
                    *(u32x4*)(rowp + bj * 128) = out; } }
    }
};

struct EpiMixed {
    static constexpr bool PERM = true, MIDK = false;
    EpiSwiglu e1; EpiDown e2; unsigned* rdy; int ntA;
    __device__ __forceinline__ void mid(f32x4 (&acc)[2][2][4][2], const pg8::Unit& u, int wr, int wc, int fr, int fq) const {}
    __device__ __forceinline__ void prefetch(const pg8::Unit& u, int wid, int lane) const { if (u.kind == 1) e1.prefetch(u, wid, lane); else e2.prefetch(u, wid, lane); }
    __device__ __forceinline__ void operator()(const f32x4 (&acc)[2][2][4][2], const pg8::Unit& u, int wr, int wc, int fr, int fq) const {
        if (u.kind == 1) {
            e1(acc, u, wr, wc, fr, fq);
            asm volatile("s_waitcnt vmcnt(0)" ::: "memory");
            __builtin_amdgcn_s_barrier();
            if (threadIdx.x == 0) { __builtin_amdgcn_fence(__ATOMIC_RELEASE, "agent"); asm volatile("s_waitcnt vmcnt(0)" ::: "memory");
                __hip_atomic_fetch_add(rdy + (u.pm - ntA), 1u, RLX_AGENT); }
        } else e2(acc, u, wr, wc, fr, fq);
    }
};

__device__ __forceinline__ void grouped_fill(Frame& F, GroupedOrder& S, int mode, int tabbase, unsigned offH, unsigned offACT) {
    LAS int* TP = (LAS int*)(F.lds + TAB_OFF);
    S.TP = TP; S.TABR = (const LAS unsigned*)(F.lds + TAB_OFF + tabbase); S.UT = nullptr;
    S.ntiles = __builtin_amdgcn_readfirstlane(TP[NE]);
    S.ntA = (F.G == 256 && S.ntiles >= 32) ? (S.ntiles & ~31) : S.ntiles;
    S.mixed = (mode == 2); S.G = F.G; S.c = F.bx; S.rowbytes = 1024;
    S.Wgu = (const char*)(F.ws + WS_WGU); S.Wdn = (const char*)(F.ws + WS_WDN); S.offH = offH; S.offACT = offACT;
    S.rdy = (const unsigned*)(F.ws + WS_CTL) + CW_RDY;
}
template <int MODE>
__device__ __forceinline__ void grouped_setup(Frame& F, GroupedOrder& S, int tabbase, bool have_tp, unsigned offH, unsigned offACT) {
    LAS int* TP = (LAS int*)(F.lds + TAB_OFF);
    LAS unsigned* TABR = (LAS unsigned*)(F.lds + TAB_OFF + tabbase);
    const unsigned* cnt = (const unsigned*)(F.ws + WS_CTL) + CW_CNT;
    if (!have_tp) {
        if (F.tid < 64) {
            const int c = (F.tid < NE) ? (int)__hip_atomic_load(cnt + (F.tid & 31), RLX_AGENT) : 0;
            const int nt_ = (c + 255) >> 8; int incl = nt_;
#pragma unroll
            for (int off = 1; off < 32; off <<= 1) { const int v = __shfl_up(incl, off); if ((F.tid & 63) >= off) incl += v; }
            if (F.tid < NE) TP[F.tid] = incl - nt_;
            if (F.tid == NE - 1) TP[NE] = incl; }
        __syncthreads();
    }
    grouped_fill(F, S, MODE, tabbase, offH, offACT);
    LAS int* UT = (LAS int*)(F.lds + TAB_OFF + tabbase + 10 * 1024);
    const int* LIST = (const int*)(F.ws + WS_LIST);
    { pg8::Unit u; int sl[10]; int kd[10];
#pragma unroll
      for (int li = 0; li < 10; ++li) { sl[li] = DUMP; kd[li] = 0;
          const bool ok = S.next(li, u);
          if (F.tid == 0) { UT[8 * li] = ok ? u.pm : 0; UT[8 * li + 1] = ok ? u.pn : 0; UT[8 * li + 2] = ok ? u.e : 0; UT[8 * li + 3] = ok ? 1 : 0; UT[8 * li + 4] = ok ? u.kind : 0; }
          if (ok) kd[li] = u.kind;
          if (ok && F.tid < 256) sl[li] = LIST[u.e * LISTCAP + (u.pm - TP[u.e]) * 256 + F.tid]; }
#pragma unroll
      for (int li = 0; li < 10; ++li) if (F.tid < 256) TABR[li * 256 + F.tid] = (kd[li] == 1) ? (unsigned)(sl[li] >> 2) * 1024u : (unsigned)sl[li]; }
    __syncthreads();
    S.UT = UT;
}
__device__ __forceinline__ void grouped_attach(Frame& F, GroupedOrder& S, int mode, int tabbase, unsigned offH, unsigned offACT) {
    grouped_fill(F, S, mode, tabbase, offH, offACT);
    S.UT = (const LAS int*)(F.lds + TAB_OFF + tabbase + 10 * 1024);
}

__device__ __forceinline__ void p8_phase(Frame& F, const Args& a) {
    const int gw0 = F.bx * NWAVES + F.wave, NGW0 = F.G * NWAVES, lane = F.lane;
    const bool blocked = (F.G == 256); constexpr int RPW = T / (256 * NWAVES);
    const int vw = F.vcu * NWAVES + F.wave;
    const int gw = blocked ? vw * RPW : gw0, NGW = blocked ? 1 : NGW0, mend = blocked ? (vw + 1) * RPW : T;
    const bf16_t* X1 = (const bf16_t*)(F.ws + WS_X1); const float* mod = (const float*)(F.ws + WS_MOD);
    const unsigned char* YB = F.ws + WS_YB; const float* TOPG = (const float*)(F.ws + WS_TOPG);
    LAS float* ROW = (LAS float*)(F.lds + F.wave * 4352);
    f32x4 gf[4], g2[4]; int bcur = -1;
#pragma unroll
    for (int j = 0; j < 4; ++j) gf[j] = *((const GAS f32x4*)a.in[I_GFIN] + lane + 64 * j);
    u32x2 xv[4], xn[4], xn2[4]; f32x4 gk = {0.f, 0.f, 0.f, 0.f}, gkn = {0.f, 0.f, 0.f, 0.f}, gkn2 = {0.f, 0.f, 0.f, 0.f}; u32x4 yv[4], yn[4], yn2[4];
#define P8_LOAD(m_, X, Y, G_) do { G_ = *(const f32x4*)(TOPG + (size_t)(m_) * 4); \
        _Pragma("unroll") for (int j = 0; j < 4; ++j) X[j] = *((const GAS u32x2*)(X1 + (size_t)(m_) * D) + lane + 64 * j); \
        _Pragma("unroll") for (int k = 0; k < 4; ++k) Y[k] = *((const GAS u32x4*)(YB + (size_t)((m_) * 4 + k) * D) + lane); } while (0)
    if (gw < mend) P8_LOAD(gw, xv, yv, gk);
    if (gw + NGW < mend) P8_LOAD(gw + NGW, xn, yn, gkn);
    for (int m = gw; m < mend; m += NGW) {
        const int b = m / SEQ, mn2 = m + 2 * NGW;
        if (mn2 < mend) P8_LOAD(mn2, xn2, yn2, gkn2);
        if (b != bcur) { bcur = b;
#pragma unroll
            for (int j = 0; j < 4; ++j) g2[j] = *((const GAS f32x4*)(mod + b * 6144 + 5120) + lane + 64 * j); }
        float s[16];
#pragma unroll
        for (int q = 0; q < 16; ++q) s[q] = 0.f;
#pragma unroll
        for (int k = 0; k < 4; ++k) { const unsigned yw[4] = {yv[k].x, yv[k].y, yv[k].z, yv[k].w};
#pragma unroll
            for (int q = 0; q < 4; ++q) { const f32x2 lo = __builtin_amdgcn_cvt_pk_f32_fp8(yw[q], false), hi = __builtin_amdgcn_cvt_pk_f32_fp8(yw[q], true);
                s[4 * q + 0] += gk[k] * lo.x; s[4 * q + 1] += gk[k] * lo.y; s[4 * q + 2] += gk[k] * hi.x; s[4 * q + 3] += gk[k] * hi.y; } }
#pragma unroll
        for (int q = 0; q < 16; ++q) ROW[lane * 17 + q] = s[q];
        LDS_WAIT(); asm volatile("" ::: "memory");
        f32x4 v[4]; float ss = 0.f;
#pragma unroll
        for (int j = 0; j < 4; ++j) { const int c = 4 * (lane + 64 * j); const LAS float* rp = ROW + (c >> 4) * 17 + (c & 15);
            const f32x4 sv = (f32x4){rp[0], rp[1], rp[2], rp[3]};
            v[j] = (f32x4){bflo(xv[j].x), bfhi(xv[j].x), bflo(xv[j].y), bfhi(xv[j].y)} + g2[j] * sv;
            ss += (v[j].x * v[j].x + v[j].y * v[j].y) + (v[j].z * v[j].z + v[j].w * v[j].w); }
        const float rs = rsqrtf(wave_sum(ss) * (1.f / D) + EPS);
        GAS f32x4* o = (GAS f32x4*)(a.out + (size_t)m * D) + lane;
#pragma unroll
        for (int j = 0; j < 4; ++j) __builtin_nontemporal_store(v[j] * rs * gf[j], o + 64 * j);
        LDS_WAIT(); asm volatile("" ::: "memory");
        gk = gkn; gkn = gkn2;
#pragma unroll
        for (int j = 0; j < 4; ++j) { xv[j] = xn[j]; yv[j] = yn[j]; xn[j] = xn2[j]; yn[j] = yn2[j]; }
    }
#undef P8_LOAD
}
__global__ void __launch_bounds__(NTHR, 2) mega_fwd(Args args) {
    extern __shared__ __attribute__((aligned(16))) unsigned char lds_raw[];
    Frame F;
    F.lds = (LAS unsigned char*)lds_raw;
    F.tid = threadIdx.x; F.lane = F.tid & 63; F.wave = __builtin_amdgcn_readfirstlane(F.tid >> 6);
    F.G = gridDim.x; F.bx = blockIdx.x; F.ws = args.ws;
    F.vcu = (F.G % 8 == 0) ? (F.bx % 8) * (F.G / 8) + F.bx / 8 : F.bx;
    volatile LAS unsigned* MISC = (volatile LAS unsigned*)(F.lds + LDSCTL_OFF);
    for (int u = F.tid; u < 128; u += NTHR) MISC[u] = 0u;
    __syncthreads();
    unsigned* ctl = (unsigned*)(args.ws + WS_CTL);
    XcdBarrier bar = xcd_barrier_post(ctl + CW_BAR, MISC + 8);
    const int lo = args.ph_lo, hi = args.ph_hi;
#define IN(k) (lo <= (k) && (k) < hi)
    constexpr int NBGB = 5;
    const bool bgbar = (lo == 0 && hi == 9) && (NBGB * 7 * F.G <= 32 * 8 * 32 + 7 * F.G);
    const bool attbg = bgbar && F.G == 256;
    constexpr int LRU_BG = 8;
    const int lrubg = attbg ? LRU_BG : 0;
    const int nfg = bgbar ? P0_NITEMS - NBGB * 7 * F.G - (attbg ? 2 * NWAVES * F.G : 0) - (lrubg / 2) * NWAVES * F.G : P0_NITEMS;
#define SEAM(k) do { if (IN(k) && IN((k) + 1)) { if (bgbar && (k) <= NBGB) xcd_barrier_bg(bar, F, args, P0_NITEMS - 1 - ((NBGB - (k)) * 7 * F.G + F.bx * 7 + (F.wave - 1))); else xcd_barrier(bar); } } while (0)
    if (IN(0)) { p0_phase(F, args, nfg); }
    if (IN(1)) { p1_phase(F, args); } SEAM(1);
    if (IN(2)) {
        pg8::DenseOrder S; S.init(T, NCOL, D * 2, args.ws + WS_WIN, F.G, F.bx);
        EpiBf16 E{(bf16_t*)(args.ws + WS_P), NCOL};
        pg8::gemm_phase<EpiBf16, pg8::DenseOrder, true, false>(F.lds, (const char*)(args.ws + WS_H), D * 2, S, E);
        { pg8::Unit u1;
          const int nidle = 2 * F.G - S.nwg;
          if (nidle <= 0 || nidle > F.G) router_operands(F, args, F.bx, F.G);
          else if (!S.next(1, u1)) router_operands(F, args, F.bx - (F.G - nidle), nidle); }
    }
    LruPre lpre{}; bool have_lpre = false;
    if (IN(2) && IN(3) && F.vcu < 256) { __syncthreads(); lpre = lru_pre(F, args, F.vcu); have_lpre = true; }
    SEAM(2);
    if (IN(3)) {
        for (int it = F.vcu; it < 256; it += F.G) attn_item(F, args, it, (attbg && it == F.vcu) ? NBGB * 7 * F.G : -1);
        for (int it = F.vcu; it < 256; it += F.G) { if (!(have_lpre && it == F.vcu)) lpre = lru_pre(F, args, it); lru_item(F, args, it, lpre, NBGB * 7 * F.G + 2 * NWAVES * F.G, (it == F.vcu) ? lrubg : 0); }
    } SEAM(3);
    if (IN(4)) {
        pg8::DenseOrder S; S.init(T, D, D * 2, args.ws + WS_WOUT, F.G, F.bx);
        LAS f32x2* RS = (LAS f32x2*)(F.lds + TAB_OFF);
        pg8::Unit u0;
        if (S.next(0, u0)) {
            if (F.tid < 256) { const size_t tok = (size_t)u0.pm * 256 + F.tid;
                const GAS f32x4* sa = (const GAS f32x4*)((const float*)(args.ws + WS_SSQA) + tok * 8); const GAS f32x4* sl = (const GAS f32x4*)((const float*)(args.ws + WS_SSQL) + tok * 32);
                f32x4 va = sa[0] + sa[1], vl = sl[0];
#pragma unroll
                for (int i = 1; i < 8; ++i) vl += sl[i];
                const float ssa = (va.x + va.y) + (va.z + va.w), ssl = (vl.x + vl.y) + (vl.z + vl.w);
                const float ra = rsqrtf(ssa * (1.0f / 512) + EPS), rl = rsqrtf(ssl * (1.0f / 512) + EPS);
                RS[F.tid] = (f32x2){ra / rl, rl}; }
        }
        __syncthreads();
        EpiX1 E{args.in[I_X], (const float*)(args.ws + WS_MOD), (bf16_t*)(args.ws + WS_X1), (float*)(args.ws + WS_SSQ1), RS};
        pg8::gemm_phase<EpiX1, pg8::DenseOrder, false, false>(F.lds, (const char*)(args.ws + WS_MIX), D * 2, S, E);
    } SEAM(4);
    if (IN(5)) { p5_phase(F, args, attbg ? NBGB * 7 * F.G + NWAVES * F.G : -1); } SEAM(5);
    constexpr int TB1 = 256, TB2 = 256 + 17 * 1024;
    if (IN(6)) {
        GroupedOrder S; grouped_setup<1>(F, S, TB1, false, 0u, 0u);
        EpiSwiglu E{args.ws + WS_ACT, args.in[I_BGU], (LAS float*)(F.lds + BIAS_OFF)};
        pg8::gemm_phase<EpiSwiglu, GroupedOrder, true, true>(F.lds, (const char*)(args.ws + WS_H), D, S, E);
        if (IN(7)) { GroupedOrder S2; grouped_setup<2>(F, S2, TB2, true, (unsigned)WS_H, (unsigned)WS_ACT); }
    } SEAM(6);
    if (IN(7)) {
        GroupedOrder S;
        if (IN(6)) grouped_attach(F, S, 2, TB2, (unsigned)WS_H, (unsigned)WS_ACT);
        else grouped_setup<2>(F, S, TB2, false, (unsigned)WS_H, (unsigned)WS_ACT);
        EpiMixed E{EpiSwiglu{args.ws + WS_ACT, args.in[I_BGU], (LAS float*)(F.lds + BIAS_OFF)},
                   EpiDown{args.ws + WS_YB, args.in[I_BDN], (const LAS int*)(F.lds + TAB_OFF + TB2), (LAS float*)(F.lds + BIAS_OFF)}, ctl + CW_RDY, S.ntA};
        pg8::gemm_phase<EpiMixed, GroupedOrder, true, true>(F.lds, (const char*)args.ws, D, S, E);
    } SEAM(7);
    if (IN(8)) { p8_phase(F, args); }
#undef IN
#undef SEAM
}
}
extern "C" void kernel_launch(void* const* d_in, const int* in_sizes, int n_in, void* d_out, int out_size, void* d_ws, size_t ws_size,
                              hipStream_t stream) {
    static int grid = 0;
    if (grid == 0) {
        if (n_in != 25 || out_size != mk::T * mk::D || ws_size < mk::WS_END) { fprintf(stderr, "kernel_launch: unexpected problem shape (n_in %d out %d ws %zu)\n", n_in, out_size, ws_size); grid = -1; return; }
        int dev = 0, cus = 0, per_cu = 0;
        if (hipGetDevice(&dev) != hipSuccess || hipDeviceGetAttribute(&cus, hipDeviceAttributeMultiprocessorCount, dev) != hipSuccess) { grid = -1; return; }
        if (hipFuncSetAttribute((const void*)mk::mega_fwd, hipFuncAttributeMaxDynamicSharedMemorySize, mk::LDS_BYTES) != hipSuccess) { fprintf(stderr, "kernel_launch: hipFuncSetAttribute failed\n"); grid = -1; return; }
        if (hipOccupancyMaxActiveBlocksPerMultiprocessor(&per_cu, (const void*)mk::mega_fwd, mk::NTHR, mk::LDS_BYTES) != hipSuccess || per_cu < 1) { fprintf(stderr, "kernel_launch: occupancy query says %d workgroups per CU\n", per_cu); grid = -1; return; }
        grid = cus;
    }
    if (grid < 0) return;
    if (hipMemsetAsync((char*)d_ws + mk::WS_CTL, 0, mk::CTL_ZERO_BYTES, stream) != hipSuccess) return;
    mk::Args a{};
    for (int i = 0; i < 25; ++i) a.in[i] = (const float*)d_in[i];
    a.out = (float*)d_out; a.ws = (unsigned char*)d_ws; a.ph_lo = 0; a.ph_hi = 9;
    void* kargs[] = {&a};
    hipError_t le = hipLaunchCooperativeKernel((const void*)mk::mega_fwd, dim3(grid), dim3(mk::NTHR), kargs, mk::LDS_BYTES, stream);
    if (le != hipSuccess) fprintf(stderr, "kernel_launch: cooperative launch failed: %s (grid %d)\n", hipGetErrorString(le), grid);
}
```
